# Optimizing an MI355X kernel written in HIP

```python
import math
import jax
import jax.numpy as jnp
from jax import lax
import numpy as np

D_MODEL = 1024
BATCH = 16
SEQ = 4096
DEPTH = 1

MEM_LEN = 256
NORM_EPS = 1e-5
D_FF = 2816

SSD_WIDTH = D_MODEL // 2
DIFF_WIDTH = D_MODEL - SSD_WIDTH

SSD_HEAD_DIM = 64
SSD_HEADS = SSD_WIDTH // SSD_HEAD_DIM
SSD_GROUPS = 2
SSD_STATE = 128
SSD_CONV = 5
SSD_CHUNK = 128
SSD_CONV_DIM = SSD_WIDTH + 2 * SSD_GROUPS * SSD_STATE

DIFF_HEADS = 4
DIFF_HEAD_DIM = DIFF_WIDTH // (2 * DIFF_HEADS)
DIFF_V_DIM = 2 * DIFF_HEAD_DIM
ROPE_THETA = 500000.0
ROPE_DIM = DIFF_HEAD_DIM // 4
Q_BLOCK = 128

XATTN_HEADS = 4
XATTN_HEAD_DIM = D_MODEL // XATTN_HEADS

IN_SSD = SSD_WIDTH + SSD_CONV_DIM + 2 * SSD_HEADS
IN_DIFF = 3 * DIFF_WIDTH
D_IN_PROJ = IN_SSD + IN_DIFF

kernel_name = "hybrid_ssd_diffattn_macaron_encoder"


def rms_norm(x, g):
    xf = x.astype(jnp.float32)
    y = xf * lax.rsqrt(jnp.mean(xf * xf, axis=-1, keepdims=True) + NORM_EPS)
    return (y * g.astype(jnp.float32)).astype(x.dtype)


def swiglu(h, w_gate, w_up, w_down):
    return (jax.nn.silu(h @ w_gate) * (h @ w_up)) @ w_down


def rope_tables(seq_len):
    pos = jnp.arange(seq_len, dtype=jnp.float32)
    inv_freq = 1.0 / (ROPE_THETA ** (jnp.arange(0, ROPE_DIM, 2, dtype=jnp.float32) / ROPE_DIM))
    ang = pos[:, None] * inv_freq[None, :]
    return jnp.cos(ang), jnp.sin(ang)


def partial_rope(t, cos, sin):
    half = ROPE_DIM // 2
    c = cos[None, :, None, None, :]
    s_ = sin[None, :, None, None, :]
    tf = t[..., :ROPE_DIM].astype(jnp.float32)
    t1, t2 = tf[..., :half], tf[..., half:]
    rot = jnp.concatenate([t1 * c - t2 * s_, t2 * c + t1 * s_], axis=-1).astype(t.dtype)
    return jnp.concatenate([rot, t[..., ROPE_DIM:]], axis=-1)


def segment_decay(a_cum):
    L = a_cum.shape[2]
    diff = a_cum[:, :, :, None] - a_cum[:, :, None, :]
    mask = jnp.tril(jnp.ones((L, L), dtype=bool))[None, None, :, :, None, None]
    return jnp.exp(jnp.where(mask, diff, -jnp.inf))


def ssd_chunked(xh, dt, A, Bg, Cg):
    b, s, h, p = xh.shape
    g, n = Bg.shape[-2], Bg.shape[-1]
    r = h // g
    L = SSD_CHUNK
    c = s // L
    a = (dt * A).reshape(b, c, L, g, r)
    xdt = (xh.astype(jnp.float32) * dt[..., None]).reshape(b, c, L, g, r, p)
    Bc = Bg.astype(jnp.float32).reshape(b, c, L, g, n)
    Cc = Cg.astype(jnp.float32).reshape(b, c, L, g, n)
    a_cum = jnp.cumsum(a, axis=2)
    cb = jnp.einsum("bclgn,bcsgn->bclsg", Cc, Bc)
    y_diag = jnp.einsum("bclsg,bclsgr,bcsgrp->bclgrp", cb, segment_decay(a_cum), xdt)
    decay_to_end = jnp.exp(a_cum[:, :, -1:] - a_cum)
    states = jnp.einsum("bclgn,bclgr,bclgrp->bcgrpn", Bc, decay_to_end, xdt)
    chunk_decay = jnp.exp(a_cum[:, :, -1])

    def step(carry, inp):
        st, dec = inp
        return carry * dec[..., None, None] + st, carry

    _, prev = lax.scan(step, jnp.zeros_like(states[:, 0]),
                       (jnp.moveaxis(states, 1, 0), jnp.moveaxis(chunk_decay, 1, 0)))
    prev = jnp.moveaxis(prev, 0, 1)
    y_off = jnp.einsum("bclgn,bcgrpn,bclgr->bclgrp", Cc, prev, jnp.exp(a_cum))
    return (y_diag + y_off).reshape(b, s, h, p)


def ssd_mixer(zxbcdt, conv_w, conv_b, dt_bias_fwd, dt_bias_bwd, A_log_fwd, A_log_bwd, D_skip, norm_g):
    b, s, _ = zxbcdt.shape
    z = zxbcdt[..., :SSD_WIDTH]
    xbc = zxbcdt[..., SSD_WIDTH:SSD_WIDTH + SSD_CONV_DIM]
    dt_raw = zxbcdt[..., SSD_WIDTH + SSD_CONV_DIM:].astype(jnp.float32)
    xbc = lax.conv_general_dilated(
        xbc, conv_w[:, None, :], window_strides=(1,),
        padding=[(SSD_CONV // 2, SSD_CONV // 2)],
        dimension_numbers=("NWC", "WIO", "NWC"),
        feature_group_count=SSD_CONV_DIM) + conv_b
    xbc = jax.nn.silu(xbc)
    xs = xbc[..., :SSD_WIDTH].reshape(b, s, SSD_HEADS, SSD_HEAD_DIM)
    Bg = xbc[..., SSD_WIDTH:SSD_WIDTH + SSD_GROUPS * SSD_STATE].reshape(b, s, SSD_GROUPS, SSD_STATE)
    Cg = xbc[..., SSD_WIDTH + SSD_GROUPS * SSD_STATE:].reshape(b, s, SSD_GROUPS, SSD_STATE)
    dt_f = jax.nn.softplus(dt_raw[..., :SSD_HEADS] + dt_bias_fwd.astype(jnp.float32))
    dt_b = jax.nn.softplus(dt_raw[..., SSD_HEADS:] + dt_bias_bwd.astype(jnp.float32))
    A_f = -jnp.exp(A_log_fwd.astype(jnp.float32))
    A_b = -jnp.exp(A_log_bwd.astype(jnp.float32))
    flip = lambda t: jnp.flip(t, axis=1)
    y_f = ssd_chunked(xs, dt_f, A_f, Bg, Cg)
    y_b = flip(ssd_chunked(flip(xs), flip(dt_b), A_b, flip(Bg), flip(Cg)))
    y = y_f + y_b + D_skip.astype(jnp.float32)[:, None] * xs.astype(jnp.float32)
    y = y.reshape(b, s, SSD_WIDTH) * jax.nn.silu(z.astype(jnp.float32))
    y = rms_norm(y.reshape(b, s, SSD_GROUPS, SSD_WIDTH // SSD_GROUPS),
                 norm_g.reshape(SSD_GROUPS, SSD_WIDTH // SSD_GROUPS))
    return y.reshape(b, s, SSD_WIDTH).astype(zxbcdt.dtype)


def diff_attention(qkv, lambda_q1, lambda_k1, lambda_q2, lambda_k2, subln_g, lambda_init):
    b, s, _ = qkv.shape
    H, d = DIFF_HEADS, DIFF_HEAD_DIM
    q = qkv[..., :DIFF_WIDTH].reshape(b, s, H, 2, d)
    k = qkv[..., DIFF_WIDTH:2 * DIFF_WIDTH].reshape(b, s, H, 2, d)
    v = qkv[..., 2 * DIFF_WIDTH:].reshape(b, s, H, DIFF_V_DIM)
    cos, sin = rope_tables(s)
    q = partial_rope(q, cos, sin) * (d ** -0.5)
    k = partial_rope(k, cos, sin)
    f32 = jnp.float32
    lam = (jnp.exp(jnp.sum(lambda_q1.astype(f32) * lambda_k1.astype(f32)))
           - jnp.exp(jnp.sum(lambda_q2.astype(f32) * lambda_k2.astype(f32))) + lambda_init)
    qb = jnp.moveaxis(q.reshape(b, s // Q_BLOCK, Q_BLOCK, H, 2, d), 1, 0)

    def block(q_blk):
        sc = jnp.einsum("bqhtd,bkhtd->bhtqk", q_blk, k).astype(f32)
        pr = jax.nn.softmax(sc, axis=-1)
        a = pr[:, :, 0] - lam * pr[:, :, 1]
        return jnp.einsum("bhqk,bkhe->bqhe", a, v.astype(f32)).astype(v.dtype)

    o = lax.map(block, qb)
    o = jnp.moveaxis(o, 0, 1).reshape(b, s, H, DIFF_V_DIM)
    o = rms_norm(o, subln_g) * (1.0 - lambda_init)
    return o.reshape(b, s, DIFF_WIDTH).astype(qkv.dtype)


def memory_cross_attention(h, mem_h, w_q, w_kv, w_o):
    b, s, _ = h.shape
    m = mem_h.shape[1]
    q = (h @ w_q).reshape(b, s, XATTN_HEADS, XATTN_HEAD_DIM)
    kv = (mem_h @ w_kv).reshape(b, m, 2, XATTN_HEADS, XATTN_HEAD_DIM)
    k, v = kv[:, :, 0], kv[:, :, 1]
    sc = jnp.einsum("bqhd,bkhd->bhqk", q, k).astype(jnp.float32) * (XATTN_HEAD_DIM ** -0.5)
    pr = jax.nn.softmax(sc, axis=-1)
    o = jnp.einsum("bhqk,bkhd->bqhd", pr, v.astype(jnp.float32)).astype(h.dtype)
    return o.reshape(b, s, D_MODEL) @ w_o


def setup_inputs(seed: int = 0) -> dict:
    key = jax.random.key(seed)
    keys = iter(jax.random.split(key, 40))
    f32 = jnp.float32

    def normal(shape, scale):
        return jax.random.normal(next(keys), shape, dtype=f32) * scale

    def gain(shape):
        return 1.0 + normal(shape, 0.02)

    x = normal((BATCH, SEQ, D_MODEL), 1.0)
    mem = normal((BATCH, MEM_LEN, D_MODEL), 1.0)
    dt0_f = jnp.exp(jax.random.uniform(next(keys), (DEPTH, SSD_HEADS), minval=math.log(1e-3), maxval=math.log(1e-1)))
    dt0_b = jnp.exp(jax.random.uniform(next(keys), (DEPTH, SSD_HEADS), minval=math.log(1e-3), maxval=math.log(1e-1)))
    return {
        "x": x,
        "mem": mem,
        "ffn1_norm_g": gain((DEPTH, D_MODEL)),
        "ffn1_w_gate": normal((DEPTH, D_MODEL, D_FF), D_MODEL ** -0.5),
        "ffn1_w_up": normal((DEPTH, D_MODEL, D_FF), D_MODEL ** -0.5),
        "ffn1_w_down": normal((DEPTH, D_FF, D_MODEL), D_FF ** -0.5),
        "mix_norm_g": gain((DEPTH, D_MODEL)),
        "w_in": normal((DEPTH, D_MODEL, D_IN_PROJ), D_MODEL ** -0.5),
        "conv_w": normal((DEPTH, SSD_CONV, SSD_CONV_DIM), SSD_CONV ** -0.5),
        "conv_b": normal((DEPTH, SSD_CONV_DIM), 0.01),
        "dt_bias_fwd": dt0_f + jnp.log(-jnp.expm1(-dt0_f)),
        "dt_bias_bwd": dt0_b + jnp.log(-jnp.expm1(-dt0_b)),
        "A_log_fwd": jnp.log(jax.random.uniform(next(keys), (DEPTH, SSD_HEADS), minval=1.0, maxval=16.0)),
        "A_log_bwd": jnp.log(jax.random.uniform(next(keys), (DEPTH, SSD_HEADS), minval=1.0, maxval=16.0)),
        "D_skip": 1.0 + normal((DEPTH, SSD_HEADS), 0.1),
        "ssd_norm_g": gain((DEPTH, SSD_WIDTH)),
        "lambda_q1": normal((DEPTH, DIFF_HEAD_DIM), 0.1),
        "lambda_k1": normal((DEPTH, DIFF_HEAD_DIM), 0.1),
        "lambda_q2": normal((DEPTH, DIFF_HEAD_DIM), 0.1),
        "lambda_k2": normal((DEPTH, DIFF_HEAD_DIM), 0.1),
        "diff_subln_g": gain((DEPTH, DIFF_V_DIM)),
        "w_out": normal((DEPTH, D_MODEL, D_MODEL), D_MODEL ** -0.5),
        "xattn_norm_g": gain((DEPTH, D_MODEL)),
        "mem_norm_g": gain((DEPTH, D_MODEL)),
        "xattn_w_q": normal((DEPTH, D_MODEL, D_MODEL), D_MODEL ** -0.5),
        "xattn_w_kv": normal((DEPTH, D_MODEL, 2 * D_MODEL), D_MODEL ** -0.5),
        "xattn_w_o": normal((DEPTH, D_MODEL, D_MODEL), D_MODEL ** -0.5),
        "ffn2_norm_g": gain((DEPTH, D_MODEL)),
        "ffn2_w_gate": normal((DEPTH, D_MODEL, D_FF), D_MODEL ** -0.5),
        "ffn2_w_up": normal((DEPTH, D_MODEL, D_FF), D_MODEL ** -0.5),
        "ffn2_w_down": normal((DEPTH, D_FF, D_MODEL), D_FF ** -0.5),
        "final_norm_g": gain((D_MODEL,)),
    }


def reference(x, mem, ffn1_norm_g, ffn1_w_gate, ffn1_w_up, ffn1_w_down, mix_norm_g, w_in,
              conv_w, conv_b, dt_bias_fwd, dt_bias_bwd, A_log_fwd, A_log_bwd, D_skip, ssd_norm_g,
              lambda_q1, lambda_k1, lambda_q2, lambda_k2, diff_subln_g, w_out,
              xattn_norm_g, mem_norm_g, xattn_w_q, xattn_w_kv, xattn_w_o,
              ffn2_norm_g, ffn2_w_gate, ffn2_w_up, ffn2_w_down, final_norm_g):
    for layer in range(DEPTH):
        lambda_init = 0.8 - 0.6 * math.exp(-0.3 * layer)
        h = rms_norm(x, ffn1_norm_g[layer])
        x = x + 0.5 * swiglu(h, ffn1_w_gate[layer], ffn1_w_up[layer], ffn1_w_down[layer])
        h = rms_norm(x, mix_norm_g[layer])
        proj = h @ w_in[layer]
        y_ssd = ssd_mixer(proj[..., :IN_SSD], conv_w[layer], conv_b[layer],
                          dt_bias_fwd[layer], dt_bias_bwd[layer], A_log_fwd[layer], A_log_bwd[layer],
                          D_skip[layer], ssd_norm_g[layer])
        y_diff = diff_attention(proj[..., IN_SSD:], lambda_q1[layer], lambda_k1[layer],
                                lambda_q2[layer], lambda_k2[layer], diff_subln_g[layer], lambda_init)
        y_mix = jnp.concatenate([y_ssd.astype(x.dtype), y_diff.astype(x.dtype)], axis=-1)
        x = x + y_mix @ w_out[layer]
        h = rms_norm(x, xattn_norm_g[layer])
        m = rms_norm(mem, mem_norm_g[layer])
        x = x + memory_cross_attention(h, m, xattn_w_q[layer], xattn_w_kv[layer], xattn_w_o[layer])
        h = rms_norm(x, ffn2_norm_g[layer])
        x = x + 0.5 * swiglu(h, ffn2_w_gate[layer], ffn2_w_up[layer], ffn2_w_down[layer])
    return rms_norm(x, final_norm_g)
```

```cpp
#include <hip/hip_runtime.h>
#include <hip/hip_cooperative_groups.h>
#include <cstdio>
#include <cstdint>
namespace cg = cooperative_groups;
#ifndef MK_COOP
#define MK_COOP 0
#endif
namespace pg8 {
#define PG8_LAS __attribute__((address_space(3)))
typedef unsigned short bf16_t;
typedef short bf16x8 __attribute__((ext_vector_type(8)));
typedef float f32x4 __attribute__((ext_vector_type(4)));
typedef unsigned u32x4 __attribute__((ext_vector_type(4)));
constexpr int BM = 256, BK = 64, HALF = 128, HTB = HALF * BK * 2  , STAGE_BYTES = 8 * HTB, NXCD = 8, WGM = 8;

__host__ __device__ __forceinline__ int lds_byte(int r, int c) { const int st = (r >> 4) * 2 + (c >> 5), rr = r & 15, cc = c & 31, ob = rr * 64 + cc * 2; return st * 1024 + (ob ^ (((ob >> 9) & 1) << 5)); }
__host__ __device__ __forceinline__ void stage_rc(int b, int& R, int& C) { const int st = b / 1024, sb = b % 1024, swz = sb ^ (((sb >> 9) & 1) << 5); R = (st >> 1) * 16 + swz / 64; C = (st & 1) * 32 + (swz % 64) / 2; }
__host__ __device__ __forceinline__ int perm32(int rho) { const int n = rho >> 4, i = rho & 15; return 8 * (i >> 2) + 4 * n + (i & 3); }

struct Unit { int pm, pn; };
struct Gemm { const bf16_t* A; const bf16_t* Bt; int M, N, K; };

struct StaticOrder {
    int nM, nN, nwg, G, c;
    __host__ __device__ void init(int M, int N, int G_, int c_) { nM = M / BM; nN = N / BM; nwg = nM * nN; G = G_; c = c_; }
    __host__ __device__ bool next(int i, Unit& u) const {
        const long L = (long)i * G + c; if (L >= nwg) return false;
        int wgid = (int)L; { const int q = nwg / NXCD, r = nwg % NXCD, xcd = wgid % NXCD, off = wgid / NXCD; wgid = (xcd < r ? xcd * (q + 1) : r * (q + 1) + (xcd - r) * q) + off; }
        const int nig = WGM * nN, gid = wgid / nig, fm = gid * WGM, gsz = (nM - fm) < WGM ? (nM - fm) : WGM;
        u.pm = fm + ((wgid % nig) % gsz); u.pn = (wgid % nig) / gsz; return true;
    }
    __device__ __forceinline__ void a_ready(const Unit&) const {}
    __device__ __forceinline__ void done(const Unit&) const {}
};
__device__ __forceinline__ unsigned cvt_pk_bf16(float lo, float hi) { unsigned r; asm volatile("v_cvt_pk_bf16_f32 %0, %1, %2" : "=v"(r) : "v"(lo), "v"(hi)); return r; }
template <class Epi, class Sched, bool ALIGN_EPI = false, bool SP2 = false>
__device__ __forceinline__ void gemm_phase(PG8_LAS unsigned char* lds, const Gemm g, const Sched& S, const Epi& E) {
    int tid = threadIdx.x; asm volatile("" : "+v"(tid)); const int wid = __builtin_amdgcn_readfirstlane(tid >> 6), lane = tid & 63, wr = wid >> 2, wc = wid & 3, fr = lane & 15, fq = lane >> 4;
    const int K = g.K, nt = K / BK;
    unsigned voffA[2], voffB[2];
#pragma unroll
    for (int i = 0; i < 2; ++i) { int R, C; stage_rc(tid * 16 + i * 8192, R, C); const int Rb = Epi::PERM ? ((R & ~31) + perm32(R & 31)) : R;
        voffA[i] = (unsigned)(R * K + C) * 2u; voffB[i] = (unsigned)(Rb * K + C) * 2u; }
    const size_t kstep = (size_t)(BK * 2);
    const size_t hstep = (size_t)HALF * K * 2;
    const size_t tstep = 2 * hstep;
    const unsigned ldsw = (unsigned)wid * 1024u;
    const int aoff = lds_byte(wr * 64 + fr, fq * 8), boff = lds_byte(wc * 32 + fr, fq * 8);
#define PG8_SA(b, h) (((b) * 2 + (h)) * HTB)
#define PG8_SB(b, h) ((4 + (b) * 2 + (h)) * HTB)
#define PG8_STAGE(bufoff, gbase, voff) do { _Pragma("unroll") for (int _i = 0; _i < 2; ++_i) \
        __builtin_amdgcn_global_load_lds((const unsigned*)((const char*)(gbase) + (voff)[_i]), (PG8_LAS unsigned*)(lds + (bufoff) + ldsw + _i * 8192), 16, 0, 0); } while (0)
#define PG8_LDA(dst, b, h) do { _Pragma("unroll") for (int m = 0; m < 4; ++m) _Pragma("unroll") for (int k = 0; k < 2; ++k) dst[m][k] = *(const PG8_LAS bf16x8*)(lds + PG8_SA(b, h) + aoff + m * 2048 + k * 1024); } while (0)
#define PG8_LDB(dst, b, h) do { _Pragma("unroll") for (int n = 0; n < 2; ++n) _Pragma("unroll") for (int k = 0; k < 2; ++k) dst[n][k] = *(const PG8_LAS bf16x8*)(lds + PG8_SB(b, h) + boff + n * 2048 + k * 1024); } while (0)
#define PG8_MMA(ai, bj, At, Bt) do { __builtin_amdgcn_s_setprio(1); _Pragma("unroll") for (int m = 0; m < 4; ++m) _Pragma("unroll") for (int n = 0; n < 2; ++n) _Pragma("unroll") for (int k = 0; k < 2; ++k) \
        acc[ai][bj][m][n] = __builtin_amdgcn_mfma_f32_16x16x32_bf16(Bt[n][k], At[m][k], acc[ai][bj][m][n], 0, 0, 0); __builtin_amdgcn_s_setprio(0); } while (0)
#define PG8_WAIT_V(n) asm volatile("s_waitcnt vmcnt(" #n ")" ::: "memory")
#define PG8_WAIT_L(n) asm volatile("s_waitcnt lgkmcnt(" #n ")" ::: "memory")
#define PG8_BAR __builtin_amdgcn_s_barrier()
#define PG8_SCHED __builtin_amdgcn_sched_barrier(0)
    Unit cur, nxt; int ui = 0;
    if (!S.next(0, cur)) return;
    f32x4 acc[2][2][4][2];
#pragma unroll
    for (int a = 0; a < 2; ++a)
#pragma unroll
        for (int b = 0; b < 2; ++b)
#pragma unroll
            for (int m = 0; m < 4; ++m)
#pragma unroll
                for (int n = 0; n < 2; ++n) acc[a][b][m][n] = (f32x4){0.f, 0.f, 0.f, 0.f};
    bf16x8 At[4][2], B0[2][2], B1[2][2];
    const char* cA = (const char*)g.A + (size_t)cur.pm * tstep; const char* cB = (const char*)g.Bt + (size_t)cur.pn * tstep;
    S.a_ready(cur);
    if constexpr (SP2) {
        PG8_STAGE(PG8_SB(0, 0), cB, voffB); PG8_STAGE(PG8_SB(0, 1), cB + hstep, voffB); PG8_STAGE(PG8_SA(0, 0), cA, voffA); PG8_STAGE(PG8_SA(0, 1), cA + hstep, voffA);
        if (wr == 1) PG8_BAR;
        PG8_WAIT_V(2); PG8_BAR;
        PG8_STAGE(PG8_SB(1, 0), cB + kstep, voffB); PG8_STAGE(PG8_SA(1, 0), cA + kstep, voffA); PG8_STAGE(PG8_SB(1, 1), cB + hstep + kstep, voffB);
        PG8_WAIT_V(6); PG8_BAR;
    } else {
        PG8_STAGE(PG8_SB(0, 0), cB, voffB); PG8_STAGE(PG8_SA(0, 0), cA, voffA); PG8_STAGE(PG8_SB(0, 1), cB + hstep, voffB); PG8_STAGE(PG8_SA(0, 1), cA + hstep, voffA);
        if (wr == 1) PG8_BAR;
        PG8_WAIT_V(4); PG8_BAR;
        PG8_STAGE(PG8_SB(1, 0), cB + kstep, voffB); PG8_STAGE(PG8_SA(1, 0), cA + kstep, voffA); PG8_STAGE(PG8_SB(1, 1), cB + hstep + kstep, voffB);
        PG8_WAIT_V(6); PG8_BAR;
    }
    for (;;) {
        const bool has_next = S.next(ui + 1, nxt);
        const char* nA = has_next ? (const char*)g.A + (size_t)nxt.pm * tstep : cA; const char* nB = has_next ? (const char*)g.Bt + (size_t)nxt.pn * tstep : cB;
        for (int t = 0; t < nt; t += 2) {
            const bool last = (t == nt - 2);
            const char* a1 = cA + (size_t)(t + 1) * kstep;
            const char* a2 = last ? nA : cA + (size_t)(t + 2) * kstep; const char* b2 = last ? nB : cB + (size_t)(t + 2) * kstep;
            const char* a3 = a2 + kstep; const char* b3 = b2 + kstep;
            if (last && has_next) S.a_ready(nxt);
            if constexpr (SP2) {
            PG8_LDB(B0, 0, 0); PG8_LDB(B1, 0, 1); PG8_SCHED; PG8_LDA(At, 0, 0); PG8_STAGE(PG8_SA(1, 1), a1 + hstep, voffA);
            PG8_WAIT_V(8); PG8_WAIT_L(0); PG8_BAR; PG8_MMA(0, 0, At, B0); PG8_MMA(0, 1, At, B1); PG8_BAR; PG8_SCHED;
            PG8_LDA(At, 0, 1); PG8_STAGE(PG8_SB(0, 0), b2, voffB); PG8_STAGE(PG8_SB(0, 1), b2 + hstep, voffB); PG8_STAGE(PG8_SA(0, 0), a2, voffA);
            PG8_WAIT_V(8); PG8_WAIT_L(0); PG8_BAR; PG8_MMA(1, 0, At, B0); PG8_MMA(1, 1, At, B1); PG8_BAR; PG8_SCHED;
            PG8_LDB(B0, 1, 0); PG8_LDB(B1, 1, 1); PG8_SCHED; PG8_LDA(At, 1, 0); PG8_STAGE(PG8_SA(0, 1), a2 + hstep, voffA);
            PG8_WAIT_V(8); PG8_WAIT_L(0); PG8_BAR; PG8_MMA(0, 0, At, B0); PG8_MMA(0, 1, At, B1); PG8_BAR; PG8_SCHED;
            PG8_LDA(At, 1, 1); PG8_STAGE(PG8_SB(1, 0), b3, voffB); PG8_STAGE(PG8_SB(1, 1), b3 + hstep, voffB); PG8_STAGE(PG8_SA(1, 0), a3, voffA);
            PG8_WAIT_V(8); PG8_WAIT_L(0); PG8_BAR; PG8_MMA(1, 0, At, B0); PG8_MMA(1, 1, At, B1); PG8_BAR; PG8_SCHED;
            } else {
            PG8_LDB(B0, 0, 0); PG8_SCHED; PG8_LDA(At, 0, 0); PG8_STAGE(PG8_SA(1, 1), a1 + hstep, voffA);
            PG8_WAIT_L(8); PG8_BAR; PG8_WAIT_L(0); PG8_MMA(0, 0, At, B0); PG8_BAR; PG8_SCHED;
            PG8_LDB(B1, 0, 1); PG8_STAGE(PG8_SB(0, 0), b2, voffB);
            PG8_BAR; PG8_WAIT_L(0); PG8_MMA(0, 1, At, B1); PG8_BAR;
            PG8_LDA(At, 0, 1); PG8_STAGE(PG8_SA(0, 0), a2, voffA);
            PG8_BAR; PG8_WAIT_L(0); PG8_MMA(1, 0, At, B0); PG8_BAR; PG8_SCHED;
            PG8_STAGE(PG8_SB(0, 1), b2 + hstep, voffB);
            PG8_WAIT_V(6); PG8_BAR; PG8_MMA(1, 1, At, B1); PG8_BAR;
            PG8_LDB(B0, 1, 0); PG8_SCHED; PG8_LDA(At, 1, 0); PG8_STAGE(PG8_SA(0, 1), a2 + hstep, voffA);
            PG8_WAIT_L(8); PG8_BAR; PG8_WAIT_L(0); PG8_MMA(0, 0, At, B0); PG8_BAR; PG8_SCHED;
            PG8_LDB(B1, 1, 1); PG8_STAGE(PG8_SB(1, 0), b3, voffB);
            PG8_BAR; PG8_WAIT_L(0); PG8_MMA(0, 1, At, B1); PG8_BAR;
            PG8_LDA(At, 1, 1); PG8_STAGE(PG8_SA(1, 0), a3, voffA);
            PG8_BAR; PG8_WAIT_L(0); PG8_MMA(1, 0, At, B0); PG8_BAR; PG8_SCHED;
            PG8_STAGE(PG8_SB(1, 1), b3 + hstep, voffB);
            PG8_WAIT_V(6); PG8_BAR; PG8_MMA(1, 1, At, B1); PG8_BAR;
            }
        }
        if constexpr (ALIGN_EPI) { if (wr == 0) PG8_BAR; }
        if constexpr (!Epi::AFTER_DRAIN) { E(acc, cur, wr, wc, fr, fq); S.done(cur); }
        if (!has_next) break;
#pragma unroll
        for (int a = 0; a < 2; ++a)
#pragma unroll
            for (int b = 0; b < 2; ++b)
#pragma unroll
                for (int m = 0; m < 4; ++m)
#pragma unroll
                    for (int n = 0; n < 2; ++n) acc[a][b][m][n] = (f32x4){0.f, 0.f, 0.f, 0.f};
        cur = nxt; cA = nA; cB = nB; ++ui;
        if constexpr (ALIGN_EPI) { if (wr == 1) PG8_BAR; }
    }
    PG8_WAIT_V(0);
    if constexpr (!ALIGN_EPI) { if (wr == 0) PG8_BAR; }
    PG8_BAR;
    if constexpr (Epi::AFTER_DRAIN) { E.fused(acc, cur, wr, wc, fr, fq, lds, wid, lane); S.done(cur); }
#undef PG8_SA
#undef PG8_SB
#undef PG8_STAGE
#undef PG8_LDA
#undef PG8_LDB
#undef PG8_MMA
#undef PG8_WAIT_V
#undef PG8_WAIT_L
#undef PG8_BAR
#undef PG8_SCHED
}
}

#define LAS __attribute__((address_space(3)))
typedef unsigned char uchar;
typedef pg8::bf16_t bf16_t;
typedef pg8::bf16x8 bf16x8;
typedef pg8::f32x4 f32x4;
typedef pg8::u32x4 u32x4;
typedef unsigned u32x2 __attribute__((ext_vector_type(2)));
typedef float f32x2 __attribute__((ext_vector_type(2)));
typedef float f32x16 __attribute__((ext_vector_type(16)));
typedef __bf16 bf16x2_t __attribute__((ext_vector_type(2)));

constexpr int NB = 16, SEQ = 4096, T = NB * SEQ, DM = 1024, FF = 2816, MEML = 256, TM = NB * MEML;
constexpr int NPROJ = 3328, PLD = 3072;
constexpr int PC_Z = 0, PC_X = 512, PC_B = 1024, PC_C = 1280, PC_Q = 1536, PC_K = 2048, PC_V = 2560;
constexpr float EPS = 1e-5f, LOG2E = 1.4426950408889634f;
constexpr float LAMBDA_INIT = 0.2f;

constexpr size_t MiB = 1u << 20;
constexpr size_t WS_CTL = 0, WS_ROPE = 1 * MiB, WS_SS0 = 2 * MiB, WS_SS1 = 6 * MiB, WS_SS2 = 10 * MiB, WS_SS3 = 14 * MiB, WS_SS4 = 18 * MiB, WS_SSM = 22 * MiB,
                 WS_DT = 23 * MiB, WS_WGU1 = 27 * MiB, WS_WD1 = 38 * MiB, WS_WIN = 44 * MiB, WS_WOUT = 51 * MiB, WS_WQ = 53 * MiB, WS_WKV = 55 * MiB, WS_WO = 59 * MiB,
                 WS_WGU2 = 61 * MiB, WS_WD2 = 72 * MiB, WS_MEMB = 78 * MiB, WS_KVX = 86 * MiB, WS_VTX = 102 * MiB, WS_VT = 110 * MiB, WS_XB = 174 * MiB,
                 WS_YMIX = 302 * MiB, WS_YFB = 430 * MiB, WS_BIG = 558 * MiB, WS_END = 942 * MiB;
constexpr int LDS_BYTES = 147456, PTAB_OFF = LDS_BYTES - 512, LDS_PTAB_ABS = PTAB_OFF;

__device__ __forceinline__ const float* lds_inp(int k) {
    const LAS unsigned long long* ptab = (const LAS unsigned long long*)(uintptr_t)0; const unsigned long long v = *(const LAS unsigned long long*)((const LAS uchar*)ptab + LDS_PTAB_ABS + 8 * k);
    return (const float*)(((unsigned long long)(unsigned)__builtin_amdgcn_readfirstlane((int)(v >> 32)) << 32) | (unsigned long long)(unsigned)__builtin_amdgcn_readfirstlane((int)(v & 0xffffffffull)));
}
__device__ __forceinline__ int opaque_tid() { int t = threadIdx.x; asm volatile("" : "+v"(t)); return t; }
__device__ __forceinline__ unsigned cvtpk(float lo, float hi) { f32x2 v = {lo, hi}; bf16x2_t b = __builtin_convertvector(v, bf16x2_t); return __builtin_bit_cast(unsigned, b); }
__device__ __forceinline__ float bflo(unsigned w) { return __uint_as_float(w << 16); }
__device__ __forceinline__ float bfhi(unsigned w) { return __uint_as_float(w & 0xffff0000u); }
__device__ __forceinline__ float wave_sum(float v) {
#pragma unroll
    for (int o = 1; o < 64; o <<= 1) v += __shfl_xor(v, o);
    return v;
}
__device__ __forceinline__ float fast_exp2(float x) { return __builtin_amdgcn_exp2f(x); }
__device__ __forceinline__ float silu_f(float g) { return g * __builtin_amdgcn_rcpf(1.0f + fast_exp2(-LOG2E * g)); }
__device__ __forceinline__ float row_rs(const float* part, int row) {
    const f32x4* p = (const f32x4*)(part + (size_t)row * 16);
    const f32x4 a = p[0], b = p[1], c = p[2], d = p[3];
    const float s = (((a[0] + a[1]) + (a[2] + a[3])) + ((b[0] + b[1]) + (b[2] + b[3]))) + (((c[0] + c[1]) + (c[2] + c[3])) + ((d[0] + d[1]) + (d[2] + d[3])));
    return 1.0f / sqrtf(s * (1.0f / 1024.0f) + EPS);
}

struct EpiBf16RS {
    static constexpr bool PERM = true, AFTER_DRAIN = false;
    const float* part; float scale; bf16_t* O; int ldc;
    __device__ __forceinline__ void operator()(const f32x4 (&acc)[2][2][4][2], const pg8::Unit& u, int wr, int wc, int fr, int fq) const {
        const int row0 = u.pm * 256 + wr * 64 + fr, col0 = u.pn * 256 + wc * 32 + 8 * fq;
#pragma unroll
        for (int ai = 0; ai < 2; ++ai)
#pragma unroll
            for (int m = 0; m < 4; ++m) {
                const int row = row0 + ai * 128 + m * 16; const float rs = row_rs(part, row) * scale; bf16_t* rp = O + (size_t)row * ldc + col0;
#pragma unroll
                for (int bj = 0; bj < 2; ++bj) { const f32x4 v0 = acc[ai][bj][m][0] * rs, v1 = acc[ai][bj][m][1] * rs;
                    u32x4 w; w.x = cvtpk(v0[0], v0[1]); w.y = cvtpk(v0[2], v0[3]); w.z = cvtpk(v1[0], v1[1]); w.w = cvtpk(v1[2], v1[3]);
                    *(u32x4*)(rp + bj * 128) = w; }
                asm volatile("" ::: "memory");
            }
    }
};
struct EpiSwiGLU {
    static constexpr bool PERM = true, AFTER_DRAIN = false;
    const float* part; bf16_t* U;
    __device__ __forceinline__ void operator()(const f32x4 (&acc)[2][2][4][2], const pg8::Unit& u, int wr, int wc, int fr, int fq) const {
        const int row0 = u.pm * 256 + wr * 64 + fr, col0 = u.pn * 128 + wc * 32 + 8 * fq;
#pragma unroll
        for (int ai = 0; ai < 2; ++ai)
#pragma unroll
            for (int m = 0; m < 4; ++m) {
                const int row = row0 + ai * 128 + m * 16; const float rs = row_rs(part, row);
                float h[8];
#pragma unroll
                for (int n = 0; n < 2; ++n)
#pragma unroll
                    for (int e = 0; e < 4; ++e) { const float g = acc[ai][0][m][n][e] * rs, up = acc[ai][1][m][n][e] * rs; h[4 * n + e] = silu_f(g) * up; }
                u32x4 w; w.x = cvtpk(h[0], h[1]); w.y = cvtpk(h[2], h[3]); w.z = cvtpk(h[4], h[5]); w.w = cvtpk(h[6], h[7]);
                *(u32x4*)(U + (size_t)row * FF + col0) = w;
                asm volatile("" ::: "memory");
            }
    }
};
struct EpiResidual {
    static constexpr bool PERM = true, AFTER_DRAIN = false;
    const float* res; float alpha; float* out; bf16_t* xb; float* part;
    __device__ __forceinline__ void operator()(const f32x4 (&acc)[2][2][4][2], const pg8::Unit& u, int wr, int wc, int fr, int fq) const {
        const int row0 = u.pm * 256 + wr * 64 + fr, col0 = u.pn * 256 + wc * 32 + 8 * fq;
#pragma unroll
        for (int ai = 0; ai < 2; ++ai)
#pragma unroll
            for (int m = 0; m < 4; ++m) {
                const int row = row0 + ai * 128 + m * 16; float ss = 0.f;
#pragma unroll
                for (int bj = 0; bj < 2; ++bj) { const size_t off = (size_t)row * DM + col0 + bj * 128;
                    const f32x4 r0 = *(const f32x4*)(res + off), r1 = *(const f32x4*)(res + off + 4);
                    const f32x4 v0 = r0 + acc[ai][bj][m][0] * alpha, v1 = r1 + acc[ai][bj][m][1] * alpha;
                    *(f32x4*)(out + off) = v0; *(f32x4*)(out + off + 4) = v1;
                    if (xb) { u32x4 w; w.x = cvtpk(v0[0], v0[1]); w.y = cvtpk(v0[2], v0[3]); w.z = cvtpk(v1[0], v1[1]); w.w = cvtpk(v1[2], v1[3]); *(u32x4*)(xb + off) = w; }
                    ss += ((v0[0] * v0[0] + v0[1] * v0[1]) + (v0[2] * v0[2] + v0[3] * v0[3])) + ((v1[0] * v1[0] + v1[1] * v1[1]) + (v1[2] * v1[2] + v1[3] * v1[3])); }
                ss += __shfl_xor(ss, 16); ss += __shfl_xor(ss, 32);
                if (fq == 0) part[(size_t)row * 16 + u.pn * 4 + wc] = ss;
                asm volatile("" ::: "memory");
            }
    }
};
struct EpiProj {
    static constexpr bool PERM = true, AFTER_DRAIN = false;
    const float* part; bf16_t* P; float* DT; const float* cs; const float* sn; const float* dtb_f; const float* dtb_b;
    __device__ __forceinline__ void operator()(const f32x4 (&acc)[2][2][4][2], const pg8::Unit& u, int wr, int wc, int fr, int fq) const {
        const int pn = u.pn; const int row0 = u.pm * 256 + wr * 64 + fr;
        if (pn == 12) {
            if (wc == 0 && fq < 2) {
                const float* bias = (fq == 0) ? dtb_f : dtb_b;
#pragma unroll
                for (int ai = 0; ai < 2; ++ai)
#pragma unroll
                    for (int m = 0; m < 4; ++m) { const int row = row0 + ai * 128 + m * 16; const float rs = row_rs(part, row);
#pragma unroll
                        for (int n = 0; n < 2; ++n) { f32x4 o;
#pragma unroll
                            for (int e = 0; e < 4; ++e) { const float x = acc[ai][0][m][n][e] * rs + bias[4 * n + e]; o[e] = x > 20.f ? x : log1pf(__expf(x)); }
                            *(f32x4*)(DT + (size_t)row * 16 + 8 * fq + 4 * n) = o; } asm volatile("" ::: "memory"); }
            }
            return;
        }
        const bool isq = (pn == 6 || pn == 7), isk = (pn == 8 || pn == 9), rope = (isq || isk) && ((wc & 1) == 0);
        const float qs = isq ? 0.125f * LOG2E : 1.0f; const float sgn = (fq == 0) ? -1.f : 1.f;
        const int col0 = pn * 256 + wc * 32 + 8 * fq;
#pragma unroll
        for (int ai = 0; ai < 2; ++ai)
#pragma unroll
            for (int m = 0; m < 4; ++m) {
                const int row = row0 + ai * 128 + m * 16; const float rs = row_rs(part, row) * qs; const int pos = row & (SEQ - 1);
                bf16_t* rp = P + (size_t)row * PLD + col0;
#pragma unroll
                for (int bj = 0; bj < 2; ++bj) { f32x4 v0 = acc[ai][bj][m][0], v1 = acc[ai][bj][m][1];
                    if (rope) { f32x4 p0, p1;
#pragma unroll
                        for (int e = 0; e < 4; ++e) { p0[e] = __shfl_xor(v0[e], 16); p1[e] = __shfl_xor(v1[e], 16); }
                        if (fq < 2) { const f32x4 c0 = *(const f32x4*)(cs + pos * 8), c1 = *(const f32x4*)(cs + pos * 8 + 4), s0 = *(const f32x4*)(sn + pos * 8), s1 = *(const f32x4*)(sn + pos * 8 + 4);
                            v0 = v0 * c0 + p0 * s0 * sgn; v1 = v1 * c1 + p1 * s1 * sgn; } }
                    v0 = v0 * rs; v1 = v1 * rs;
                    u32x4 w; w.x = cvtpk(v0[0], v0[1]); w.y = cvtpk(v0[2], v0[3]); w.z = cvtpk(v1[0], v1[1]); w.w = cvtpk(v1[2], v1[3]);
                    *(u32x4*)(rp + bj * 128) = w; }
                asm volatile("" ::: "memory");
            }
    }
};
struct EpiAny {
    static constexpr bool PERM = true, AFTER_DRAIN = false;
    int kind; unsigned char* ws; float scale; unsigned part_off, o_off, xb_off, opart_off; int ldc, res_is_x; float* out;
    __device__ __forceinline__ void operator()(const f32x4 (&acc)[2][2][4][2], const pg8::Unit& u, int wr, int wc, int fr, int fq) const {
        if (kind == 0) { EpiBf16RS e{(const float*)(ws + part_off), scale, (bf16_t*)(ws + o_off), ldc}; e(acc, u, wr, wc, fr, fq); }
        else if (kind == 1) { EpiSwiGLU e{(const float*)(ws + part_off), (bf16_t*)(ws + o_off)}; e(acc, u, wr, wc, fr, fq); }
        else if (kind == 2) { const float* res = res_is_x ? lds_inp(0) : out; EpiResidual e{res, scale, out, xb_off ? (bf16_t*)(ws + xb_off) : nullptr, (float*)(ws + opart_off)}; e(acc, u, wr, wc, fr, fq); }
        else { EpiProj e{(const float*)(ws + part_off), (bf16_t*)(ws + o_off), (float*)(ws + WS_DT), (const float*)(ws + WS_ROPE), (const float*)(ws + WS_ROPE) + SEQ * 8, lds_inp(10), lds_inp(11)}; e(acc, u, wr, wc, fr, fq); }
    }
};
struct GJob { const bf16_t* A; const bf16_t* Bt; int M, N, K; EpiAny E; };
template <class Epi> __device__ __forceinline__ void run_gemm(LAS uchar* lds, const bf16_t* A, const bf16_t* Bt, int M, int N, int K, const Epi& E) {
    pg8::Gemm g{A, Bt, M, N, K}; pg8::StaticOrder S; S.init(M, N, (int)gridDim.x, (int)blockIdx.x);
    pg8::gemm_phase<Epi, pg8::StaticOrder, true, true>(lds, g, S, E);
}

__device__ __forceinline__ int map_row(int kind, int n) {
    if (kind == 1) return (n >> 7) * 256 + (n & 127);
    if (kind == 2) return (n >> 7) * 256 + 128 + (n & 127);
    if (kind == 3) return n < 1536 ? n : (n < 1552 ? 3072 + (n - 1536) : n - 16);
    return n;
}
__device__ __forceinline__ void p0_transpose_item(const float* W, int K, int N, bf16_t* WT, int kind, const float* g, LAS float* scr, int item, int lane) {
    const int nblk = (N + 31) >> 5, kb = item / nblk, nb = item - kb * nblk, k0 = 64 * kb, n0 = 32 * nb;
    const int ncol = n0 + (lane & 31); const bool valid = ncol < N;
#pragma unroll 8
    for (int i = 0; i < 32; ++i) { const int kk = 2 * i + (lane >> 5); float v = valid ? W[(size_t)(k0 + kk) * N + ncol] : 0.f; if (g) v *= g[k0 + kk]; scr[kk * 33 + (lane & 31)] = v; }
    asm volatile("s_waitcnt lgkmcnt(0)" ::: "memory");
    const int c = lane & 7;
#pragma unroll
    for (int j = 0; j < 4; ++j) { const int n = (lane >> 3) + 8 * j; const LAS float* s = scr + (8 * c) * 33 + n;
        if (n0 + n < N) { u32x4 o; o.x = cvtpk(s[0 * 33], s[1 * 33]); o.y = cvtpk(s[2 * 33], s[3 * 33]); o.z = cvtpk(s[4 * 33], s[5 * 33]); o.w = cvtpk(s[6 * 33], s[7 * 33]);
            *(u32x4*)(WT + (size_t)map_row(kind, n0 + n) * K + k0 + 8 * c) = o; } }
    asm volatile("s_waitcnt lgkmcnt(0)" ::: "memory");
}
__device__ __forceinline__ void row_to_bf16_ss(const float* xrow, bf16_t* orow, float* part, int lane) {
    f32x4 v[4]; float s = 0.f;
#pragma unroll
    for (int j = 0; j < 4; ++j) { v[j] = ((const f32x4*)xrow)[lane + 64 * j]; s += (v[j][0] * v[j][0] + v[j][1] * v[j][1]) + (v[j][2] * v[j][2] + v[j][3] * v[j][3]); }
    s = wave_sum(s);
#pragma unroll
    for (int j = 0; j < 4; ++j) { u32x2 w; w.x = cvtpk(v[j][0], v[j][1]); w.y = cvtpk(v[j][2], v[j][3]); ((u32x2*)orow)[lane + 64 * j] = w; }
    if (lane < 16) part[lane] = (lane == 0) ? s : 0.f;
}
__device__ __forceinline__ void rope_entry(int idx, float* cs, float* sn) {
    const int pos = idx >> 3, i = idx & 7;
    const float invf = (i == 0) ? 1.0f : (i == 1) ? 0.193922758102417f : (i == 2) ? 0.03760603070259094f : (i == 3) ? 0.00729266507551074f : (i == 4) ? 0.001414213445968926f
                     : (i == 5) ? 0.00027424818836152554f : (i == 6) ? 5.318296462064609e-05f : 1.0313385246263351e-05f;
    const float angf = (float)pos * invf;
    const double x = (double)angf; const double kq = rint(x * 0.6366197723675814);
    double r = fma(-kq, 1.5707963267948966, x); r = fma(-kq, 6.123233995736766e-17, r);
    const int q = ((int)kq) & 3; const double r2 = r * r;
    const double s = r * (1.0 + r2 * (-1.0 / 6 + r2 * (1.0 / 120 + r2 * (-1.0 / 5040 + r2 * (1.0 / 362880 + r2 * (-1.0 / 39916800 + r2 * (1.0 / 6227020800.0)))))));
    const double c = 1.0 + r2 * (-0.5 + r2 * (1.0 / 24 + r2 * (-1.0 / 720 + r2 * (1.0 / 40320 + r2 * (-1.0 / 3628800 + r2 * (1.0 / 479001600.0 + r2 * (-1.0 / 87178291200.0)))))));
    const double co = (q == 0) ? c : (q == 1) ? -s : (q == 2) ? -c : s;
    const double si = (q == 0) ? s : (q == 1) ? c : (q == 2) ? -s : -c;
    cs[idx] = (float)co; sn[idx] = (float)si;
}

__device__ __forceinline__ void transpose64(const bf16_t* src, int sp, bf16_t* dst, int dp, LAS uchar* scr, int lane) {
#pragma unroll
    for (int i = 0; i < 8; ++i) { const int r = i * 8 + (lane >> 3), c8 = lane & 7; const u32x4 v = *(const u32x4*)(src + (size_t)r * sp + c8 * 8);
        LAS unsigned* w = (LAS unsigned*)(scr + r * 132 + c8 * 16); w[0] = v.x; w[1] = v.y; w[2] = v.z; w[3] = v.w; }
    asm volatile("s_waitcnt lgkmcnt(0)" ::: "memory");
#pragma unroll
    for (int i = 0; i < 8; ++i) { const int c = i * 8 + (lane >> 3), r8 = lane & 7; unsigned e[8];
#pragma unroll
        for (int j = 0; j < 8; ++j) e[j] = *(const LAS unsigned short*)(scr + (r8 * 8 + j) * 132 + c * 2);
        u32x4 o; o.x = e[0] | (e[1] << 16); o.y = e[2] | (e[3] << 16); o.z = e[4] | (e[5] << 16); o.w = e[6] | (e[7] << 16);
        *(u32x4*)(dst + (size_t)c * dp + r8 * 8) = o; }
    asm volatile("s_waitcnt lgkmcnt(0)" ::: "memory");
}
__device__ __forceinline__ void conv_phase(const bf16_t* P, const float* cw, const float* cb, bf16_t* XC, int gtid, int nthr) {
    for (int it = gtid; it < (T / 16) * 128; it += nthr) {
        const int cg8 = it & 127, run = it >> 7, tok0 = run * 16, s0 = tok0 & (SEQ - 1), ch = cg8 * 8;
        float w[5][8], bias[8];
#pragma unroll
        for (int k = 0; k < 5; ++k) { const f32x4 a = *(const f32x4*)(cw + k * 1024 + ch), b = *(const f32x4*)(cw + k * 1024 + ch + 4);
#pragma unroll
            for (int e = 0; e < 4; ++e) { w[k][e] = a[e]; w[k][4 + e] = b[e]; } }
        { const f32x4 a = *(const f32x4*)(cb + ch), b = *(const f32x4*)(cb + ch + 4);
#pragma unroll
          for (int e = 0; e < 4; ++e) { bias[e] = a[e]; bias[4 + e] = b[e]; } }
        const bf16_t* src = P + (size_t)tok0 * PLD + PC_X + ch;
        float win[5][8];
#pragma unroll
        for (int j = 0; j < 4; ++j) { const int s = s0 + j - 2; u32x4 v = {0u, 0u, 0u, 0u}; if (s >= 0 && s < SEQ) v = *(const u32x4*)(src + (ptrdiff_t)(j - 2) * PLD);
            win[j][0] = bflo(v.x); win[j][1] = bfhi(v.x); win[j][2] = bflo(v.y); win[j][3] = bfhi(v.y); win[j][4] = bflo(v.z); win[j][5] = bfhi(v.z); win[j][6] = bflo(v.w); win[j][7] = bfhi(v.w); }
#pragma unroll
        for (int i = 0; i < 16; ++i) {
            { const int s = s0 + i + 2; u32x4 v = {0u, 0u, 0u, 0u}; if (s < SEQ) v = *(const u32x4*)(src + (ptrdiff_t)(i + 2) * PLD);
              float* d = win[(i + 4) % 5];
              d[0] = bflo(v.x); d[1] = bfhi(v.x); d[2] = bflo(v.y); d[3] = bfhi(v.y); d[4] = bflo(v.z); d[5] = bfhi(v.z); d[6] = bflo(v.w); d[7] = bfhi(v.w); }
            float o[8];
#pragma unroll
            for (int e = 0; e < 8; ++e) { float a = bias[e];
#pragma unroll
                for (int k = 0; k < 5; ++k) a += w[k][e] * win[(i + k) % 5][e];
                o[e] = silu_f(a); }
            u32x4 ov; ov.x = cvtpk(o[0], o[1]); ov.y = cvtpk(o[2], o[3]); ov.z = cvtpk(o[4], o[5]); ov.w = cvtpk(o[6], o[7]);
            *(u32x4*)(XC + (size_t)(tok0 + i) * 1024 + ch) = ov;
        }
    }
}

__device__ __forceinline__ float dpp_sum8(float v) {
    v += __builtin_bit_cast(float, __builtin_amdgcn_update_dpp(0, __builtin_bit_cast(int, v), 0xB1, 0xF, 0xF, true));
    v += __builtin_bit_cast(float, __builtin_amdgcn_update_dpp(0, __builtin_bit_cast(int, v), 0x4E, 0xF, 0xF, true));
    v += __builtin_bit_cast(float, __builtin_amdgcn_update_dpp(0, __builtin_bit_cast(int, v), 0x141, 0xF, 0xF, true));
    return v;
}
__device__ __forceinline__ void ssd_item(LAS uchar* lds, int b, int h, int dir, const bf16_t* XC, const float* DT, float Aneg, bf16_t* Y) {
    const int tid = opaque_tid(), p = tid >> 3, nq = tid & 7, g = h >> 2;
    LAS float* sB = (LAS float*)lds;
    LAS float* sC = sB + 64 * 128;
    LAS float* sX = sC + 64 * 128;
    LAS float* sY = sX + 64 * 64;
    LAS float* sDt = sY + 64 * 64;
    LAS float* sE = sDt + 64;
    float st[16];
#pragma unroll
    for (int k = 0; k < 16; ++k) st[k] = 0.f;
    u32x4 rb[2], rc[2], rx; float rdt = 0.f;
    const size_t tokb = (size_t)b * SEQ;
#define SSD_LOAD(blk) do { const int t0_ = dir ? (SEQ - 64 - (blk) * 64) : (blk) * 64; \
        _Pragma("unroll") for (int i_ = 0; i_ < 2; ++i_) { const int id_ = tid + 512 * i_, r_ = id_ >> 4, c_ = id_ & 15; const bf16_t* s_ = XC + (tokb + t0_ + r_) * 1024 + 512 + g * 128 + c_ * 8; \
            rb[i_] = *(const u32x4*)s_; rc[i_] = *(const u32x4*)(s_ + 256); } \
        { const int r_ = tid >> 3, c_ = tid & 7; rx = *(const u32x4*)(XC + (tokb + t0_ + r_) * 1024 + h * 64 + c_ * 8); } \
        if (tid < 64) rdt = DT[(tokb + t0_ + tid) * 16 + dir * 8 + h]; } while (0)
#define SSD_ST8(dst, v) do { f32x4 a_, b_; a_[0] = bflo((v).x); a_[1] = bfhi((v).x); a_[2] = bflo((v).y); a_[3] = bfhi((v).y); b_[0] = bflo((v).z); b_[1] = bfhi((v).z); b_[2] = bflo((v).w); b_[3] = bfhi((v).w); \
        *(LAS f32x4*)(dst) = a_; *(LAS f32x4*)((dst) + 4) = b_; } while (0)
#define SSD_STORE() do { \
        _Pragma("unroll") for (int i_ = 0; i_ < 2; ++i_) { const int id_ = tid + 512 * i_, r_ = id_ >> 4, c_ = id_ & 15; SSD_ST8(sB + r_ * 128 + c_ * 8, rb[i_]); SSD_ST8(sC + r_ * 128 + c_ * 8, rc[i_]); } \
        { const int r_ = tid >> 3, c_ = tid & 7; SSD_ST8(sX + r_ * 64 + c_ * 8, rx); } \
        if (tid < 64) { sDt[tid] = rdt; sE[tid] = __expf(rdt * Aneg); } } while (0)
    SSD_LOAD(0); SSD_STORE();
    __syncthreads();
    for (int blk = 0; blk < SEQ / 64; ++blk) {
        if (blk + 1 < SEQ / 64) SSD_LOAD(blk + 1);
        for (int j = 0; j < 64; ++j) {
            const int i = dir ? 63 - j : j;
            const float e = sE[i], xdt = sX[i * 64 + p] * sDt[i];
            const LAS f32x4* bp = (const LAS f32x4*)(sB + i * 128 + nq * 16); const LAS f32x4* cp = (const LAS f32x4*)(sC + i * 128 + nq * 16);
            float acc = 0.f;
#pragma unroll
            for (int q = 0; q < 4; ++q) { const f32x4 bv = bp[q], cv = cp[q];
#pragma unroll
                for (int k = 0; k < 4; ++k) { st[4 * q + k] = st[4 * q + k] * e + xdt * bv[k]; acc += cv[k] * st[4 * q + k]; } }
            acc = dpp_sum8(acc);
            if (nq == 0) sY[i * 64 + p] = acc;
        }
        __syncthreads();
        { const int t0 = dir ? (SEQ - 64 - blk * 64) : blk * 64; const int r = tid >> 3, c = tid & 7; const LAS f32x4* yp = (const LAS f32x4*)(sY + r * 64 + c * 8); const f32x4 a = yp[0], bq = yp[1];
          u32x4 w; w.x = cvtpk(a[0], a[1]); w.y = cvtpk(a[2], a[3]); w.z = cvtpk(bq[0], bq[1]); w.w = cvtpk(bq[2], bq[3]);
          *(u32x4*)(Y + (tokb + t0 + r) * 512 + h * 64 + c * 8) = w; }
        if (blk + 1 < SEQ / 64) SSD_STORE();
        __syncthreads();
    }
#undef SSD_LOAD
#undef SSD_ST8
#undef SSD_STORE
}

__device__ __forceinline__ int crow(int r, int hi) { return (r & 3) + 8 * (r >> 2) + 4 * hi; }
#define MFMA32(a, b, c) __builtin_amdgcn_mfma_f32_32x32x16_bf16((a), (b), (c), 0, 0, 0)
template <int DQK, int KW, int DVT, int NT, int MODE, bool PIPE>
__device__ __forceinline__ void attn_item(LAS uchar* lds, const bf16_t* qptr, int qpitch, const bf16_t* kptr, int kpitch, int kwcol, const bf16_t* vtptr, int vtpitch, int vrow,
                                          bf16_t* outp, int opitch, float lam, const float* subg) {
    constexpr int KROW = KW * 2 + 16, KBUF = 64 * KROW, VROW = 136, VBUF = DVT * VROW, NKP = 64 * (KW / 8) / 512, NVP = DVT * 8 / 512, NS = DQK / 16;
    static_assert(2 * KBUF + 2 * VBUF <= PTAB_OFF && 128 * 256 * 4 + 1024 <= PTAB_OFF, "attention LDS");
    const int tid = opaque_tid(), lane = tid & 63, wid = __builtin_amdgcn_readfirstlane(tid >> 6), qg = wid >> 1, t = wid & 1, l31 = lane & 31, hi = lane >> 5;
    bf16x8 qf[NS];
    { const bf16_t* qr = qptr + (size_t)(qg * 32 + l31) * qpitch + 8 * hi;
#pragma unroll
      for (int s = 0; s < NS; ++s) qf[s] = *(const bf16x8*)(qr + 16 * s); }
    f32x16 o[4];
#pragma unroll
    for (int d = 0; d < 4; ++d)
#pragma unroll
        for (int r = 0; r < 16; ++r) o[d][r] = 0.f;
    float m = -1e30f, l = 0.f;
    u32x4 kst[NKP], vst[NVP];
#define AT_LOAD(tile) do { \
        _Pragma("unroll") for (int i_ = 0; i_ < NKP; ++i_) { const int id_ = tid + 512 * i_, r_ = id_ / (KW / 8), c_ = id_ % (KW / 8); kst[i_] = *(const u32x4*)(kptr + (size_t)((tile) * 64 + r_) * kpitch + c_ * 8); } \
        _Pragma("unroll") for (int i_ = 0; i_ < NVP; ++i_) { const int id_ = tid + 512 * i_, r_ = id_ >> 3, c_ = id_ & 7; vst[i_] = *(const u32x4*)(vtptr + (size_t)r_ * vtpitch + (tile) * 64 + c_ * 8); } } while (0)
#define AT_STORE(buf) do { \
        _Pragma("unroll") for (int i_ = 0; i_ < NKP; ++i_) { const int id_ = tid + 512 * i_, r_ = id_ / (KW / 8), c_ = id_ % (KW / 8); *(LAS u32x4*)(lds + (buf) * KBUF + r_ * KROW + c_ * 16) = kst[i_]; } \
        _Pragma("unroll") for (int i_ = 0; i_ < NVP; ++i_) { const int id_ = tid + 512 * i_, r_ = id_ >> 3, c_ = id_ & 7; LAS u32x2* d_ = (LAS u32x2*)(lds + 2 * KBUF + (buf) * VBUF + r_ * VROW + c_ * 16); \
            d_[0] = (u32x2){vst[i_].x, vst[i_].y}; d_[1] = (u32x2){vst[i_].z, vst[i_].w}; } } while (0)
    if (PIPE) { AT_LOAD(0); AT_STORE(0); __syncthreads(); }
    for (int tile = 0; tile < NT; ++tile) {
        if (PIPE) { if (tile + 1 < NT) AT_LOAD(tile + 1); }
        else { AT_LOAD(tile); AT_STORE(tile & 1); __syncthreads(); }
        const LAS uchar* kb = lds + (tile & 1) * KBUF; const LAS uchar* vb = lds + 2 * KBUF + (tile & 1) * VBUF;
        f32x16 s0, s1;
#pragma unroll
        for (int r = 0; r < 16; ++r) { s0[r] = 0.f; s1[r] = 0.f; }
        { const LAS uchar* ka = kb + l31 * KROW + (kwcol + 8 * hi) * 2;
#pragma unroll
          for (int s = 0; s < NS; ++s) { const bf16x8 a0 = *(const LAS bf16x8*)(ka + 32 * s), a1 = *(const LAS bf16x8*)(ka + 32 * KROW + 32 * s);
              s0 = MFMA32(a0, qf[s], s0); s1 = MFMA32(a1, qf[s], s1); } }
        float mx = fmaxf(s0[0], s1[0]);
#pragma unroll
        for (int r = 1; r < 16; ++r) mx = fmaxf(mx, fmaxf(s0[r], s1[r]));
        mx = fmaxf(mx, __shfl_xor(mx, 32));
        const float mnew = fmaxf(m, mx); const float alpha = fast_exp2(m - mnew);
        if (__any(mnew > m)) {
#pragma unroll
            for (int r = 0; r < 16; ++r) { const float ar = __shfl(alpha, crow(r, hi));
#pragma unroll
                for (int d = 0; d < 4; ++d) o[d][r] *= ar; }
        }
        m = mnew; float ps = 0.f;
#pragma unroll
        for (int r = 0; r < 16; ++r) { s0[r] = fast_exp2(s0[r] - m); s1[r] = fast_exp2(s1[r] - m); ps += s0[r] + s1[r]; }
        l = l * alpha + ps;
#pragma unroll
        for (int kt = 0; kt < 2; ++kt)
#pragma unroll
            for (int j = 0; j < 2; ++j) {
                u32x4 pw;
                if (kt == 0) { pw.x = cvtpk(s0[8 * j], s0[8 * j + 1]); pw.y = cvtpk(s0[8 * j + 2], s0[8 * j + 3]); pw.z = cvtpk(s0[8 * j + 4], s0[8 * j + 5]); pw.w = cvtpk(s0[8 * j + 6], s0[8 * j + 7]); }
                else         { pw.x = cvtpk(s1[8 * j], s1[8 * j + 1]); pw.y = cvtpk(s1[8 * j + 2], s1[8 * j + 3]); pw.z = cvtpk(s1[8 * j + 4], s1[8 * j + 5]); pw.w = cvtpk(s1[8 * j + 6], s1[8 * j + 7]); }
                const bf16x8 pa = __builtin_bit_cast(bf16x8, pw);
#pragma unroll
                for (int d = 0; d < 4; ++d) { const LAS uchar* va = vb + (vrow + 32 * d + l31) * VROW + (32 * kt + 16 * j + 4 * hi) * 2;
                    const u32x2 lo = *(const LAS u32x2*)va, hh = *(const LAS u32x2*)(va + 16);
                    u32x4 vw; vw.x = lo.x; vw.y = lo.y; vw.z = hh.x; vw.w = hh.y;
                    o[d] = MFMA32(pa, __builtin_bit_cast(bf16x8, vw), o[d]); }
            }
        if (PIPE) { if (tile + 1 < NT) AT_STORE((tile + 1) & 1); __syncthreads(); }
    }
    if (!PIPE) __syncthreads();
#undef AT_LOAD
#undef AT_STORE
    l += __shfl_xor(l, 32);
    LAS float* ex = (LAS float*)lds; LAS float* lsum = (LAS float*)(lds + 128 * 256 * 4);
#pragma unroll
    for (int d = 0; d < 4; ++d)
#pragma unroll
        for (int r = 0; r < 16; ++r) ex[(qg * 32 + crow(r, hi)) * 256 + t * 128 + 32 * d + l31] = o[d][r];
    if (hi == 0) lsum[t * 128 + qg * 32 + l31] = l;
    __syncthreads();
    for (int rr = 0; rr < 16; ++rr) {
        const int q = wid * 16 + rr;
        if (MODE == 0) {
            const float i1 = 1.0f / lsum[q], i2 = lam / lsum[128 + q];
            const f32x2 o1 = ((const LAS f32x2*)(ex + q * 256))[lane], o2 = ((const LAS f32x2*)(ex + q * 256 + 128))[lane];
            const float a = o1.x * i1 - o2.x * i2, bq = o1.y * i1 - o2.y * i2;
            const float ss = wave_sum(a * a + bq * bq); const float rn = (1.0f - LAMBDA_INIT) / sqrtf(ss * (1.0f / 128.0f) + EPS);
            *(unsigned*)(outp + (size_t)q * opitch + 2 * lane) = cvtpk(a * rn * subg[2 * lane], bq * rn * subg[2 * lane + 1]);
        } else {
            const float inv = 1.0f / lsum[q]; const f32x4 v = ((const LAS f32x4*)(ex + q * 256))[lane];
            u32x2 w; w.x = cvtpk(v[0] * inv, v[1] * inv); w.y = cvtpk(v[2] * inv, v[3] * inv);
            *(u32x2*)(outp + (size_t)q * opitch + 4 * lane) = w;
        }
    }
    __syncthreads();
}

#ifndef PHASE_MASK
#define PHASE_MASK 0xFFFF
#endif
#define PH_ON(k) ((PHASE_MASK >> (k)) & 1)
#define PH_IDS const int tid = opaque_tid(), lane = tid & 63, wave = __builtin_amdgcn_readfirstlane(tid >> 6), gw = bx * 8 + wave, gtid = bx * 512 + tid; (void)lane; (void)gw; (void)gtid; (void)wave
struct Args { const float* in[32]; float* out; unsigned char* ws; int ph_lo, ph_hi; };
constexpr int N_PHASES = 14;

__global__ void __launch_bounds__(512, 2) mega_fwd(Args a) {
    extern __shared__ __attribute__((aligned(16))) unsigned char lds_raw[];
    LAS uchar* lds = (LAS uchar*)lds_raw;
    const int G = (int)gridDim.x, bx = (int)blockIdx.x, NGW = G * 8, NTHR = G * 512;
    LAS unsigned long long* ptab = (LAS unsigned long long*)(lds + PTAB_OFF);
    if (threadIdx.x < 32) ptab[threadIdx.x] = (unsigned long long)a.in[threadIdx.x];
    __syncthreads();
#define INP(k) ((const float*)(((unsigned long long)(unsigned)__builtin_amdgcn_readfirstlane((int)(ptab[k] >> 32)) << 32) | (unsigned long long)(unsigned)__builtin_amdgcn_readfirstlane((int)(ptab[k] & 0xffffffffull))))
    if (a.ph_lo == 0 && PH_ON(0)) {
        float* rope_cs = (float*)(a.ws + WS_ROPE);
        for (int i = bx * 512 + (int)threadIdx.x; i < SEQ * 8; i += NTHR) rope_entry(i, rope_cs, rope_cs + SEQ * 8);
    }
    for (int ph = a.ph_lo; ph < a.ph_hi; ++ph) {
        unsigned char* ws = a.ws; asm volatile("" : "+s"(ws));
        float* lamp = (float*)(ws + WS_CTL);
        float* rope_cs = (float*)(ws + WS_ROPE); float* rope_sn = rope_cs + SEQ * 8;
        float* SS0 = (float*)(ws + WS_SS0); float* SS1 = (float*)(ws + WS_SS1); float* SS2 = (float*)(ws + WS_SS2); float* SS3 = (float*)(ws + WS_SS3); float* SS4 = (float*)(ws + WS_SS4); float* SSM = (float*)(ws + WS_SSM);
        float* DTB = (float*)(ws + WS_DT);
        bf16_t* WGU1 = (bf16_t*)(ws + WS_WGU1); bf16_t* WD1 = (bf16_t*)(ws + WS_WD1); bf16_t* WIN = (bf16_t*)(ws + WS_WIN); bf16_t* WOUT = (bf16_t*)(ws + WS_WOUT);
        bf16_t* WQ = (bf16_t*)(ws + WS_WQ); bf16_t* WKV = (bf16_t*)(ws + WS_WKV); bf16_t* WO = (bf16_t*)(ws + WS_WO); bf16_t* WGU2 = (bf16_t*)(ws + WS_WGU2); bf16_t* WD2 = (bf16_t*)(ws + WS_WD2);
        bf16_t* MEMB = (bf16_t*)(ws + WS_MEMB); bf16_t* KVX = (bf16_t*)(ws + WS_KVX); bf16_t* VTX = (bf16_t*)(ws + WS_VTX); bf16_t* VT = (bf16_t*)(ws + WS_VT);
        bf16_t* XB = (bf16_t*)(ws + WS_XB); bf16_t* XC = XB;
        bf16_t* YMIX = (bf16_t*)(ws + WS_YMIX); bf16_t* OX = YMIX;
        bf16_t* YF = (bf16_t*)(ws + WS_YFB); bf16_t* YB = YF + (size_t)T * 512; bf16_t* QX = YF;
        bf16_t* BIG = (bf16_t*)(ws + WS_BIG); bf16_t* U = BIG; bf16_t* PROJ = BIG;
        float* out = a.out;

        if (ph == 0 && PH_ON(0)) {
            PH_IDS;
            LAS float* scr = (LAS float*)(lds + wave * 16384);
            constexpr int I_G = 16 * 88, I_D = 44 * 32, I_IN = 16 * 97, I_SQ = 16 * 32, I_KV = 16 * 64;
            constexpr int NITEMS = 6 * I_G + I_IN + 3 * I_SQ + I_KV;
            static_assert(I_G == I_D, "item counts");
            for (int it = gw; it < NITEMS; it += NGW) {
                int r = it; const float* W; const float* gq = nullptr; bf16_t* WT; int K = DM, N = DM, kind = 0;
                if (r < 3 * I_G) { const int w = r / I_G; r -= w * I_G; if (w == 2) { W = INP(5); K = FF; WT = WD1; } else { W = INP(3 + w); N = FF; WT = WGU1; kind = 1 + w; gq = INP(2); } }
                else if (r < 6 * I_G) { r -= 3 * I_G; const int w = r / I_G; r -= w * I_G; if (w == 2) { W = INP(30); K = FF; WT = WD2; } else { W = INP(28 + w); N = FF; WT = WGU2; kind = 1 + w; gq = INP(27); } }
                else if (r < 6 * I_G + I_IN) { r -= 6 * I_G; W = INP(7); N = 3088; WT = WIN; kind = 3; gq = INP(6); }
                else { r -= 6 * I_G + I_IN;
                    if (r < I_SQ) { W = INP(21); WT = WOUT; }
                    else if (r < 2 * I_SQ) { r -= I_SQ; W = INP(24); WT = WQ; gq = INP(22); }
                    else if (r < 3 * I_SQ) { r -= 2 * I_SQ; W = INP(26); WT = WO; }
                    else { r -= 3 * I_SQ; W = INP(25); N = 2 * DM; WT = WKV; gq = INP(23); } }
                p0_transpose_item(W, K, N, WT, kind, gq, scr, r, lane);
            }
            for (int mrow = gw; mrow < T; mrow += NGW) row_to_bf16_ss(INP(0) + (size_t)mrow * DM, XB + (size_t)mrow * DM, SS0 + (size_t)mrow * 16, lane);
            for (int mrow = gw; mrow < TM; mrow += NGW) row_to_bf16_ss(INP(1) + (size_t)mrow * DM, MEMB + (size_t)mrow * DM, SSM + (size_t)mrow * 16, lane);
            for (int i = gtid; i < (NPROJ - 3088) * DM / 8; i += NTHR) ((u32x4*)(WIN + (size_t)3088 * DM))[i] = (u32x4){0u, 0u, 0u, 0u};
            if (bx == 0 && wave == 0) {
                const float s1 = wave_sum(INP(16)[lane] * INP(17)[lane]), s2 = wave_sum(INP(18)[lane] * INP(19)[lane]);
                if (lane == 0) lamp[0] = __expf(s1) - __expf(s2) + LAMBDA_INIT;
            }
        } else if (PH_ON(1) && (ph == 1 || ph == 2 || ph == 3 || ph == 7 || ph == 8 || ph == 10 || ph == 11 || ph == 12)) {
            for (int sub = 0; sub < 2; ++sub) {
                if (sub == 1 && ph != 1) break;
                GJob j; j.E = EpiAny{0, ws, 1.0f, 0u, 0u, 0u, 0u, 0, 0, out};
                if (ph == 1 && sub == 0) { j.A = XB; j.Bt = WGU1; j.M = T; j.N = 2 * FF; j.K = DM; j.E.kind = 1; j.E.part_off = (unsigned)WS_SS0; j.E.o_off = (unsigned)WS_BIG; }
                else if (ph == 1)        { j.A = MEMB; j.Bt = WKV; j.M = TM; j.N = 2 * DM; j.K = DM; j.E.kind = 0; j.E.part_off = (unsigned)WS_SSM; j.E.o_off = (unsigned)WS_KVX; j.E.ldc = 2 * DM; }
                else if (ph == 2)        { j.A = U; j.Bt = WD1; j.M = T; j.N = DM; j.K = FF; j.E.kind = 2; j.E.res_is_x = 1; j.E.scale = 0.5f; j.E.xb_off = (unsigned)WS_XB; j.E.opart_off = (unsigned)WS_SS1; }
                else if (ph == 3)        { j.A = XB; j.Bt = WIN; j.M = T; j.N = NPROJ; j.K = DM; j.E.kind = 3; j.E.part_off = (unsigned)WS_SS1; j.E.o_off = (unsigned)WS_BIG; }
                else if (ph == 7)        { j.A = YMIX; j.Bt = WOUT; j.M = T; j.N = DM; j.K = DM; j.E.kind = 2; j.E.xb_off = (unsigned)WS_XB; j.E.opart_off = (unsigned)WS_SS2; }
                else if (ph == 8)        { j.A = XB; j.Bt = WQ; j.M = T; j.N = DM; j.K = DM; j.E.kind = 0; j.E.part_off = (unsigned)WS_SS2; j.E.scale = 0.0625f * LOG2E; j.E.o_off = (unsigned)WS_YFB; j.E.ldc = DM; }
                else if (ph == 10)       { j.A = OX; j.Bt = WO; j.M = T; j.N = DM; j.K = DM; j.E.kind = 2; j.E.xb_off = (unsigned)WS_XB; j.E.opart_off = (unsigned)WS_SS3; }
                else if (ph == 11)       { j.A = XB; j.Bt = WGU2; j.M = T; j.N = 2 * FF; j.K = DM; j.E.kind = 1; j.E.part_off = (unsigned)WS_SS3; j.E.o_off = (unsigned)WS_BIG; }
                else                     { j.A = U; j.Bt = WD2; j.M = T; j.N = DM; j.K = FF; j.E.kind = 2; j.E.scale = 0.5f; j.E.xb_off = 0u; j.E.opart_off = (unsigned)WS_SS4; }
                run_gemm(lds, j.A, j.Bt, j.M, j.N, j.K, j.E);
            }
        } else if (ph == 4 && PH_ON(4)) {
            PH_IDS;
            conv_phase(PROJ, INP(8), INP(9), XC, gtid, NTHR);
            LAS uchar* scr = lds + wave * 8448;
            for (int it = gw; it < NB * 4 * 2 * 64; it += NGW) { const int st = it & 63, dt = (it >> 6) & 1, bh = it >> 7, b = bh >> 2, h = bh & 3;
                transpose64(PROJ + (size_t)(b * SEQ + st * 64) * PLD + PC_V + h * 128 + dt * 64, PLD, VT + (size_t)(bh * 128 + dt * 64) * SEQ + st * 64, SEQ, scr, lane); }
            for (int it = gw; it < NB * 4 * 4 * 4; it += NGW) { const int mt = it & 3, dt = (it >> 2) & 3, bh = it >> 4, b = bh >> 2, h = bh & 3;
                transpose64(KVX + (size_t)(b * MEML + mt * 64) * (2 * DM) + DM + h * 256 + dt * 64, 2 * DM, VTX + (size_t)(bh * 256 + dt * 64) * MEML + mt * 64, MEML, scr, lane); }
        } else if (ph == 5 && PH_ON(5)) {
            PH_IDS;
            for (int it = bx; it < NB * 8 * 2; it += G) { const int dir = it & 1, h = (it >> 1) & 7, b = it >> 4;
                const float Aneg = -__expf(dir ? INP(13)[h] : INP(12)[h]);
                ssd_item(lds, b, h, dir, XC, DTB, Aneg, dir ? YB : YF); }
            for (int i = 0;; ++i) {
                int bh, qb;
                if (G == 256) { if (i >= 8) break; bh = i * 8 + (bx & 7); qb = bx >> 3; }
                else { const int L = i * G + bx; if (L >= 2048) break; bh = L >> 5; qb = L & 31; }
                const int b = bh >> 2, h = bh & 3; const size_t row0 = (size_t)b * SEQ + qb * 128;
                const int t = wave & 1;
                attn_item<64, 128, 128, 64, 0, true>(lds, PROJ + row0 * PLD + PC_Q + h * 128 + t * 64, PLD, PROJ + (size_t)b * SEQ * PLD + PC_K + h * 128, PLD, t * 64,
                                               VT + (size_t)bh * 128 * SEQ, SEQ, 0, YMIX + row0 * DM + 512 + h * 128, DM, lamp[0], INP(20));
            }
        } else if (ph == 6 && PH_ON(6)) {
            PH_IDS;
            for (int it = gw; it < T * 2; it += NGW) { const int tok = it >> 1, g = it & 1, c = g * 256 + 4 * lane, h = c >> 6;
                const u32x2 yf = *(const u32x2*)(YF + (size_t)tok * 512 + c), yb = *(const u32x2*)(YB + (size_t)tok * 512 + c), xv = *(const u32x2*)(XC + (size_t)tok * 1024 + c), zv = *(const u32x2*)(PROJ + (size_t)tok * PLD + PC_Z + c);
                const float D = INP(14)[h];
                float y[4];
                y[0] = (bflo(yf.x) + bflo(yb.x) + D * bflo(xv.x)) * silu_f(bflo(zv.x)); y[1] = (bfhi(yf.x) + bfhi(yb.x) + D * bfhi(xv.x)) * silu_f(bfhi(zv.x));
                y[2] = (bflo(yf.y) + bflo(yb.y) + D * bflo(xv.y)) * silu_f(bflo(zv.y)); y[3] = (bfhi(yf.y) + bfhi(yb.y) + D * bfhi(xv.y)) * silu_f(bfhi(zv.y));
                const float ss = wave_sum((y[0] * y[0] + y[1] * y[1]) + (y[2] * y[2] + y[3] * y[3])); const float rn = 1.0f / sqrtf(ss * (1.0f / 256.0f) + EPS);
                const f32x4 gv = *(const f32x4*)(INP(15) + c);
                u32x2 w; w.x = cvtpk(y[0] * rn * gv[0], y[1] * rn * gv[1]); w.y = cvtpk(y[2] * rn * gv[2], y[3] * rn * gv[3]);
                *(u32x2*)(YMIX + (size_t)tok * DM + c) = w; }
        } else if (ph == 9 && PH_ON(9)) {
            PH_IDS;
            for (int i = 0;; ++i) {
                int bh, qb;
                if (G == 256) { if (i >= 8) break; bh = i * 8 + (bx & 7); qb = bx >> 3; }
                else { const int L = i * G + bx; if (L >= 2048) break; bh = L >> 5; qb = L & 31; }
                const int b = bh >> 2, h = bh & 3; const size_t row0 = (size_t)b * SEQ + qb * 128;
                const int t = wave & 1;
                attn_item<256, 256, 256, 4, 1, false>(lds, QX + row0 * DM + h * 256, DM, KVX + (size_t)b * MEML * (2 * DM) + h * 256, 2 * DM, 0,
                                               VTX + (size_t)bh * 256 * MEML, MEML, t * 128, OX + row0 * DM + h * 256, DM, 0.f, nullptr);
            }
        } else if (ph == 13 && PH_ON(13)) {
            PH_IDS;
            for (int row = gw; row < T; row += NGW) { const float rs = row_rs(SS4, row); f32x4* xr = (f32x4*)(out + (size_t)row * DM);
#pragma unroll
                for (int j = 0; j < 4; ++j) { const f32x4 gv = ((const f32x4*)INP(31))[lane + 64 * j]; xr[lane + 64 * j] = xr[lane + 64 * j] * rs * gv; } }
        }
        if (ph + 1 < a.ph_hi) cg::this_grid().sync();
    }
}

extern "C" void kernel_launch(void* const* d_in, const int* in_sizes, int n_in, void* d_out, int out_size, void* d_ws, size_t ws_size, hipStream_t stream) {
    static int grid = 0;
    if (grid == 0) {
        if (n_in != 32 || in_sizes[0] != T * DM || out_size != T * DM || ws_size < WS_END) {
            fprintf(stderr, "kernel_launch: unexpected shapes (n_in %d, in0 %d, out %d, ws %zu < %zu); nothing launched\n", n_in, n_in > 0 ? in_sizes[0] : -1, out_size, ws_size, (size_t)WS_END); grid = -1; return; }
        int dev = 0, cus = 0, per_cu = 0;
        hipGetDevice(&dev); hipDeviceGetAttribute(&cus, hipDeviceAttributeMultiprocessorCount, dev);
        if (hipFuncSetAttribute((const void*)mega_fwd, hipFuncAttributeMaxDynamicSharedMemorySize, LDS_BYTES) != hipSuccess) { fprintf(stderr, "kernel_launch: hipFuncSetAttribute failed\n"); grid = -1; return; }
        if (hipOccupancyMaxActiveBlocksPerMultiprocessor(&per_cu, (const void*)mega_fwd, 512, LDS_BYTES) != hipSuccess || per_cu < 1) { fprintf(stderr, "kernel_launch: occupancy query says %d\n", per_cu); per_cu = 1; }
        (void)hipGetLastError();
        grid = cus * per_cu;
        if (grid <= 0) grid = 256;
    }
    if (grid < 0) return;
    Args a{};
    for (int i = 0; i < 32; ++i) a.in[i] = (const float*)d_in[i];
    a.out = (float*)d_out; a.ws = (unsigned char*)d_ws;
#if MK_COOP
    a.ph_lo = 0; a.ph_hi = N_PHASES;
    void* kargs[] = {&a};
    hipError_t e = hipLaunchCooperativeKernel((const void*)mega_fwd, dim3(grid), dim3(512), kargs, LDS_BYTES, stream);
    if (e != hipSuccess) fprintf(stderr, "kernel_launch: cooperative launch failed: %s (grid %d)\n", hipGetErrorString(e), grid);
#else
    for (int ph = 0; ph < N_PHASES; ++ph) { a.ph_lo = ph; a.ph_hi = ph + 1; hipLaunchKernelGGL(mega_fwd, dim3(grid), dim3(512), LDS_BYTES, stream, a); }
#endif
}
```

```cpp
#include <hip/hip_runtime.h>
#include <hip/hip_cooperative_groups.h>
#include <cstdio>
#include <cstdint>
namespace cg = cooperative_groups;
#ifndef MK_COOP
#define MK_COOP 1
#endif
namespace pg8 {
#define PG8_LAS __attribute__((address_space(3)))
typedef unsigned short bf16_t;
typedef short bf16x8 __attribute__((ext_vector_type(8)));
typedef float f32x4 __attribute__((ext_vector_type(4)));
typedef unsigned u32x4 __attribute__((ext_vector_type(4)));
constexpr int BM = 256, BK = 64, HALF = 128, HTB = HALF * BK * 2  , STAGE_BYTES = 8 * HTB, NXCD = 8, WGM = 8;

__host__ __device__ __forceinline__ int lds_byte(int r, int c) { const int st = (r >> 4) * 2 + (c >> 5), rr = r & 15, cc = c & 31, ob = rr * 64 + cc * 2; return st * 1024 + (ob ^ (((ob >> 9) & 1) << 5)); }
__host__ __device__ __forceinline__ void stage_rc(int b, int& R, int& C) { const int st = b / 1024, sb = b % 1024, swz = sb ^ (((sb >> 9) & 1) << 5); R = (st >> 1) * 16 + swz / 64; C = (st & 1) * 32 + (swz % 64) / 2; }
__host__ __device__ __forceinline__ int perm32(int rho) { const int n = rho >> 4, i = rho & 15; return 8 * (i >> 2) + 4 * n + (i & 3); }

struct Unit { int pm, pn; };
struct Gemm { const bf16_t* A; const bf16_t* Bt; int M, N, K; };

struct StaticOrder {
    int nM, nN, nwg, G, c;
    __host__ __device__ void init(int M, int N, int G_, int c_) { nM = M / BM; nN = N / BM; nwg = nM * nN; G = G_; c = c_; }
    __host__ __device__ bool next(int i, Unit& u) const {
        const long L = (long)i * G + c; if (L >= nwg) return false;
        int wgid = (int)L; { const int q = nwg / NXCD, r = nwg % NXCD, xcd = wgid % NXCD, off = wgid / NXCD; wgid = (xcd < r ? xcd * (q + 1) : r * (q + 1) + (xcd - r) * q) + off; }
        const int nig = WGM * nN, gid = wgid / nig, fm = gid * WGM, gsz = (nM - fm) < WGM ? (nM - fm) : WGM;
        u.pm = fm + ((wgid % nig) % gsz); u.pn = (wgid % nig) / gsz; return true;
    }
    __device__ __forceinline__ void a_ready(const Unit&) const {}
    __device__ __forceinline__ void done(const Unit&) const {}
};
__device__ __forceinline__ unsigned cvt_pk_bf16(float lo, float hi) { unsigned r; asm volatile("v_cvt_pk_bf16_f32 %0, %1, %2" : "=v"(r) : "v"(lo), "v"(hi)); return r; }
template <class Epi, class Sched, bool ALIGN_EPI = false, bool SP2 = false>
__device__ __forceinline__ void gemm_phase(PG8_LAS unsigned char* lds, const Gemm g, const Sched& S, const Epi& E) {
    int tid = threadIdx.x; asm volatile("" : "+v"(tid)); const int wid = __builtin_amdgcn_readfirstlane(tid >> 6), lane = tid & 63, wr = wid >> 2, wc = wid & 3, fr = lane & 15, fq = lane >> 4;
    const int K = g.K, nt = K / BK;
    unsigned voffA[2], voffB[2];
#pragma unroll
    for (int i = 0; i < 2; ++i) { int R, C; stage_rc(tid * 16 + i * 8192, R, C); const int Rb = Epi::PERM ? ((R & ~31) + perm32(R & 31)) : R;
        voffA[i] = (unsigned)(R * K + C) * 2u; voffB[i] = (unsigned)(Rb * K + C) * 2u; }
    const size_t kstep = (size_t)(BK * 2);
    const size_t hstep = (size_t)HALF * K * 2;
    const size_t tstep = 2 * hstep;
    const unsigned ldsw = (unsigned)wid * 1024u;
    const int aoff = lds_byte(wr * 64 + fr, fq * 8), boff = lds_byte(wc * 32 + fr, fq * 8);
#define PG8_SA(b, h) (((b) * 2 + (h)) * HTB)
#define PG8_SB(b, h) ((4 + (b) * 2 + (h)) * HTB)
#define PG8_STAGE(bufoff, gbase, voff) do { _Pragma("unroll") for (int _i = 0; _i < 2; ++_i) \
        __builtin_amdgcn_global_load_lds((const unsigned*)((const char*)(gbase) + (voff)[_i]), (PG8_LAS unsigned*)(lds + (bufoff) + ldsw + _i * 8192), 16, 0, 0); } while (0)
#define PG8_LDA(dst, b, h) do { _Pragma("unroll") for (int m = 0; m < 4; ++m) _Pragma("unroll") for (int k = 0; k < 2; ++k) dst[m][k] = *(const PG8_LAS bf16x8*)(lds + PG8_SA(b, h) + aoff + m * 2048 + k * 1024); } while (0)
#define PG8_LDB(dst, b, h) do { _Pragma("unroll") for (int n = 0; n < 2; ++n) _Pragma("unroll") for (int k = 0; k < 2; ++k) dst[n][k] = *(const PG8_LAS bf16x8*)(lds + PG8_SB(b, h) + boff + n * 2048 + k * 1024); } while (0)
#define PG8_MMA(ai, bj, At, Bt) do { __builtin_amdgcn_s_setprio(1); _Pragma("unroll") for (int m = 0; m < 4; ++m) _Pragma("unroll") for (int n = 0; n < 2; ++n) _Pragma("unroll") for (int k = 0; k < 2; ++k) \
        acc[ai][bj][m][n] = __builtin_amdgcn_mfma_f32_16x16x32_bf16(Bt[n][k], At[m][k], acc[ai][bj][m][n], 0, 0, 0); __builtin_amdgcn_s_setprio(0); } while (0)
#define PG8_WAIT_V(n) asm volatile("s_waitcnt vmcnt(" #n ")" ::: "memory")
#define PG8_WAIT_L(n) asm volatile("s_waitcnt lgkmcnt(" #n ")" ::: "memory")
#define PG8_BAR __builtin_amdgcn_s_barrier()
#define PG8_SCHED __builtin_amdgcn_sched_barrier(0)
    Unit cur, nxt; int ui = 0;
    if (!S.next(0, cur)) return;
    f32x4 acc[2][2][4][2];
#pragma unroll
    for (int a = 0; a < 2; ++a)
#pragma unroll
        for (int b = 0; b < 2; ++b)
#pragma unroll
            for (int m = 0; m < 4; ++m)
#pragma unroll
                for (int n = 0; n < 2; ++n) acc[a][b][m][n] = (f32x4){0.f, 0.f, 0.f, 0.f};
    bf16x8 At[4][2], B0[2][2], B1[2][2];
    const char* cA = (const char*)g.A + (size_t)cur.pm * tstep; const char* cB = (const char*)g.Bt + (size_t)cur.pn * tstep;
    S.a_ready(cur);
    if constexpr (SP2) {
        PG8_STAGE(PG8_SB(0, 0), cB, voffB); PG8_STAGE(PG8_SB(0, 1), cB + hstep, voffB); PG8_STAGE(PG8_SA(0, 0), cA, voffA); PG8_STAGE(PG8_SA(0, 1), cA + hstep, voffA);
        if (wr == 1) PG8_BAR;
        PG8_WAIT_V(2); PG8_BAR;
        PG8_STAGE(PG8_SB(1, 0), cB + kstep, voffB); PG8_STAGE(PG8_SA(1, 0), cA + kstep, voffA); PG8_STAGE(PG8_SB(1, 1), cB + hstep + kstep, voffB);
        PG8_WAIT_V(6); PG8_BAR;
    } else {
        PG8_STAGE(PG8_SB(0, 0), cB, voffB); PG8_STAGE(PG8_SA(0, 0), cA, voffA); PG8_STAGE(PG8_SB(0, 1), cB + hstep, voffB); PG8_STAGE(PG8_SA(0, 1), cA + hstep, voffA);
        if (wr == 1) PG8_BAR;
        PG8_WAIT_V(4); PG8_BAR;
        PG8_STAGE(PG8_SB(1, 0), cB + kstep, voffB); PG8_STAGE(PG8_SA(1, 0), cA + kstep, voffA); PG8_STAGE(PG8_SB(1, 1), cB + hstep + kstep, voffB);
        PG8_WAIT_V(6); PG8_BAR;
    }
    for (;;) {
        const bool has_next = S.next(ui + 1, nxt);
        const char* nA = has_next ? (const char*)g.A + (size_t)nxt.pm * tstep : cA; const char* nB = has_next ? (const char*)g.Bt + (size_t)nxt.pn * tstep : cB;
        for (int t = 0; t < nt; t += 2) {
            const bool last = (t == nt - 2);
            const char* a1 = cA + (size_t)(t + 1) * kstep;
            const char* a2 = last ? nA : cA + (size_t)(t + 2) * kstep; const char* b2 = last ? nB : cB + (size_t)(t + 2) * kstep;
            const char* a3 = a2 + kstep; const char* b3 = b2 + kstep;
            if (last && has_next) S.a_ready(nxt);
            if constexpr (SP2) {
            PG8_LDB(B0, 0, 0); PG8_LDB(B1, 0, 1); PG8_SCHED; PG8_LDA(At, 0, 0); PG8_STAGE(PG8_SA(1, 1), a1 + hstep, voffA);
            PG8_WAIT_V(8); PG8_WAIT_L(0); PG8_BAR; PG8_MMA(0, 0, At, B0); PG8_MMA(0, 1, At, B1); PG8_BAR; PG8_SCHED;
            PG8_LDA(At, 0, 1); PG8_STAGE(PG8_SB(0, 0), b2, voffB); PG8_STAGE(PG8_SB(0, 1), b2 + hstep, voffB); PG8_STAGE(PG8_SA(0, 0), a2, voffA);
            PG8_WAIT_V(8); PG8_WAIT_L(0); PG8_BAR; PG8_MMA(1, 0, At, B0); PG8_MMA(1, 1, At, B1); PG8_BAR; PG8_SCHED;
            PG8_LDB(B0, 1, 0); PG8_LDB(B1, 1, 1); PG8_SCHED; PG8_LDA(At, 1, 0); PG8_STAGE(PG8_SA(0, 1), a2 + hstep, voffA);
            PG8_WAIT_V(8); PG8_WAIT_L(0); PG8_BAR; PG8_MMA(0, 0, At, B0); PG8_MMA(0, 1, At, B1); PG8_BAR; PG8_SCHED;
            PG8_LDA(At, 1, 1); PG8_STAGE(PG8_SB(1, 0), b3, voffB); PG8_STAGE(PG8_SB(1, 1), b3 + hstep, voffB); PG8_STAGE(PG8_SA(1, 0), a3, voffA);
            PG8_WAIT_V(8); PG8_WAIT_L(0); PG8_BAR; PG8_MMA(1, 0, At, B0); PG8_MMA(1, 1, At, B1); PG8_BAR; PG8_SCHED;
            } else {
            PG8_LDB(B0, 0, 0); PG8_SCHED; PG8_LDA(At, 0, 0); PG8_STAGE(PG8_SA(1, 1), a1 + hstep, voffA);
            PG8_WAIT_L(8); PG8_BAR; PG8_WAIT_L(0); PG8_MMA(0, 0, At, B0); PG8_BAR; PG8_SCHED;
            PG8_LDB(B1, 0, 1); PG8_STAGE(PG8_SB(0, 0), b2, voffB);
            PG8_BAR; PG8_WAIT_L(0); PG8_MMA(0, 1, At, B1); PG8_BAR;
            PG8_LDA(At, 0, 1); PG8_STAGE(PG8_SA(0, 0), a2, voffA);
            PG8_BAR; PG8_WAIT_L(0); PG8_MMA(1, 0, At, B0); PG8_BAR; PG8_SCHED;
            PG8_STAGE(PG8_SB(0, 1), b2 + hstep, voffB);
            PG8_WAIT_V(6); PG8_BAR; PG8_MMA(1, 1, At, B1); PG8_BAR;
            PG8_LDB(B0, 1, 0); PG8_SCHED; PG8_LDA(At, 1, 0); PG8_STAGE(PG8_SA(0, 1), a2 + hstep, voffA);
            PG8_WAIT_L(8); PG8_BAR; PG8_WAIT_L(0); PG8_MMA(0, 0, At, B0); PG8_BAR; PG8_SCHED;
            PG8_LDB(B1, 1, 1); PG8_STAGE(PG8_SB(1, 0), b3, voffB);
            PG8_BAR; PG8_WAIT_L(0); PG8_MMA(0, 1, At, B1); PG8_BAR;
            PG8_LDA(At, 1, 1); PG8_STAGE(PG8_SA(1, 0), a3, voffA);
            PG8_BAR; PG8_WAIT_L(0); PG8_MMA(1, 0, At, B0); PG8_BAR; PG8_SCHED;
            PG8_STAGE(PG8_SB(1, 1), b3 + hstep, voffB);
            PG8_WAIT_V(6); PG8_BAR; PG8_MMA(1, 1, At, B1); PG8_BAR;
            }
        }
        if constexpr (ALIGN_EPI) { if (wr == 0) PG8_BAR; }
        if constexpr (!Epi::AFTER_DRAIN) { E(acc, cur, wr, wc, fr, fq); S.done(cur); }
        if (!has_next) break;
#pragma unroll
        for (int a = 0; a < 2; ++a)
#pragma unroll
            for (int b = 0; b < 2; ++b)
#pragma unroll
                for (int m = 0; m < 4; ++m)
#pragma unroll
                    for (int n = 0; n < 2; ++n) acc[a][b][m][n] = (f32x4){0.f, 0.f, 0.f, 0.f};
        cur = nxt; cA = nA; cB = nB; ++ui;
        if constexpr (ALIGN_EPI) { if (wr == 1) PG8_BAR; }
    }
    PG8_WAIT_V(0);
    if constexpr (!ALIGN_EPI) { if (wr == 0) PG8_BAR; }
    PG8_BAR;
    if constexpr (Epi::AFTER_DRAIN) { E.fused(acc, cur, wr, wc, fr, fq, lds, wid, lane); S.done(cur); }
#undef PG8_SA
#undef PG8_SB
#undef PG8_STAGE
#undef PG8_LDA
#undef PG8_LDB
#undef PG8_MMA
#undef PG8_WAIT_V
#undef PG8_WAIT_L
#undef PG8_BAR
#undef PG8_SCHED
}
}

#define LAS __attribute__((address_space(3)))
typedef unsigned char uchar;
typedef pg8::bf16_t bf16_t;
typedef pg8::bf16x8 bf16x8;
typedef pg8::f32x4 f32x4;
typedef pg8::u32x4 u32x4;
typedef unsigned u32x2 __attribute__((ext_vector_type(2)));
typedef float f32x2 __attribute__((ext_vector_type(2)));
typedef float f32x16 __attribute__((ext_vector_type(16)));
typedef __bf16 bf16x2_t __attribute__((ext_vector_type(2)));

constexpr int NB = 16, SEQ = 4096, T = NB * SEQ, DM = 1024, FF = 2816, MEML = 256, TM = NB * MEML;
constexpr int NPROJ = 3328, PLD = 3072;
constexpr int PC_Z = 0, PC_X = 512, PC_B = 1024, PC_C = 1280, PC_Q = 1536, PC_K = 2048, PC_V = 2560;
constexpr float EPS = 1e-5f, LOG2E = 1.4426950408889634f;
constexpr float LAMBDA_INIT = 0.2f;

constexpr size_t MiB = 1u << 20;
constexpr size_t WS_CTL = 0, WS_ROPE = 1 * MiB, WS_SS0 = 2 * MiB, WS_SS1 = 6 * MiB, WS_SS2 = 10 * MiB, WS_SS3 = 14 * MiB, WS_SS4 = 18 * MiB, WS_SSM = 22 * MiB,
                 WS_DT = 23 * MiB, WS_WGU1 = 27 * MiB, WS_WD1 = 38 * MiB, WS_WIN = 44 * MiB, WS_WOUT = 51 * MiB, WS_WQ = 53 * MiB, WS_WKV = 55 * MiB, WS_WO = 59 * MiB,
                 WS_WGU2 = 61 * MiB, WS_WD2 = 72 * MiB, WS_MEMB = 78 * MiB, WS_KVX = 86 * MiB, WS_VTX = 102 * MiB, WS_VT = 110 * MiB, WS_XB = 174 * MiB,
                 WS_YMIX = 302 * MiB, WS_YFB = 430 * MiB, WS_BIG = 558 * MiB, WS_END = 942 * MiB;
constexpr int LDS_BYTES = 147456, PTAB_OFF = LDS_BYTES - 512, LDS_PTAB_ABS = PTAB_OFF;

__device__ __forceinline__ const float* lds_inp(int k) {
    const LAS unsigned long long* ptab = (const LAS unsigned long long*)(uintptr_t)0; const unsigned long long v = *(const LAS unsigned long long*)((const LAS uchar*)ptab + LDS_PTAB_ABS + 8 * k);
    return (const float*)(((unsigned long long)(unsigned)__builtin_amdgcn_readfirstlane((int)(v >> 32)) << 32) | (unsigned long long)(unsigned)__builtin_amdgcn_readfirstlane((int)(v & 0xffffffffull)));
}
__device__ __forceinline__ int opaque_tid() { int t = threadIdx.x; asm volatile("" : "+v"(t)); return t; }
__device__ __forceinline__ unsigned cvtpk(float lo, float hi) { f32x2 v = {lo, hi}; bf16x2_t b = __builtin_convertvector(v, bf16x2_t); return __builtin_bit_cast(unsigned, b); }
__device__ __forceinline__ float bflo(unsigned w) { return __uint_as_float(w << 16); }
__device__ __forceinline__ float bfhi(unsigned w) { return __uint_as_float(w & 0xffff0000u); }
__device__ __forceinline__ float wave_sum(float v) {
#pragma unroll
    for (int o = 1; o < 64; o <<= 1) v += __shfl_xor(v, o);
    return v;
}
__device__ __forceinline__ float fast_exp2(float x) { return __builtin_amdgcn_exp2f(x); }
__device__ __forceinline__ float silu_f(float g) { return g * __builtin_amdgcn_rcpf(1.0f + fast_exp2(-LOG2E * g)); }
__device__ __forceinline__ float row_rs(const float* part, int row) {
    const f32x4* p = (const f32x4*)(part + (size_t)row * 16);
    const f32x4 a = p[0], b = p[1], c = p[2], d = p[3];
    const float s = (((a[0] + a[1]) + (a[2] + a[3])) + ((b[0] + b[1]) + (b[2] + b[3]))) + (((c[0] + c[1]) + (c[2] + c[3])) + ((d[0] + d[1]) + (d[2] + d[3])));
    return 1.0f / sqrtf(s * (1.0f / 1024.0f) + EPS);
}

struct EpiBf16RS {
    static constexpr bool PERM = true, AFTER_DRAIN = false;
    const float* part; float scale; bf16_t* O; int ldc;
    __device__ __forceinline__ void operator()(const f32x4 (&acc)[2][2][4][2], const pg8::Unit& u, int wr, int wc, int fr, int fq) const {
        const int row0 = u.pm * 256 + wr * 64 + fr, col0 = u.pn * 256 + wc * 32 + 8 * fq;
#pragma unroll
        for (int ai = 0; ai < 2; ++ai)
#pragma unroll
            for (int m = 0; m < 4; ++m) {
                const int row = row0 + ai * 128 + m * 16; const float rs = row_rs(part, row) * scale; bf16_t* rp = O + (size_t)row * ldc + col0;
#pragma unroll
                for (int bj = 0; bj < 2; ++bj) { const f32x4 v0 = acc[ai][bj][m][0] * rs, v1 = acc[ai][bj][m][1] * rs;
                    u32x4 w; w.x = cvtpk(v0[0], v0[1]); w.y = cvtpk(v0[2], v0[3]); w.z = cvtpk(v1[0], v1[1]); w.w = cvtpk(v1[2], v1[3]);
                    *(u32x4*)(rp + bj * 128) = w; }
                asm volatile("" ::: "memory");
            }
    }
};
struct EpiSwiGLU {
    static constexpr bool PERM = true, AFTER_DRAIN = false;
    const float* part; bf16_t* U;
    __device__ __forceinline__ void operator()(const f32x4 (&acc)[2][2][4][2], const pg8::Unit& u, int wr, int wc, int fr, int fq) const {
        const int row0 = u.pm * 256 + wr * 64 + fr, col0 = u.pn * 128 + wc * 32 + 8 * fq;
#pragma unroll
        for (int ai = 0; ai < 2; ++ai)
#pragma unroll
            for (int m = 0; m < 4; ++m) {
                const int row = row0 + ai * 128 + m * 16; const float rs = row_rs(part, row);
                float h[8];
#pragma unroll
                for (int n = 0; n < 2; ++n)
#pragma unroll
                    for (int e = 0; e < 4; ++e) { const float g = acc[ai][0][m][n][e] * rs, up = acc[ai][1][m][n][e] * rs; h[4 * n + e] = silu_f(g) * up; }
                u32x4 w; w.x = cvtpk(h[0], h[1]); w.y = cvtpk(h[2], h[3]); w.z = cvtpk(h[4], h[5]); w.w = cvtpk(h[6], h[7]);
                *(u32x4*)(U + (size_t)row * FF + col0) = w;
                asm volatile("" ::: "memory");
            }
    }
};
struct EpiResidual {
    static constexpr bool PERM = true, AFTER_DRAIN = false;
    const float* res; float alpha; float* out; bf16_t* xb; float* part;
    __device__ __forceinline__ void operator()(const f32x4 (&acc)[2][2][4][2], const pg8::Unit& u, int wr, int wc, int fr, int fq) const {
        const int row0 = u.pm * 256 + wr * 64 + fr, col0 = u.pn * 256 + wc * 32 + 8 * fq;
#pragma unroll
        for (int ai = 0; ai < 2; ++ai)
#pragma unroll
            for (int m = 0; m < 4; ++m) {
                const int row = row0 + ai * 128 + m * 16; float ss = 0.f;
#pragma unroll
                for (int bj = 0; bj < 2; ++bj) { const size_t off = (size_t)row * DM + col0 + bj * 128;
                    const f32x4 r0 = *(const f32x4*)(res + off), r1 = *(const f32x4*)(res + off + 4);
                    const f32x4 v0 = r0 + acc[ai][bj][m][0] * alpha, v1 = r1 + acc[ai][bj][m][1] * alpha;
                    *(f32x4*)(out + off) = v0; *(f32x4*)(out + off + 4) = v1;
                    if (xb) { u32x4 w; w.x = cvtpk(v0[0], v0[1]); w.y = cvtpk(v0[2], v0[3]); w.z = cvtpk(v1[0], v1[1]); w.w = cvtpk(v1[2], v1[3]); *(u32x4*)(xb + off) = w; }
                    ss += ((v0[0] * v0[0] + v0[1] * v0[1]) + (v0[2] * v0[2] + v0[3] * v0[3])) + ((v1[0] * v1[0] + v1[1] * v1[1]) + (v1[2] * v1[2] + v1[3] * v1[3])); }
                ss += __shfl_xor(ss, 16); ss += __shfl_xor(ss, 32);
                if (fq == 0) part[(size_t)row * 16 + u.pn * 4 + wc] = ss;
                asm volatile("" ::: "memory");
            }
    }
};
struct EpiProj {
    static constexpr bool PERM = true, AFTER_DRAIN = false;
    const float* part; bf16_t* P; float* DT; const float* cs; const float* sn; const float* dtb_f; const float* dtb_b;
    __device__ __forceinline__ void operator()(const f32x4 (&acc)[2][2][4][2], const pg8::Unit& u, int wr, int wc, int fr, int fq) const {
        const int pn = u.pn; const int row0 = u.pm * 256 + wr * 64 + fr;
        if (pn == 12) {
            if (wc == 0 && fq < 2) {
                const float* bias = (fq == 0) ? dtb_f : dtb_b;
#pragma unroll
                for (int ai = 0; ai < 2; ++ai)
#pragma unroll
                    for (int m = 0; m < 4; ++m) { const int row = row0 + ai * 128 + m * 16; const float rs = row_rs(part, row);
#pragma unroll
                        for (int n = 0; n < 2; ++n) { f32x4 o;
#pragma unroll
                            for (int e = 0; e < 4; ++e) { const float x = acc[ai][0][m][n][e] * rs + bias[4 * n + e]; o[e] = x > 20.f ? x : log1pf(__expf(x)); }
                            *(f32x4*)(DT + (size_t)row * 16 + 8 * fq + 4 * n) = o; } asm volatile("" ::: "memory"); }
            }
            return;
        }
        const bool isq = (pn == 6 || pn == 7), isk = (pn == 8 || pn == 9), rope = (isq || isk) && ((wc & 1) == 0);
        const float qs = isq ? 0.125f * LOG2E : 1.0f; const float sgn = (fq == 0) ? -1.f : 1.f;
        const int col0 = pn * 256 + wc * 32 + 8 * fq;
#pragma unroll
        for (int ai = 0; ai < 2; ++ai)
#pragma unroll
            for (int m = 0; m < 4; ++m) {
                const int row = row0 + ai * 128 + m * 16; const float rs = row_rs(part, row) * qs; const int pos = row & (SEQ - 1);
                bf16_t* rp = P + (size_t)row * PLD + col0;
#pragma unroll
                for (int bj = 0; bj < 2; ++bj) { f32x4 v0 = acc[ai][bj][m][0], v1 = acc[ai][bj][m][1];
                    if (rope) { f32x4 p0, p1;
#pragma unroll
                        for (int e = 0; e < 4; ++e) { p0[e] = __shfl_xor(v0[e], 16); p1[e] = __shfl_xor(v1[e], 16); }
                        if (fq < 2) { const f32x4 c0 = *(const f32x4*)(cs + pos * 8), c1 = *(const f32x4*)(cs + pos * 8 + 4), s0 = *(const f32x4*)(sn + pos * 8), s1 = *(const f32x4*)(sn + pos * 8 + 4);
                            v0 = v0 * c0 + p0 * s0 * sgn; v1 = v1 * c1 + p1 * s1 * sgn; } }
                    v0 = v0 * rs; v1 = v1 * rs;
                    u32x4 w; w.x = cvtpk(v0[0], v0[1]); w.y = cvtpk(v0[2], v0[3]); w.z = cvtpk(v1[0], v1[1]); w.w = cvtpk(v1[2], v1[3]);
                    *(u32x4*)(rp + bj * 128) = w; }
                asm volatile("" ::: "memory");
            }
    }
};
struct EpiAny {
    static constexpr bool PERM = true, AFTER_DRAIN = false;
    int kind; unsigned char* ws; float scale; unsigned part_off, o_off, xb_off, opart_off; int ldc, res_is_x; float* out;
    __device__ __forceinline__ void operator()(const f32x4 (&acc)[2][2][4][2], const pg8::Unit& u, int wr, int wc, int fr, int fq) const {
        if (kind == 0) { EpiBf16RS e{(const float*)(ws + part_off), scale, (bf16_t*)(ws + o_off), ldc}; e(acc, u, wr, wc, fr, fq); }
        else if (kind == 1) { EpiSwiGLU e{(const float*)(ws + part_off), (bf16_t*)(ws + o_off)}; e(acc, u, wr, wc, fr, fq); }
        else if (kind == 2) { const float* res = res_is_x ? lds_inp(0) : out; EpiResidual e{res, scale, out, xb_off ? (bf16_t*)(ws + xb_off) : nullptr, (float*)(ws + opart_off)}; e(acc, u, wr, wc, fr, fq); }
        else { EpiProj e{(const float*)(ws + part_off), (bf16_t*)(ws + o_off), (float*)(ws + WS_DT), (const float*)(ws + WS_ROPE), (const float*)(ws + WS_ROPE) + SEQ * 8, lds_inp(10), lds_inp(11)}; e(acc, u, wr, wc, fr, fq); }
    }
};
struct GJob { const bf16_t* A; const bf16_t* Bt; int M, N, K; EpiAny E; };
template <class Epi> __device__ __forceinline__ void run_gemm(LAS uchar* lds, const bf16_t* A, const bf16_t* Bt, int M, int N, int K, const Epi& E) {
    pg8::Gemm g{A, Bt, M, N, K}; pg8::StaticOrder S; S.init(M, N, (int)gridDim.x, (int)blockIdx.x);
    pg8::gemm_phase<Epi, pg8::StaticOrder, true, true>(lds, g, S, E);
}

__device__ __forceinline__ int map_row(int kind, int n) {
    if (kind == 1) return (n >> 7) * 256 + (n & 127);
    if (kind == 2) return (n >> 7) * 256 + 128 + (n & 127);
    if (kind == 3) return n < 1536 ? n : (n < 1552 ? 3072 + (n - 1536) : n - 16);
    return n;
}
__device__ __forceinline__ void p0_transpose_item(const float* W, int K, int N, bf16_t* WT, int kind, const float* g, LAS float* scr, int item, int lane) {
    const int nblk = (N + 31) >> 5, kb = item / nblk, nb = item - kb * nblk, k0 = 64 * kb, n0 = 32 * nb;
    const int ncol = n0 + (lane & 31); const bool valid = ncol < N;
#pragma unroll 8
    for (int i = 0; i < 32; ++i) { const int kk = 2 * i + (lane >> 5); float v = valid ? W[(size_t)(k0 + kk) * N + ncol] : 0.f; if (g) v *= g[k0 + kk]; scr[kk * 33 + (lane & 31)] = v; }
    asm volatile("s_waitcnt lgkmcnt(0)" ::: "memory");
    const int c = lane & 7;
#pragma unroll
    for (int j = 0; j < 4; ++j) { const int n = (lane >> 3) + 8 * j; const LAS float* s = scr + (8 * c) * 33 + n;
        if (n0 + n < N) { u32x4 o; o.x = cvtpk(s[0 * 33], s[1 * 33]); o.y = cvtpk(s[2 * 33], s[3 * 33]); o.z = cvtpk(s[4 * 33], s[5 * 33]); o.w = cvtpk(s[6 * 33], s[7 * 33]);
            *(u32x4*)(WT + (size_t)map_row(kind, n0 + n) * K + k0 + 8 * c) = o; } }
    asm volatile("s_waitcnt lgkmcnt(0)" ::: "memory");
}
__device__ __forceinline__ void row_to_bf16_ss(const float* xrow, bf16_t* orow, float* part, int lane) {
    f32x4 v[4]; float s = 0.f;
#pragma unroll
    for (int j = 0; j < 4; ++j) { v[j] = ((const f32x4*)xrow)[lane + 64 * j]; s += (v[j][0] * v[j][0] + v[j][1] * v[j][1]) + (v[j][2] * v[j][2] + v[j][3] * v[j][3]); }
    s = wave_sum(s);
#pragma unroll
    for (int j = 0; j < 4; ++j) { u32x2 w; w.x = cvtpk(v[j][0], v[j][1]); w.y = cvtpk(v[j][2], v[j][3]); ((u32x2*)orow)[lane + 64 * j] = w; }
    if (lane < 16) part[lane] = (lane == 0) ? s : 0.f;
}
__device__ __forceinline__ void rope_entry(int idx, float* cs, float* sn) {
    const int pos = idx >> 3, i = idx & 7;
    const float invf = (i == 0) ? 1.0f : (i == 1) ? 0.193922758102417f : (i == 2) ? 0.03760603070259094f : (i == 3) ? 0.00729266507551074f : (i == 4) ? 0.001414213445968926f
                     : (i == 5) ? 0.00027424818836152554f : (i == 6) ? 5.318296462064609e-05f : 1.0313385246263351e-05f;
    const float angf = (float)pos * invf;
    const double x = (double)angf; const double kq = rint(x * 0.6366197723675814);
    double r = fma(-kq, 1.5707963267948966, x); r = fma(-kq, 6.123233995736766e-17, r);
    const int q = ((int)kq) & 3; const double r2 = r * r;
    const double s = r * (1.0 + r2 * (-1.0 / 6 + r2 * (1.0 / 120 + r2 * (-1.0 / 5040 + r2 * (1.0 / 362880 + r2 * (-1.0 / 39916800 + r2 * (1.0 / 6227020800.0)))))));
    const double c = 1.0 + r2 * (-0.5 + r2 * (1.0 / 24 + r2 * (-1.0 / 720 + r2 * (1.0 / 40320 + r2 * (-1.0 / 3628800 + r2 * (1.0 / 479001600.0 + r2 * (-1.0 / 87178291200.0)))))));
    const double co = (q == 0) ? c : (q == 1) ? -s : (q == 2) ? -c : s;
    const double si = (q == 0) ? s : (q == 1) ? c : (q == 2) ? -s : -c;
    cs[idx] = (float)co; sn[idx] = (float)si;
}

__device__ __forceinline__ void transpose64(const bf16_t* src, int sp, bf16_t* dst, int dp, LAS uchar* scr, int lane) {
#pragma unroll
    for (int i = 0; i < 8; ++i) { const int r = i * 8 + (lane >> 3), c8 = lane & 7; const u32x4 v = *(const u32x4*)(src + (size_t)r * sp + c8 * 8);
        LAS unsigned* w = (LAS unsigned*)(scr + r * 132 + c8 * 16); w[0] = v.x; w[1] = v.y; w[2] = v.z; w[3] = v.w; }
    asm volatile("s_waitcnt lgkmcnt(0)" ::: "memory");
#pragma unroll
    for (int i = 0; i < 8; ++i) { const int c = i * 8 + (lane >> 3), r8 = lane & 7; unsigned e[8];
#pragma unroll
        for (int j = 0; j < 8; ++j) e[j] = *(const LAS unsigned short*)(scr + (r8 * 8 + j) * 132 + c * 2);
        u32x4 o; o.x = e[0] | (e[1] << 16); o.y = e[2] | (e[3] << 16); o.z = e[4] | (e[5] << 16); o.w = e[6] | (e[7] << 16);
        *(u32x4*)(dst + (size_t)c * dp + r8 * 8) = o; }
    asm volatile("s_waitcnt lgkmcnt(0)" ::: "memory");
}
__device__ __forceinline__ void conv_phase(const bf16_t* P, const float* cw, const float* cb, bf16_t* XC, int gtid, int nthr) {
    for (int it = gtid; it < (T / 16) * 128; it += nthr) {
        const int cg8 = it & 127, run = it >> 7, tok0 = run * 16, s0 = tok0 & (SEQ - 1), ch = cg8 * 8;
        float w[5][8], bias[8];
#pragma unroll
        for (int k = 0; k < 5; ++k) { const f32x4 a = *(const f32x4*)(cw + k * 1024 + ch), b = *(const f32x4*)(cw + k * 1024 + ch + 4);
#pragma unroll
            for (int e = 0; e < 4; ++e) { w[k][e] = a[e]; w[k][4 + e] = b[e]; } }
        { const f32x4 a = *(const f32x4*)(cb + ch), b = *(const f32x4*)(cb + ch + 4);
#pragma unroll
          for (int e = 0; e < 4; ++e) { bias[e] = a[e]; bias[4 + e] = b[e]; } }
        const bf16_t* src = P + (size_t)tok0 * PLD + PC_X + ch;
        float win[5][8];
#pragma unroll
        for (int j = 0; j < 4; ++j) { const int s = s0 + j - 2; u32x4 v = {0u, 0u, 0u, 0u}; if (s >= 0 && s < SEQ) v = *(const u32x4*)(src + (ptrdiff_t)(j - 2) * PLD);
            win[j][0] = bflo(v.x); win[j][1] = bfhi(v.x); win[j][2] = bflo(v.y); win[j][3] = bfhi(v.y); win[j][4] = bflo(v.z); win[j][5] = bfhi(v.z); win[j][6] = bflo(v.w); win[j][7] = bfhi(v.w); }
#pragma unroll
        for (int i = 0; i < 16; ++i) {
            { const int s = s0 + i + 2; u32x4 v = {0u, 0u, 0u, 0u}; if (s < SEQ) v = *(const u32x4*)(src + (ptrdiff_t)(i + 2) * PLD);
              float* d = win[(i + 4) % 5];
              d[0] = bflo(v.x); d[1] = bfhi(v.x); d[2] = bflo(v.y); d[3] = bfhi(v.y); d[4] = bflo(v.z); d[5] = bfhi(v.z); d[6] = bflo(v.w); d[7] = bfhi(v.w); }
            float o[8];
#pragma unroll
            for (int e = 0; e < 8; ++e) { float a = bias[e];
#pragma unroll
                for (int k = 0; k < 5; ++k) a += w[k][e] * win[(i + k) % 5][e];
                o[e] = silu_f(a); }
            u32x4 ov; ov.x = cvtpk(o[0], o[1]); ov.y = cvtpk(o[2], o[3]); ov.z = cvtpk(o[4], o[5]); ov.w = cvtpk(o[6], o[7]);
            *(u32x4*)(XC + (size_t)(tok0 + i) * 1024 + ch) = ov;
        }
    }
}

__device__ __forceinline__ float dpp_sum8(float v) {
    v += __builtin_bit_cast(float, __builtin_amdgcn_update_dpp(0, __builtin_bit_cast(int, v), 0xB1, 0xF, 0xF, true));
    v += __builtin_bit_cast(float, __builtin_amdgcn_update_dpp(0, __builtin_bit_cast(int, v), 0x4E, 0xF, 0xF, true));
    v += __builtin_bit_cast(float, __builtin_amdgcn_update_dpp(0, __builtin_bit_cast(int, v), 0x141, 0xF, 0xF, true));
    return v;
}
__device__ __forceinline__ void ssd_item(LAS uchar* lds, int b, int h, int dir, const bf16_t* XC, const float* DT, float Aneg, bf16_t* Y) {
    const int tid = opaque_tid(), p = tid >> 3, nq = tid & 7, g = h >> 2;
    LAS float* sB = (LAS float*)lds;
    LAS float* sC = sB + 64 * 128;
    LAS float* sX = sC + 64 * 128;
    LAS float* sY = sX + 64 * 64;
    LAS float* sDt = sY + 64 * 64;
    LAS float* sE = sDt + 64;
    float st[16];
#pragma unroll
    for (int k = 0; k < 16; ++k) st[k] = 0.f;
    u32x4 rb[2], rc[2], rx; float rdt = 0.f;
    const size_t tokb = (size_t)b * SEQ;
#define SSD_LOAD(blk) do { const int t0_ = dir ? (SEQ - 64 - (blk) * 64) : (blk) * 64; \
        _Pragma("unroll") for (int i_ = 0; i_ < 2; ++i_) { const int id_ = tid + 512 * i_, r_ = id_ >> 4, c_ = id_ & 15; const bf16_t* s_ = XC + (tokb + t0_ + r_) * 1024 + 512 + g * 128 + c_ * 8; \
            rb[i_] = *(const u32x4*)s_; rc[i_] = *(const u32x4*)(s_ + 256); } \
        { const int r_ = tid >> 3, c_ = tid & 7; rx = *(const u32x4*)(XC + (tokb + t0_ + r_) * 1024 + h * 64 + c_ * 8); } \
        if (tid < 64) rdt = DT[(tokb + t0_ + tid) * 16 + dir * 8 + h]; } while (0)
#define SSD_ST8(dst, v) do { f32x4 a_, b_; a_[0] = bflo((v).x); a_[1] = bfhi((v).x); a_[2] = bflo((v).y); a_[3] = bfhi((v).y); b_[0] = bflo((v).z); b_[1] = bfhi((v).z); b_[2] = bflo((v).w); b_[3] = bfhi((v).w); \
        *(LAS f32x4*)(dst) = a_; *(LAS f32x4*)((dst) + 4) = b_; } while (0)
#define SSD_STORE() do { \
        _Pragma("unroll") for (int i_ = 0; i_ < 2; ++i_) { const int id_ = tid + 512 * i_, r_ = id_ >> 4, c_ = id_ & 15; SSD_ST8(sB + r_ * 128 + c_ * 8, rb[i_]); SSD_ST8(sC + r_ * 128 + c_ * 8, rc[i_]); } \
        { const int r_ = tid >> 3, c_ = tid & 7; SSD_ST8(sX + r_ * 64 + c_ * 8, rx); } \
        if (tid < 64) { sDt[tid] = rdt; sE[tid] = __expf(rdt * Aneg); } } while (0)
    SSD_LOAD(0); SSD_STORE();
    __syncthreads();
    for (int blk = 0; blk < SEQ / 64; ++blk) {
        if (blk + 1 < SEQ / 64) SSD_LOAD(blk + 1);
        for (int j = 0; j < 64; ++j) {
            const int i = dir ? 63 - j : j;
            const float e = sE[i], xdt = sX[i * 64 + p] * sDt[i];
            const LAS f32x4* bp = (const LAS f32x4*)(sB + i * 128 + nq * 16); const LAS f32x4* cp = (const LAS f32x4*)(sC + i * 128 + nq * 16);
            float acc = 0.f;
#pragma unroll
            for (int q = 0; q < 4; ++q) { const f32x4 bv = bp[q], cv = cp[q];
#pragma unroll
                for (int k = 0; k < 4; ++k) { st[4 * q + k] = st[4 * q + k] * e + xdt * bv[k]; acc += cv[k] * st[4 * q + k]; } }
            acc = dpp_sum8(acc);
            if (nq == 0) sY[i * 64 + p] = acc;
        }
        __syncthreads();
        { const int t0 = dir ? (SEQ - 64 - blk * 64) : blk * 64; const int r = tid >> 3, c = tid & 7; const LAS f32x4* yp = (const LAS f32x4*)(sY + r * 64 + c * 8); const f32x4 a = yp[0], bq = yp[1];
          u32x4 w; w.x = cvtpk(a[0], a[1]); w.y = cvtpk(a[2], a[3]); w.z = cvtpk(bq[0], bq[1]); w.w = cvtpk(bq[2], bq[3]);
          *(u32x4*)(Y + (tokb + t0 + r) * 512 + h * 64 + c * 8) = w; }
        if (blk + 1 < SEQ / 64) SSD_STORE();
        __syncthreads();
    }
#undef SSD_LOAD
#undef SSD_ST8
#undef SSD_STORE
}

__device__ __forceinline__ int crow(int r, int hi) { return (r & 3) + 8 * (r >> 2) + 4 * hi; }
#define MFMA32(a, b, c) __builtin_amdgcn_mfma_f32_32x32x16_bf16((a), (b), (c), 0, 0, 0)
template <int DQK, int KW, int DVT, int NT, int MODE, bool PIPE>
__device__ __forceinline__ void attn_item(LAS uchar* lds, const bf16_t* qptr, int qpitch, const bf16_t* kptr, int kpitch, int kwcol, const bf16_t* vtptr, int vtpitch, int vrow,
                                          bf16_t* outp, int opitch, float lam, const float* subg) {
    constexpr int KROW = KW * 2 + 16, KBUF = 64 * KROW, VROW = 136, VBUF = DVT * VROW, NKP = 64 * (KW / 8) / 512, NVP = DVT * 8 / 512, NS = DQK / 16;
    static_assert(2 * KBUF + 2 * VBUF <= PTAB_OFF && 128 * 256 * 4 + 1024 <= PTAB_OFF, "attention LDS");
    const int tid = opaque_tid(), lane = tid & 63, wid = __builtin_amdgcn_readfirstlane(tid >> 6), qg = wid >> 1, t = wid & 1, l31 = lane & 31, hi = lane >> 5;
    bf16x8 qf[NS];
    { const bf16_t* qr = qptr + (size_t)(qg * 32 + l31) * qpitch + 8 * hi;
#pragma unroll
      for (int s = 0; s < NS; ++s) qf[s] = *(const bf16x8*)(qr + 16 * s); }
    f32x16 o[4];
#pragma unroll
    for (int d = 0; d < 4; ++d)
#pragma unroll
        for (int r = 0; r < 16; ++r) o[d][r] = 0.f;
    float m = -1e30f, l = 0.f;
    u32x4 kst[NKP], vst[NVP];
#define AT_LOAD(tile) do { \
        _Pragma("unroll") for (int i_ = 0; i_ < NKP; ++i_) { const int id_ = tid + 512 * i_, r_ = id_ / (KW / 8), c_ = id_ % (KW / 8); kst[i_] = *(const u32x4*)(kptr + (size_t)((tile) * 64 + r_) * kpitch + c_ * 8); } \
        _Pragma("unroll") for (int i_ = 0; i_ < NVP; ++i_) { const int id_ = tid + 512 * i_, r_ = id_ >> 3, c_ = id_ & 7; vst[i_] = *(const u32x4*)(vtptr + (size_t)r_ * vtpitch + (tile) * 64 + c_ * 8); } } while (0)
#define AT_STORE(buf) do { \
        _Pragma("unroll") for (int i_ = 0; i_ < NKP; ++i_) { const int id_ = tid + 512 * i_, r_ = id_ / (KW / 8), c_ = id_ % (KW / 8); *(LAS u32x4*)(lds + (buf) * KBUF + r_ * KROW + c_ * 16) = kst[i_]; } \
        _Pragma("unroll") for (int i_ = 0; i_ < NVP; ++i_) { const int id_ = tid + 512 * i_, r_ = id_ >> 3, c_ = id_ & 7; LAS u32x2* d_ = (LAS u32x2*)(lds + 2 * KBUF + (buf) * VBUF + r_ * VROW + c_ * 16); \
            d_[0] = (u32x2){vst[i_].x, vst[i_].y}; d_[1] = (u32x2){vst[i_].z, vst[i_].w}; } } while (0)
    if (PIPE) { AT_LOAD(0); AT_STORE(0); __syncthreads(); }
    for (int tile = 0; tile < NT; ++tile) {
        if (PIPE) { if (tile + 1 < NT) AT_LOAD(tile + 1); }
        else { AT_LOAD(tile); AT_STORE(tile & 1); __syncthreads(); }
        const LAS uchar* kb = lds + (tile & 1) * KBUF; const LAS uchar* vb = lds + 2 * KBUF + (tile & 1) * VBUF;
        f32x16 s0, s1;
#pragma unroll
        for (int r = 0; r < 16; ++r) { s0[r] = 0.f; s1[r] = 0.f; }
        { const LAS uchar* ka = kb + l31 * KROW + (kwcol + 8 * hi) * 2;
#pragma unroll
          for (int s = 0; s < NS; ++s) { const bf16x8 a0 = *(const LAS bf16x8*)(ka + 32 * s), a1 = *(const LAS bf16x8*)(ka + 32 * KROW + 32 * s);
              s0 = MFMA32(a0, qf[s], s0); s1 = MFMA32(a1, qf[s], s1); } }
        float mx = fmaxf(s0[0], s1[0]);
#pragma unroll
        for (int r = 1; r < 16; ++r) mx = fmaxf(mx, fmaxf(s0[r], s1[r]));
        mx = fmaxf(mx, __shfl_xor(mx, 32));
        const float mnew = fmaxf(m, mx); const float alpha = fast_exp2(m - mnew);
        if (__any(mnew > m)) {
#pragma unroll
            for (int r = 0; r < 16; ++r) { const float ar = __shfl(alpha, crow(r, hi));
#pragma unroll
                for (int d = 0; d < 4; ++d) o[d][r] *= ar; }
        }
        m = mnew; float ps = 0.f;
#pragma unroll
        for (int r = 0; r < 16; ++r) { s0[r] = fast_exp2(s0[r] - m); s1[r] = fast_exp2(s1[r] - m); ps += s0[r] + s1[r]; }
        l = l * alpha + ps;
#pragma unroll
        for (int kt = 0; kt < 2; ++kt)
#pragma unroll
            for (int j = 0; j < 2; ++j) {
                u32x4 pw;
                if (kt == 0) { pw.x = cvtpk(s0[8 * j], s0[8 * j + 1]); pw.y = cvtpk(s0[8 * j + 2], s0[8 * j + 3]); pw.z = cvtpk(s0[8 * j + 4], s0[8 * j + 5]); pw.w = cvtpk(s0[8 * j + 6], s0[8 * j + 7]); }
                else         { pw.x = cvtpk(s1[8 * j], s1[8 * j + 1]); pw.y = cvtpk(s1[8 * j + 2], s1[8 * j + 3]); pw.z = cvtpk(s1[8 * j + 4], s1[8 * j + 5]); pw.w = cvtpk(s1[8 * j + 6], s1[8 * j + 7]); }
                const bf16x8 pa = __builtin_bit_cast(bf16x8, pw);
#pragma unroll
                for (int d = 0; d < 4; ++d) { const LAS uchar* va = vb + (vrow + 32 * d + l31) * VROW + (32 * kt + 16 * j + 4 * hi) * 2;
                    const u32x2 lo = *(const LAS u32x2*)va, hh = *(const LAS u32x2*)(va + 16);
                    u32x4 vw; vw.x = lo.x; vw.y = lo.y; vw.z = hh.x; vw.w = hh.y;
                    o[d] = MFMA32(pa, __builtin_bit_cast(bf16x8, vw), o[d]); }
            }
        if (PIPE) { if (tile + 1 < NT) AT_STORE((tile + 1) & 1); __syncthreads(); }
    }
    if (!PIPE) __syncthreads();
#undef AT_LOAD
#undef AT_STORE
    l += __shfl_xor(l, 32);
    LAS float* ex = (LAS float*)lds; LAS float* lsum = (LAS float*)(lds + 128 * 256 * 4);
#pragma unroll
    for (int d = 0; d < 4; ++d)
#pragma unroll
        for (int r = 0; r < 16; ++r) ex[(qg * 32 + crow(r, hi)) * 256 + t * 128 + 32 * d + l31] = o[d][r];
    if (hi == 0) lsum[t * 128 + qg * 32 + l31] = l;
    __syncthreads();
    for (int rr = 0; rr < 16; ++rr) {
        const int q = wid * 16 + rr;
        if (MODE == 0) {
            const float i1 = 1.0f / lsum[q], i2 = lam / lsum[128 + q];
            const f32x2 o1 = ((const LAS f32x2*)(ex + q * 256))[lane], o2 = ((const LAS f32x2*)(ex + q * 256 + 128))[lane];
            const float a = o1.x * i1 - o2.x * i2, bq = o1.y * i1 - o2.y * i2;
            const float ss = wave_sum(a * a + bq * bq); const float rn = (1.0f - LAMBDA_INIT) / sqrtf(ss * (1.0f / 128.0f) + EPS);
            *(unsigned*)(outp + (size_t)q * opitch + 2 * lane) = cvtpk(a * rn * subg[2 * lane], bq * rn * subg[2 * lane + 1]);
        } else {
            const float inv = 1.0f / lsum[q]; const f32x4 v = ((const LAS f32x4*)(ex + q * 256))[lane];
            u32x2 w; w.x = cvtpk(v[0] * inv, v[1] * inv); w.y = cvtpk(v[2] * inv, v[3] * inv);
            *(u32x2*)(outp + (size_t)q * opitch + 4 * lane) = w;
        }
    }
    __syncthreads();
}

#ifndef PHASE_MASK
#define PHASE_MASK 0xFFFF
#endif
#define PH_ON(k) ((PHASE_MASK >> (k)) & 1)
#define PH_IDS const int tid = opaque_tid(), lane = tid & 63, wave = __builtin_amdgcn_readfirstlane(tid >> 6), gw = bx * 8 + wave, gtid = bx * 512 + tid; (void)lane; (void)gw; (void)gtid; (void)wave
struct Args { const float* in[32]; float* out; unsigned char* ws; int ph_lo, ph_hi; };
constexpr int N_PHASES = 14;

__global__ void __launch_bounds__(512, 2) mega_fwd(Args a) {
    extern __shared__ __attribute__((aligned(16))) unsigned char lds_raw[];
    LAS uchar* lds = (LAS uchar*)lds_raw;
    const int G = (int)gridDim.x, bx = (int)blockIdx.x, NGW = G * 8, NTHR = G * 512;
    LAS unsigned long long* ptab = (LAS unsigned long long*)(lds + PTAB_OFF);
    if (threadIdx.x < 32) ptab[threadIdx.x] = (unsigned long long)a.in[threadIdx.x];
    __syncthreads();
#define INP(k) ((const float*)(((unsigned long long)(unsigned)__builtin_amdgcn_readfirstlane((int)(ptab[k] >> 32)) << 32) | (unsigned long long)(unsigned)__builtin_amdgcn_readfirstlane((int)(ptab[k] & 0xffffffffull))))
    if (a.ph_lo == 0 && PH_ON(0)) {
        float* rope_cs = (float*)(a.ws + WS_ROPE);
        for (int i = bx * 512 + (int)threadIdx.x; i < SEQ * 8; i += NTHR) rope_entry(i, rope_cs, rope_cs + SEQ * 8);
    }
    for (int ph = a.ph_lo; ph < a.ph_hi; ++ph) {
        unsigned char* ws = a.ws; asm volatile("" : "+s"(ws));
        float* lamp = (float*)(ws + WS_CTL);
        float* rope_cs = (float*)(ws + WS_ROPE); float* rope_sn = rope_cs + SEQ * 8;
        float* SS0 = (float*)(ws + WS_SS0); float* SS1 = (float*)(ws + WS_SS1); float* SS2 = (float*)(ws + WS_SS2); float* SS3 = (float*)(ws + WS_SS3); float* SS4 = (float*)(ws + WS_SS4); float* SSM = (float*)(ws + WS_SSM);
        float* DTB = (float*)(ws + WS_DT);
        bf16_t* WGU1 = (bf16_t*)(ws + WS_WGU1); bf16_t* WD1 = (bf16_t*)(ws + WS_WD1); bf16_t* WIN = (bf16_t*)(ws + WS_WIN); bf16_t* WOUT = (bf16_t*)(ws + WS_WOUT);
        bf16_t* WQ = (bf16_t*)(ws + WS_WQ); bf16_t* WKV = (bf16_t*)(ws + WS_WKV); bf16_t* WO = (bf16_t*)(ws + WS_WO); bf16_t* WGU2 = (bf16_t*)(ws + WS_WGU2); bf16_t* WD2 = (bf16_t*)(ws + WS_WD2);
        bf16_t* MEMB = (bf16_t*)(ws + WS_MEMB); bf16_t* KVX = (bf16_t*)(ws + WS_KVX); bf16_t* VTX = (bf16_t*)(ws + WS_VTX); bf16_t* VT = (bf16_t*)(ws + WS_VT);
        bf16_t* XB = (bf16_t*)(ws + WS_XB); bf16_t* XC = XB;
        bf16_t* YMIX = (bf16_t*)(ws + WS_YMIX); bf16_t* OX = YMIX;
        bf16_t* YF = (bf16_t*)(ws + WS_YFB); bf16_t* YB = YF + (size_t)T * 512; bf16_t* QX = YF;
        bf16_t* BIG = (bf16_t*)(ws + WS_BIG); bf16_t* U = BIG; bf16_t* PROJ = BIG;
        float* out = a.out;

        if (ph == 0 && PH_ON(0)) {
            PH_IDS;
            LAS float* scr = (LAS float*)(lds + wave * 16384);
            constexpr int I_G = 16 * 88, I_D = 44 * 32, I_IN = 16 * 97, I_SQ = 16 * 32, I_KV = 16 * 64;
            constexpr int NITEMS = 6 * I_G + I_IN + 3 * I_SQ + I_KV;
            static_assert(I_G == I_D, "item counts");
            for (int it = gw; it < NITEMS; it += NGW) {
                int r = it; const float* W; const float* gq = nullptr; bf16_t* WT; int K = DM, N = DM, kind = 0;
                if (r < 3 * I_G) { const int w = r / I_G; r -= w * I_G; if (w == 2) { W = INP(5); K = FF; WT = WD1; } else { W = INP(3 + w); N = FF; WT = WGU1; kind = 1 + w; gq = INP(2); } }
                else if (r < 6 * I_G) { r -= 3 * I_G; const int w = r / I_G; r -= w * I_G; if (w == 2) { W = INP(30); K = FF; WT = WD2; } else { W = INP(28 + w); N = FF; WT = WGU2; kind = 1 + w; gq = INP(27); } }
                else if (r < 6 * I_G + I_IN) { r -= 6 * I_G; W = INP(7); N = 3088; WT = WIN; kind = 3; gq = INP(6); }
                else { r -= 6 * I_G + I_IN;
                    if (r < I_SQ) { W = INP(21); WT = WOUT; }
                    else if (r < 2 * I_SQ) { r -= I_SQ; W = INP(24); WT = WQ; gq = INP(22); }
                    else if (r < 3 * I_SQ) { r -= 2 * I_SQ; W = INP(26); WT = WO; }
                    else { r -= 3 * I_SQ; W = INP(25); N = 2 * DM; WT = WKV; gq = INP(23); } }
                p0_transpose_item(W, K, N, WT, kind, gq, scr, r, lane);
            }
            for (int mrow = gw; mrow < T; mrow += NGW) row_to_bf16_ss(INP(0) + (size_t)mrow * DM, XB + (size_t)mrow * DM, SS0 + (size_t)mrow * 16, lane);
            for (int mrow = gw; mrow < TM; mrow += NGW) row_to_bf16_ss(INP(1) + (size_t)mrow * DM, MEMB + (size_t)mrow * DM, SSM + (size_t)mrow * 16, lane);
            for (int i = gtid; i < (NPROJ - 3088) * DM / 8; i += NTHR) ((u32x4*)(WIN + (size_t)3088 * DM))[i] = (u32x4){0u, 0u, 0u, 0u};
            if (bx == 0 && wave == 0) {
                const float s1 = wave_sum(INP(16)[lane] * INP(17)[lane]), s2 = wave_sum(INP(18)[lane] * INP(19)[lane]);
                if (lane == 0) lamp[0] = __expf(s1) - __expf(s2) + LAMBDA_INIT;
            }
        } else if (PH_ON(1) && (ph == 1 || ph == 2 || ph == 3 || ph == 7 || ph == 8 || ph == 10 || ph == 11 || ph == 12)) {
            for (int sub = 0; sub < 2; ++sub) {
                if (sub == 1 && ph != 1) break;
                GJob j; j.E = EpiAny{0, ws, 1.0f, 0u, 0u, 0u, 0u, 0, 0, out};
                if (ph == 1 && sub == 0) { j.A = XB; j.Bt = WGU1; j.M = T; j.N = 2 * FF; j.K = DM; j.E.kind = 1; j.E.part_off = (unsigned)WS_SS0; j.E.o_off = (unsigned)WS_BIG; }
                else if (ph == 1)        { j.A = MEMB; j.Bt = WKV; j.M = TM; j.N = 2 * DM; j.K = DM; j.E.kind = 0; j.E.part_off = (unsigned)WS_SSM; j.E.o_off = (unsigned)WS_KVX; j.E.ldc = 2 * DM; }
                else if (ph == 2)        { j.A = U; j.Bt = WD1; j.M = T; j.N = DM; j.K = FF; j.E.kind = 2; j.E.res_is_x = 1; j.E.scale = 0.5f; j.E.xb_off = (unsigned)WS_XB; j.E.opart_off = (unsigned)WS_SS1; }
                else if (ph == 3)        { j.A = XB; j.Bt = WIN; j.M = T; j.N = NPROJ; j.K = DM; j.E.kind = 3; j.E.part_off = (unsigned)WS_SS1; j.E.o_off = (unsigned)WS_BIG; }
                else if (ph == 7)        { j.A = YMIX; j.Bt = WOUT; j.M = T; j.N = DM; j.K = DM; j.E.kind = 2; j.E.xb_off = (unsigned)WS_XB; j.E.opart_off = (unsigned)WS_SS2; }
                else if (ph == 8)        { j.A = XB; j.Bt = WQ; j.M = T; j.N = DM; j.K = DM; j.E.kind = 0; j.E.part_off = (unsigned)WS_SS2; j.E.scale = 0.0625f * LOG2E; j.E.o_off = (unsigned)WS_YFB; j.E.ldc = DM; }
                else if (ph == 10)       { j.A = OX; j.Bt = WO; j.M = T; j.N = DM; j.K = DM; j.E.kind = 2; j.E.xb_off = (unsigned)WS_XB; j.E.opart_off = (unsigned)WS_SS3; }
                else if (ph == 11)       { j.A = XB; j.Bt = WGU2; j.M = T; j.N = 2 * FF; j.K = DM; j.E.kind = 1; j.E.part_off = (unsigned)WS_SS3; j.E.o_off = (unsigned)WS_BIG; }
                else                     { j.A = U; j.Bt = WD2; j.M = T; j.N = DM; j.K = FF; j.E.kind = 2; j.E.scale = 0.5f; j.E.xb_off = 0u; j.E.opart_off = (unsigned)WS_SS4; }
                run_gemm(lds, j.A, j.Bt, j.M, j.N, j.K, j.E);
            }
        } else if (ph == 4 && PH_ON(4)) {
            PH_IDS;
            conv_phase(PROJ, INP(8), INP(9), XC, gtid, NTHR);
            LAS uchar* scr = lds + wave * 8448;
            for (int it = gw; it < NB * 4 * 2 * 64; it += NGW) { const int st = it & 63, dt = (it >> 6) & 1, bh = it >> 7, b = bh >> 2, h = bh & 3;
                transpose64(PROJ + (size_t)(b * SEQ + st * 64) * PLD + PC_V + h * 128 + dt * 64, PLD, VT + (size_t)(bh * 128 + dt * 64) * SEQ + st * 64, SEQ, scr, lane); }
            for (int it = gw; it < NB * 4 * 4 * 4; it += NGW) { const int mt = it & 3, dt = (it >> 2) & 3, bh = it >> 4, b = bh >> 2, h = bh & 3;
                transpose64(KVX + (size_t)(b * MEML + mt * 64) * (2 * DM) + DM + h * 256 + dt * 64, 2 * DM, VTX + (size_t)(bh * 256 + dt * 64) * MEML + mt * 64, MEML, scr, lane); }
        } else if (ph == 5 && PH_ON(5)) {
            PH_IDS;
            for (int it = bx; it < NB * 8 * 2; it += G) { const int dir = it & 1, h = (it >> 1) & 7, b = it >> 4;
                const float Aneg = -__expf(dir ? INP(13)[h] : INP(12)[h]);
                ssd_item(lds, b, h, dir, XC, DTB, Aneg, dir ? YB : YF); }
            for (int i = 0;; ++i) {
                int bh, qb;
                if (G == 256) { if (i >= 8) break; bh = i * 8 + (bx & 7); qb = bx >> 3; }
                else { const int L = i * G + bx; if (L >= 2048) break; bh = L >> 5; qb = L & 31; }
                const int b = bh >> 2, h = bh & 3; const size_t row0 = (size_t)b * SEQ + qb * 128;
                const int t = wave & 1;
                attn_item<64, 128, 128, 64, 0, true>(lds, PROJ + row0 * PLD + PC_Q + h * 128 + t * 64, PLD, PROJ + (size_t)b * SEQ * PLD + PC_K + h * 128, PLD, t * 64,
                                               VT + (size_t)bh * 128 * SEQ, SEQ, 0, YMIX + row0 * DM + 512 + h * 128, DM, lamp[0], INP(20));
            }
        } else if (ph == 6 && PH_ON(6)) {
            PH_IDS;
            for (int it = gw; it < T * 2; it += NGW) { const int tok = it >> 1, g = it & 1, c = g * 256 + 4 * lane, h = c >> 6;
                const u32x2 yf = *(const u32x2*)(YF + (size_t)tok * 512 + c), yb = *(const u32x2*)(YB + (size_t)tok * 512 + c), xv = *(const u32x2*)(XC + (size_t)tok * 1024 + c), zv = *(const u32x2*)(PROJ + (size_t)tok * PLD + PC_Z + c);
                const float D = INP(14)[h];
                float y[4];
                y[0] = (bflo(yf.x) + bflo(yb.x) + D * bflo(xv.x)) * silu_f(bflo(zv.x)); y[1] = (bfhi(yf.x) + bfhi(yb.x) + D * bfhi(xv.x)) * silu_f(bfhi(zv.x));
                y[2] = (bflo(yf.y) + bflo(yb.y) + D * bflo(xv.y)) * silu_f(bflo(zv.y)); y[3] = (bfhi(yf.y) + bfhi(yb.y) + D * bfhi(xv.y)) * silu_f(bfhi(zv.y));
                const float ss = wave_sum((y[0] * y[0] + y[1] * y[1]) + (y[2] * y[2] + y[3] * y[3])); const float rn = 1.0f / sqrtf(ss * (1.0f / 256.0f) + EPS);
                const f32x4 gv = *(const f32x4*)(INP(15) + c);
                u32x2 w; w.x = cvtpk(y[0] * rn * gv[0], y[1] * rn * gv[1]); w.y = cvtpk(y[2] * rn * gv[2], y[3] * rn * gv[3]);
                *(u32x2*)(YMIX + (size_t)tok * DM + c) = w; }
        } else if (ph == 9 && PH_ON(9)) {
            PH_IDS;
            for (int i = 0;; ++i) {
                int bh, qb;
                if (G == 256) { if (i >= 8) break; bh = i * 8 + (bx & 7); qb = bx >> 3; }
                else { const int L = i * G + bx; if (L >= 2048) break; bh = L >> 5; qb = L & 31; }
                const int b = bh >> 2, h = bh & 3; const size_t row0 = (size_t)b * SEQ + qb * 128;
                const int t = wave & 1;
                attn_item<256, 256, 256, 4, 1, false>(lds, QX + row0 * DM + h * 256, DM, KVX + (size_t)b * MEML * (2 * DM) + h * 256, 2 * DM, 0,
                                               VTX + (size_t)bh * 256 * MEML, MEML, t * 128, OX + row0 * DM + h * 256, DM, 0.f, nullptr);
            }
        } else if (ph == 13 && PH_ON(13)) {
            PH_IDS;
            for (int row = gw; row < T; row += NGW) { const float rs = row_rs(SS4, row); f32x4* xr = (f32x4*)(out + (size_t)row * DM);
#pragma unroll
                for (int j = 0; j < 4; ++j) { const f32x4 gv = ((const f32x4*)INP(31))[lane + 64 * j]; xr[lane + 64 * j] = xr[lane + 64 * j] * rs * gv; } }
        }
        if (ph + 1 < a.ph_hi) cg::this_grid().sync();
    }
}

extern "C" void kernel_launch(void* const* d_in, const int* in_sizes, int n_in, void* d_out, int out_size, void* d_ws, size_t ws_size, hipStream_t stream) {
    static int grid = 0;
    if (grid == 0) {
        if (n_in != 32 || in_sizes[0] != T * DM || out_size != T * DM || ws_size < WS_END) {
            fprintf(stderr, "kernel_launch: unexpected shapes (n_in %d, in0 %d, out %d, ws %zu < %zu); nothing launched\n", n_in, n_in > 0 ? in_sizes[0] : -1, out_size, ws_size, (size_t)WS_END); grid = -1; return; }
        int dev = 0, cus = 0, per_cu = 0;
        hipGetDevice(&dev); hipDeviceGetAttribute(&cus, hipDeviceAttributeMultiprocessorCount, dev);
        if (hipFuncSetAttribute((const void*)mega_fwd, hipFuncAttributeMaxDynamicSharedMemorySize, LDS_BYTES) != hipSuccess) { fprintf(stderr, "kernel_launch: hipFuncSetAttribute failed\n"); grid = -1; return; }
        if (hipOccupancyMaxActiveBlocksPerMultiprocessor(&per_cu, (const void*)mega_fwd, 512, LDS_BYTES) != hipSuccess || per_cu < 1) { fprintf(stderr, "kernel_launch: occupancy query says %d\n", per_cu); per_cu = 1; }
        (void)hipGetLastError();
        grid = cus * per_cu;
        if (grid <= 0) grid = 256;
    }
    if (grid < 0) return;
    Args a{};
    for (int i = 0; i < 32; ++i) a.in[i] = (const float*)d_in[i];
    a.out = (float*)d_out; a.ws = (unsigned char*)d_ws;
#if MK_COOP
    a.ph_lo = 0; a.ph_hi = N_PHASES;
    void* kargs[] = {&a};
    hipError_t e = hipLaunchCooperativeKernel((const void*)mega_fwd, dim3(grid), dim3(512), kargs, LDS_BYTES, stream);
    if (e != hipSuccess) fprintf(stderr, "kernel_launch: cooperative launch failed: %s (grid %d)\n", hipGetErrorString(e), grid);
#else
    for (int ph = 0; ph < N_PHASES; ++ph) { a.ph_lo = ph; a.ph_hi = ph + 1; hipLaunchKernelGGL(mega_fwd, dim3(grid), dim3(512), LDS_BYTES, stream, a); }
#endif
}
```

```cpp
#include <hip/hip_runtime.h>
#include <hip/hip_cooperative_groups.h>
#include <cstdio>
#include <cstdint>
namespace cg = cooperative_groups;
#ifndef MK_COOP
#define MK_COOP 1
#endif
namespace pg8 {
#define PG8_LAS __attribute__((address_space(3)))
typedef unsigned short bf16_t;
typedef short bf16x8 __attribute__((ext_vector_type(8)));
typedef float f32x4 __attribute__((ext_vector_type(4)));
typedef unsigned u32x4 __attribute__((ext_vector_type(4)));
constexpr int BM = 256, BK = 64, HALF = 128, HTB = HALF * BK * 2  , STAGE_BYTES = 8 * HTB, NXCD = 8, WGM = 8;

__host__ __device__ __forceinline__ int lds_byte(int r, int c) { const int st = (r >> 4) * 2 + (c >> 5), rr = r & 15, cc = c & 31, ob = rr * 64 + cc * 2; return st * 1024 + (ob ^ (((ob >> 9) & 1) << 5)); }
__host__ __device__ __forceinline__ void stage_rc(int b, int& R, int& C) { const int st = b / 1024, sb = b % 1024, swz = sb ^ (((sb >> 9) & 1) << 5); R = (st >> 1) * 16 + swz / 64; C = (st & 1) * 32 + (swz % 64) / 2; }
__host__ __device__ __forceinline__ int perm32(int rho) { const int n = rho >> 4, i = rho & 15; return 8 * (i >> 2) + 4 * n + (i & 3); }

struct Unit { int pm, pn; };
struct Gemm { const bf16_t* A; const bf16_t* Bt; int M, N, K; };

struct StaticOrder {
    int nM, nN, nwg, G, c;
    __host__ __device__ void init(int M, int N, int G_, int c_) { nM = M / BM; nN = N / BM; nwg = nM * nN; G = G_; c = c_; }
    __host__ __device__ bool next(int i, Unit& u) const {
        const long L = (long)i * G + c; if (L >= nwg) return false;
        int wgid = (int)L; { const int q = nwg / NXCD, r = nwg % NXCD, xcd = wgid % NXCD, off = wgid / NXCD; wgid = (xcd < r ? xcd * (q + 1) : r * (q + 1) + (xcd - r) * q) + off; }
        const int nig = WGM * nN, gid = wgid / nig, fm = gid * WGM, gsz = (nM - fm) < WGM ? (nM - fm) : WGM;
        u.pm = fm + ((wgid % nig) % gsz); u.pn = (wgid % nig) / gsz; return true;
    }
    __device__ __forceinline__ void a_ready(const Unit&) const {}
    __device__ __forceinline__ void done(const Unit&) const {}
};
__device__ __forceinline__ unsigned cvt_pk_bf16(float lo, float hi) { unsigned r; asm volatile("v_cvt_pk_bf16_f32 %0, %1, %2" : "=v"(r) : "v"(lo), "v"(hi)); return r; }
template <class Epi, class Sched, bool ALIGN_EPI = false, bool SP2 = false>
__device__ __forceinline__ void gemm_phase(PG8_LAS unsigned char* lds, const Gemm g, const Sched& S, const Epi& E) {
    int tid = threadIdx.x; asm volatile("" : "+v"(tid)); const int wid = __builtin_amdgcn_readfirstlane(tid >> 6), lane = tid & 63, wr = wid >> 2, wc = wid & 3, fr = lane & 15, fq = lane >> 4;
    const int K = g.K, nt = K / BK;
    unsigned voffA[2], voffB[2];
#pragma unroll
    for (int i = 0; i < 2; ++i) { int R, C; stage_rc(tid * 16 + i * 8192, R, C); const int Rb = Epi::PERM ? ((R & ~31) + perm32(R & 31)) : R;
        voffA[i] = (unsigned)(R * K + C) * 2u; voffB[i] = (unsigned)(Rb * K + C) * 2u; }
    const size_t kstep = (size_t)(BK * 2);
    const size_t hstep = (size_t)HALF * K * 2;
    const size_t tstep = 2 * hstep;
    const unsigned ldsw = (unsigned)wid * 1024u;
    const int aoff = lds_byte(wr * 64 + fr, fq * 8), boff = lds_byte(wc * 32 + fr, fq * 8);
#define PG8_SA(b, h) (((b) * 2 + (h)) * HTB)
#define PG8_SB(b, h) ((4 + (b) * 2 + (h)) * HTB)
#define PG8_STAGE(bufoff, gbase, voff) do { _Pragma("unroll") for (int _i = 0; _i < 2; ++_i) \
        __builtin_amdgcn_global_load_lds((const unsigned*)((const char*)(gbase) + (voff)[_i]), (PG8_LAS unsigned*)(lds + (bufoff) + ldsw + _i * 8192), 16, 0, 0); } while (0)
#define PG8_LDA(dst, b, h) do { _Pragma("unroll") for (int m = 0; m < 4; ++m) _Pragma("unroll") for (int k = 0; k < 2; ++k) dst[m][k] = *(const PG8_LAS bf16x8*)(lds + PG8_SA(b, h) + aoff + m * 2048 + k * 1024); } while (0)
#define PG8_LDB(dst, b, h) do { _Pragma("unroll") for (int n = 0; n < 2; ++n) _Pragma("unroll") for (int k = 0; k < 2; ++k) dst[n][k] = *(const PG8_LAS bf16x8*)(lds + PG8_SB(b, h) + boff + n * 2048 + k * 1024); } while (0)
#define PG8_MMA(ai, bj, At, Bt) do { __builtin_amdgcn_s_setprio(1); _Pragma("unroll") for (int m = 0; m < 4; ++m) _Pragma("unroll") for (int n = 0; n < 2; ++n) _Pragma("unroll") for (int k = 0; k < 2; ++k) \
        acc[ai][bj][m][n] = __builtin_amdgcn_mfma_f32_16x16x32_bf16(Bt[n][k], At[m][k], acc[ai][bj][m][n], 0, 0, 0); __builtin_amdgcn_s_setprio(0); } while (0)
#define PG8_WAIT_V(n) asm volatile("s_waitcnt vmcnt(" #n ")" ::: "memory")
#define PG8_WAIT_L(n) asm volatile("s_waitcnt lgkmcnt(" #n ")" ::: "memory")
#define PG8_BAR __builtin_amdgcn_s_barrier()
#define PG8_SCHED __builtin_amdgcn_sched_barrier(0)
    Unit cur, nxt; int ui = 0;
    if (!S.next(0, cur)) return;
    f32x4 acc[2][2][4][2];
#pragma unroll
    for (int a = 0; a < 2; ++a)
#pragma unroll
        for (int b = 0; b < 2; ++b)
#pragma unroll
            for (int m = 0; m < 4; ++m)
#pragma unroll
                for (int n = 0; n < 2; ++n) acc[a][b][m][n] = (f32x4){0.f, 0.f, 0.f, 0.f};
    bf16x8 At[4][2], B0[2][2], B1[2][2];
    const char* cA = (const char*)g.A + (size_t)cur.pm * tstep; const char* cB = (const char*)g.Bt + (size_t)cur.pn * tstep;
    S.a_ready(cur);
    if constexpr (SP2) {
        PG8_STAGE(PG8_SB(0, 0), cB, voffB); PG8_STAGE(PG8_SB(0, 1), cB + hstep, voffB); PG8_STAGE(PG8_SA(0, 0), cA, voffA); PG8_STAGE(PG8_SA(0, 1), cA + hstep, voffA);
        if (wr == 1) PG8_BAR;
        PG8_WAIT_V(2); PG8_BAR;
        PG8_STAGE(PG8_SB(1, 0), cB + kstep, voffB); PG8_STAGE(PG8_SA(1, 0), cA + kstep, voffA); PG8_STAGE(PG8_SB(1, 1), cB + hstep + kstep, voffB);
        PG8_WAIT_V(6); PG8_BAR;
    } else {
        PG8_STAGE(PG8_SB(0, 0), cB, voffB); PG8_STAGE(PG8_SA(0, 0), cA, voffA); PG8_STAGE(PG8_SB(0, 1), cB + hstep, voffB); PG8_STAGE(PG8_SA(0, 1), cA + hstep, voffA);
        if (wr == 1) PG8_BAR;
        PG8_WAIT_V(4); PG8_BAR;
        PG8_STAGE(PG8_SB(1, 0), cB + kstep, voffB); PG8_STAGE(PG8_SA(1, 0), cA + kstep, voffA); PG8_STAGE(PG8_SB(1, 1), cB + hstep + kstep, voffB);
        PG8_WAIT_V(6); PG8_BAR;
    }
    for (;;) {
        const bool has_next = S.next(ui + 1, nxt);
        const char* nA = has_next ? (const char*)g.A + (size_t)nxt.pm * tstep : cA; const char* nB = has_next ? (const char*)g.Bt + (size_t)nxt.pn * tstep : cB;
        for (int t = 0; t < nt; t += 2) {
            const bool last = (t == nt - 2);
            const char* a1 = cA + (size_t)(t + 1) * kstep;
            const char* a2 = last ? nA : cA + (size_t)(t + 2) * kstep; const char* b2 = last ? nB : cB + (size_t)(t + 2) * kstep;
            const char* a3 = a2 + kstep; const char* b3 = b2 + kstep;
            if (last && has_next) S.a_ready(nxt);
            if constexpr (SP2) {
            PG8_LDB(B0, 0, 0); PG8_LDB(B1, 0, 1); PG8_SCHED; PG8_LDA(At, 0, 0); PG8_STAGE(PG8_SA(1, 1), a1 + hstep, voffA);
            PG8_WAIT_V(8); PG8_WAIT_L(0); PG8_BAR; PG8_MMA(0, 0, At, B0); PG8_MMA(0, 1, At, B1); PG8_BAR; PG8_SCHED;
            PG8_LDA(At, 0, 1); PG8_STAGE(PG8_SB(0, 0), b2, voffB); PG8_STAGE(PG8_SB(0, 1), b2 + hstep, voffB); PG8_STAGE(PG8_SA(0, 0), a2, voffA);
            PG8_WAIT_V(8); PG8_WAIT_L(0); PG8_BAR; PG8_MMA(1, 0, At, B0); PG8_MMA(1, 1, At, B1); PG8_BAR; PG8_SCHED;
            PG8_LDB(B0, 1, 0); PG8_LDB(B1, 1, 1); PG8_SCHED; PG8_LDA(At, 1, 0); PG8_STAGE(PG8_SA(0, 1), a2 + hstep, voffA);
            PG8_WAIT_V(8); PG8_WAIT_L(0); PG8_BAR; PG8_MMA(0, 0, At, B0); PG8_MMA(0, 1, At, B1); PG8_BAR; PG8_SCHED;
            PG8_LDA(At, 1, 1); PG8_STAGE(PG8_SB(1, 0), b3, voffB); PG8_STAGE(PG8_SB(1, 1), b3 + hstep, voffB); PG8_STAGE(PG8_SA(1, 0), a3, voffA);
            PG8_WAIT_V(8); PG8_WAIT_L(0); PG8_BAR; PG8_MMA(1, 0, At, B0); PG8_MMA(1, 1, At, B1); PG8_BAR; PG8_SCHED;
            } else {
            PG8_LDB(B0, 0, 0); PG8_SCHED; PG8_LDA(At, 0, 0); PG8_STAGE(PG8_SA(1, 1), a1 + hstep, voffA);
            PG8_WAIT_L(8); PG8_BAR; PG8_WAIT_L(0); PG8_MMA(0, 0, At, B0); PG8_BAR; PG8_SCHED;
            PG8_LDB(B1, 0, 1); PG8_STAGE(PG8_SB(0, 0), b2, voffB);
            PG8_BAR; PG8_WAIT_L(0); PG8_MMA(0, 1, At, B1); PG8_BAR;
            PG8_LDA(At, 0, 1); PG8_STAGE(PG8_SA(0, 0), a2, voffA);
            PG8_BAR; PG8_WAIT_L(0); PG8_MMA(1, 0, At, B0); PG8_BAR; PG8_SCHED;
            PG8_STAGE(PG8_SB(0, 1), b2 + hstep, voffB);
            PG8_WAIT_V(6); PG8_BAR; PG8_MMA(1, 1, At, B1); PG8_BAR;
            PG8_LDB(B0, 1, 0); PG8_SCHED; PG8_LDA(At, 1, 0); PG8_STAGE(PG8_SA(0, 1), a2 + hstep, voffA);
            PG8_WAIT_L(8); PG8_BAR; PG8_WAIT_L(0); PG8_MMA(0, 0, At, B0); PG8_BAR; PG8_SCHED;
            PG8_LDB(B1, 1, 1); PG8_STAGE(PG8_SB(1, 0), b3, voffB);
            PG8_BAR; PG8_WAIT_L(0); PG8_MMA(0, 1, At, B1); PG8_BAR;
            PG8_LDA(At, 1, 1); PG8_STAGE(PG8_SA(1, 0), a3, voffA);
            PG8_BAR; PG8_WAIT_L(0); PG8_MMA(1, 0, At, B0); PG8_BAR; PG8_SCHED;
            PG8_STAGE(PG8_SB(1, 1), b3 + hstep, voffB);
            PG8_WAIT_V(6); PG8_BAR; PG8_MMA(1, 1, At, B1); PG8_BAR;
            }
        }
        if constexpr (ALIGN_EPI) { if (wr == 0) PG8_BAR; }
        if constexpr (!Epi::AFTER_DRAIN) { E(acc, cur, wr, wc, fr, fq); S.done(cur); }
        if (!has_next) break;
#pragma unroll
        for (int a = 0; a < 2; ++a)
#pragma unroll
            for (int b = 0; b < 2; ++b)
#pragma unroll
                for (int m = 0; m < 4; ++m)
#pragma unroll
                    for (int n = 0; n < 2; ++n) acc[a][b][m][n] = (f32x4){0.f, 0.f, 0.f, 0.f};
        cur = nxt; cA = nA; cB = nB; ++ui;
        if constexpr (ALIGN_EPI) { if (wr == 1) PG8_BAR; }
    }
    PG8_WAIT_V(0);
    if constexpr (!ALIGN_EPI) { if (wr == 0) PG8_BAR; }
    PG8_BAR;
    if constexpr (Epi::AFTER_DRAIN) { E.fused(acc, cur, wr, wc, fr, fq, lds, wid, lane); S.done(cur); }
#undef PG8_SA
#undef PG8_SB
#undef PG8_STAGE
#undef PG8_LDA
#undef PG8_LDB
#undef PG8_MMA
#undef PG8_WAIT_V
#undef PG8_WAIT_L
#undef PG8_BAR
#undef PG8_SCHED
}
}

#define LAS __attribute__((address_space(3)))
typedef unsigned char uchar;
typedef pg8::bf16_t bf16_t;
typedef pg8::bf16x8 bf16x8;
typedef pg8::f32x4 f32x4;
typedef pg8::u32x4 u32x4;
typedef unsigned u32x2 __attribute__((ext_vector_type(2)));
typedef float f32x2 __attribute__((ext_vector_type(2)));
typedef float f32x16 __attribute__((ext_vector_type(16)));
typedef __bf16 bf16x2_t __attribute__((ext_vector_type(2)));

constexpr int NB = 16, SEQ = 4096, T = NB * SEQ, DM = 1024, FF = 2816, MEML = 256, TM = NB * MEML;
constexpr int NPROJ = 3328, PLD = 3072;
constexpr int PC_Z = 0, PC_X = 512, PC_B = 1024, PC_C = 1280, PC_Q = 1536, PC_K = 2048, PC_V = 2560;
constexpr float EPS = 1e-5f, LOG2E = 1.4426950408889634f;
constexpr float LAMBDA_INIT = 0.2f;

constexpr size_t MiB = 1u << 20;
constexpr size_t WS_CTL = 0, WS_ROPE = 1 * MiB, WS_SS0 = 2 * MiB, WS_SS1 = 6 * MiB, WS_SS2 = 10 * MiB, WS_SS3 = 14 * MiB, WS_SS4 = 18 * MiB, WS_SSM = 22 * MiB,
                 WS_DT = 23 * MiB, WS_WGU1 = 27 * MiB, WS_WD1 = 38 * MiB, WS_WIN = 44 * MiB, WS_WOUT = 51 * MiB, WS_WQ = 53 * MiB, WS_WKV = 55 * MiB, WS_WO = 59 * MiB,
                 WS_WGU2 = 61 * MiB, WS_WD2 = 72 * MiB, WS_MEMB = 78 * MiB, WS_KVX = 86 * MiB, WS_VTX = 102 * MiB, WS_VT = 110 * MiB, WS_XB = 174 * MiB,
                 WS_YMIX = 302 * MiB, WS_YFB = 430 * MiB, WS_BIG = 558 * MiB, WS_END = 942 * MiB;
constexpr int LDS_BYTES = 147456, PTAB_OFF = LDS_BYTES - 512, LDS_PTAB_ABS = PTAB_OFF;

__device__ __forceinline__ const float* lds_inp(int k) {
    const LAS unsigned long long* ptab = (const LAS unsigned long long*)(uintptr_t)0; const unsigned long long v = *(const LAS unsigned long long*)((const LAS uchar*)ptab + LDS_PTAB_ABS + 8 * k);
    return (const float*)(((unsigned long long)(unsigned)__builtin_amdgcn_readfirstlane((int)(v >> 32)) << 32) | (unsigned long long)(unsigned)__builtin_amdgcn_readfirstlane((int)(v & 0xffffffffull)));
}
__device__ __forceinline__ int opaque_tid() { int t = threadIdx.x; asm volatile("" : "+v"(t)); return t; }
__device__ __forceinline__ unsigned cvtpk(float lo, float hi) { f32x2 v = {lo, hi}; bf16x2_t b = __builtin_convertvector(v, bf16x2_t); return __builtin_bit_cast(unsigned, b); }
__device__ __forceinline__ float bflo(unsigned w) { return __uint_as_float(w << 16); }
__device__ __forceinline__ float bfhi(unsigned w) { return __uint_as_float(w & 0xffff0000u); }
__device__ __forceinline__ float wave_sum(float v) {
#pragma unroll
    for (int o = 1; o < 64; o <<= 1) v += __shfl_xor(v, o);
    return v;
}
__device__ __forceinline__ float fast_exp2(float x) { return __builtin_amdgcn_exp2f(x); }
__device__ __forceinline__ float silu_f(float g) { return g * __builtin_amdgcn_rcpf(1.0f + fast_exp2(-LOG2E * g)); }
__device__ __forceinline__ float row_rs(const float* part, int row) {
    const f32x4* p = (const f32x4*)(part + (size_t)row * 16);
    const f32x4 a = p[0], b = p[1], c = p[2], d = p[3];
    const float s = (((a[0] + a[1]) + (a[2] + a[3])) + ((b[0] + b[1]) + (b[2] + b[3]))) + (((c[0] + c[1]) + (c[2] + c[3])) + ((d[0] + d[1]) + (d[2] + d[3])));
    return 1.0f / sqrtf(s * (1.0f / 1024.0f) + EPS);
}

struct EpiBf16RS {
    static constexpr bool PERM = true, AFTER_DRAIN = false;
    const float* part; float scale; bf16_t* O; int ldc;
    __device__ __forceinline__ void operator()(const f32x4 (&acc)[2][2][4][2], const pg8::Unit& u, int wr, int wc, int fr, int fq) const {
        const int row0 = u.pm * 256 + wr * 64 + fr, col0 = u.pn * 256 + wc * 32 + 8 * fq;
#pragma unroll
        for (int ai = 0; ai < 2; ++ai)
#pragma unroll
            for (int m = 0; m < 4; ++m) {
                const int row = row0 + ai * 128 + m * 16; const float rs = row_rs(part, row) * scale; bf16_t* rp = O + (size_t)row * ldc + col0;
#pragma unroll
                for (int bj = 0; bj < 2; ++bj) { const f32x4 v0 = acc[ai][bj][m][0] * rs, v1 = acc[ai][bj][m][1] * rs;
                    u32x4 w; w.x = cvtpk(v0[0], v0[1]); w.y = cvtpk(v0[2], v0[3]); w.z = cvtpk(v1[0], v1[1]); w.w = cvtpk(v1[2], v1[3]);
                    *(u32x4*)(rp + bj * 128) = w; }
                asm volatile("" ::: "memory");
            }
    }
};
struct EpiSwiGLU {
    static constexpr bool PERM = true, AFTER_DRAIN = false;
    const float* part; bf16_t* U;
    __device__ __forceinline__ void operator()(const f32x4 (&acc)[2][2][4][2], const pg8::Unit& u, int wr, int wc, int fr, int fq) const {
        const int row0 = u.pm * 256 + wr * 64 + fr, col0 = u.pn * 128 + wc * 32 + 8 * fq;
#pragma unroll
        for (int ai = 0; ai < 2; ++ai)
#pragma unroll
            for (int m = 0; m < 4; ++m) {
                const int row = row0 + ai * 128 + m * 16; const float rs = row_rs(part, row);
                float h[8];
#pragma unroll
                for (int n = 0; n < 2; ++n)
#pragma unroll
                    for (int e = 0; e < 4; ++e) { const float g = acc[ai][0][m][n][e] * rs, up = acc[ai][1][m][n][e] * rs; h[4 * n + e] = silu_f(g) * up; }
                u32x4 w; w.x = cvtpk(h[0], h[1]); w.y = cvtpk(h[2], h[3]); w.z = cvtpk(h[4], h[5]); w.w = cvtpk(h[6], h[7]);
                *(u32x4*)(U + (size_t)row * FF + col0) = w;
                asm volatile("" ::: "memory");
            }
    }
};
struct EpiResidual {
    static constexpr bool PERM = true, AFTER_DRAIN = false;
    float alpha; bf16_t* xb; float* part;
    __device__ __forceinline__ void operator()(const f32x4 (&acc)[2][2][4][2], const pg8::Unit& u, int wr, int wc, int fr, int fq) const {
        const int row0 = u.pm * 256 + wr * 64 + fr, col0 = u.pn * 256 + wc * 32 + 8 * fq;
#pragma unroll
        for (int ai = 0; ai < 2; ++ai)
#pragma unroll
            for (int m = 0; m < 4; ++m) {
                const int row = row0 + ai * 128 + m * 16; float ss = 0.f;
#pragma unroll
                for (int bj = 0; bj < 2; ++bj) { const size_t off = (size_t)row * DM + col0 + bj * 128;
                    const u32x4 rv = *(const u32x4*)(xb + off);
                    f32x4 v0, v1; v0[0] = bflo(rv.x); v0[1] = bfhi(rv.x); v0[2] = bflo(rv.y); v0[3] = bfhi(rv.y); v1[0] = bflo(rv.z); v1[1] = bfhi(rv.z); v1[2] = bflo(rv.w); v1[3] = bfhi(rv.w);
                    v0 = v0 + acc[ai][bj][m][0] * alpha; v1 = v1 + acc[ai][bj][m][1] * alpha;
                    u32x4 w; w.x = cvtpk(v0[0], v0[1]); w.y = cvtpk(v0[2], v0[3]); w.z = cvtpk(v1[0], v1[1]); w.w = cvtpk(v1[2], v1[3]); *(u32x4*)(xb + off) = w;
                    ss += ((v0[0] * v0[0] + v0[1] * v0[1]) + (v0[2] * v0[2] + v0[3] * v0[3])) + ((v1[0] * v1[0] + v1[1] * v1[1]) + (v1[2] * v1[2] + v1[3] * v1[3])); }
                ss += __shfl_xor(ss, 16); ss += __shfl_xor(ss, 32);
                if (fq == 0) part[(size_t)row * 16 + u.pn * 4 + wc] = ss;
                asm volatile("" ::: "memory");
            }
    }
};
struct EpiProj {
    static constexpr bool PERM = true, AFTER_DRAIN = false;
    const float* part; bf16_t* P; float* DT; const float* cs; const float* sn; const float* dtb_f; const float* dtb_b;
    __device__ __forceinline__ void operator()(const f32x4 (&acc)[2][2][4][2], const pg8::Unit& u, int wr, int wc, int fr, int fq) const {
        const int pn = u.pn; const int row0 = u.pm * 256 + wr * 64 + fr;
        if (pn == 12) {
            if (wc == 0 && fq < 2) {
                const float* bias = (fq == 0) ? dtb_f : dtb_b;
#pragma unroll
                for (int ai = 0; ai < 2; ++ai)
#pragma unroll
                    for (int m = 0; m < 4; ++m) { const int row = row0 + ai * 128 + m * 16; const float rs = row_rs(part, row);
#pragma unroll
                        for (int n = 0; n < 2; ++n) { f32x4 o;
#pragma unroll
                            for (int e = 0; e < 4; ++e) { const float x = acc[ai][0][m][n][e] * rs + bias[4 * n + e]; o[e] = x > 20.f ? x : log1pf(__expf(x)); }
                            *(f32x4*)(DT + (size_t)row * 16 + 8 * fq + 4 * n) = o; } asm volatile("" ::: "memory"); }
            }
            return;
        }
        const bool isq = (pn == 6 || pn == 7), isk = (pn == 8 || pn == 9), rope = (isq || isk) && ((wc & 1) == 0);
        const float qs = isq ? 0.125f * LOG2E : 1.0f; const float sgn = (fq == 0) ? -1.f : 1.f;
        const int col0 = pn * 256 + wc * 32 + 8 * fq;
#pragma unroll
        for (int ai = 0; ai < 2; ++ai)
#pragma unroll
            for (int m = 0; m < 4; ++m) {
                const int row = row0 + ai * 128 + m * 16; const float rs = row_rs(part, row) * qs; const int pos = row & (SEQ - 1);
                bf16_t* rp = P + (size_t)row * PLD + col0;
#pragma unroll
                for (int bj = 0; bj < 2; ++bj) { f32x4 v0 = acc[ai][bj][m][0], v1 = acc[ai][bj][m][1];
                    if (rope) { f32x4 p0, p1;
#pragma unroll
                        for (int e = 0; e < 4; ++e) { p0[e] = __shfl_xor(v0[e], 16); p1[e] = __shfl_xor(v1[e], 16); }
                        if (fq < 2) { const f32x4 c0 = *(const f32x4*)(cs + pos * 8), c1 = *(const f32x4*)(cs + pos * 8 + 4), s0 = *(const f32x4*)(sn + pos * 8), s1 = *(const f32x4*)(sn + pos * 8 + 4);
                            v0 = v0 * c0 + p0 * s0 * sgn; v1 = v1 * c1 + p1 * s1 * sgn; } }
                    v0 = v0 * rs; v1 = v1 * rs;
                    u32x4 w; w.x = cvtpk(v0[0], v0[1]); w.y = cvtpk(v0[2], v0[3]); w.z = cvtpk(v1[0], v1[1]); w.w = cvtpk(v1[2], v1[3]);
                    *(u32x4*)(rp + bj * 128) = w; }
                asm volatile("" ::: "memory");
            }
    }
};
struct EpiAny {
    static constexpr bool PERM = true, AFTER_DRAIN = false;
    int kind; unsigned char* ws; float scale; unsigned part_off, o_off, opart_off; int ldc;
    __device__ __forceinline__ void operator()(const f32x4 (&acc)[2][2][4][2], const pg8::Unit& u, int wr, int wc, int fr, int fq) const {
        if (kind == 0) { EpiBf16RS e{(const float*)(ws + part_off), scale, (bf16_t*)(ws + o_off), ldc}; e(acc, u, wr, wc, fr, fq); }
        else if (kind == 1) { EpiSwiGLU e{(const float*)(ws + part_off), (bf16_t*)(ws + o_off)}; e(acc, u, wr, wc, fr, fq); }
        else if (kind == 2) { EpiResidual e{scale, (bf16_t*)(ws + WS_XB), (float*)(ws + opart_off)}; e(acc, u, wr, wc, fr, fq); }
        else { EpiProj e{(const float*)(ws + part_off), (bf16_t*)(ws + o_off), (float*)(ws + WS_DT), (const float*)(ws + WS_ROPE), (const float*)(ws + WS_ROPE) + SEQ * 8, lds_inp(10), lds_inp(11)}; e(acc, u, wr, wc, fr, fq); }
    }
};
struct GJob { const bf16_t* A; const bf16_t* Bt; int M, N, K; EpiAny E; };
template <class Epi> __device__ __forceinline__ void run_gemm(LAS uchar* lds, const bf16_t* A, const bf16_t* Bt, int M, int N, int K, const Epi& E) {
    pg8::Gemm g{A, Bt, M, N, K}; pg8::StaticOrder S; S.init(M, N, (int)gridDim.x, (int)blockIdx.x);
    pg8::gemm_phase<Epi, pg8::StaticOrder, true, true>(lds, g, S, E);
}

__device__ __forceinline__ int map_row(int kind, int n) {
    if (kind == 1) return (n >> 7) * 256 + (n & 127);
    if (kind == 2) return (n >> 7) * 256 + 128 + (n & 127);
    if (kind == 3) return n < 1536 ? n : (n < 1552 ? 3072 + (n - 1536) : n - 16);
    return n;
}
__device__ __forceinline__ void p0_transpose_item(const float* W, int K, int N, bf16_t* WT, int kind, const float* g, LAS float* scr, int item, int lane) {
    const int nblk = (N + 31) >> 5, kb = item / nblk, nb = item - kb * nblk, k0 = 64 * kb, n0 = 32 * nb;
    const int ncol = n0 + (lane & 31); const bool valid = ncol < N;
#pragma unroll 8
    for (int i = 0; i < 32; ++i) { const int kk = 2 * i + (lane >> 5); float v = valid ? W[(size_t)(k0 + kk) * N + ncol] : 0.f; if (g) v *= g[k0 + kk]; scr[kk * 33 + (lane & 31)] = v; }
    asm volatile("s_waitcnt lgkmcnt(0)" ::: "memory");
    const int c = lane & 7;
#pragma unroll
    for (int j = 0; j < 4; ++j) { const int n = (lane >> 3) + 8 * j; const LAS float* s = scr + (8 * c) * 33 + n;
        if (n0 + n < N) { u32x4 o; o.x = cvtpk(s[0 * 33], s[1 * 33]); o.y = cvtpk(s[2 * 33], s[3 * 33]); o.z = cvtpk(s[4 * 33], s[5 * 33]); o.w = cvtpk(s[6 * 33], s[7 * 33]);
            *(u32x4*)(WT + (size_t)map_row(kind, n0 + n) * K + k0 + 8 * c) = o; } }
    asm volatile("s_waitcnt lgkmcnt(0)" ::: "memory");
}
__device__ __forceinline__ void row_to_bf16_ss(const float* xrow, bf16_t* orow, float* part, int lane) {
    f32x4 v[4]; float s = 0.f;
#pragma unroll
    for (int j = 0; j < 4; ++j) { v[j] = ((const f32x4*)xrow)[lane + 64 * j]; s += (v[j][0] * v[j][0] + v[j][1] * v[j][1]) + (v[j][2] * v[j][2] + v[j][3] * v[j][3]); }
    s = wave_sum(s);
#pragma unroll
    for (int j = 0; j < 4; ++j) { u32x2 w; w.x = cvtpk(v[j][0], v[j][1]); w.y = cvtpk(v[j][2], v[j][3]); ((u32x2*)orow)[lane + 64 * j] = w; }
    if (lane < 16) part[lane] = (lane == 0) ? s : 0.f;
}
__device__ __forceinline__ void rope_entry(int idx, float* cs, float* sn) {
    const int pos = idx >> 3, i = idx & 7;
    const float invf = (i == 0) ? 1.0f : (i == 1) ? 0.193922758102417f : (i == 2) ? 0.03760603070259094f : (i == 3) ? 0.00729266507551074f : (i == 4) ? 0.001414213445968926f
                     : (i == 5) ? 0.00027424818836152554f : (i == 6) ? 5.318296462064609e-05f : 1.0313385246263351e-05f;
    const float angf = (float)pos * invf;
    const double x = (double)angf; const double kq = rint(x * 0.6366197723675814);
    double r = fma(-kq, 1.5707963267948966, x); r = fma(-kq, 6.123233995736766e-17, r);
    const int q = ((int)kq) & 3; const double r2 = r * r;
    const double s = r * (1.0 + r2 * (-1.0 / 6 + r2 * (1.0 / 120 + r2 * (-1.0 / 5040 + r2 * (1.0 / 362880 + r2 * (-1.0 / 39916800 + r2 * (1.0 / 6227020800.0)))))));
    const double c = 1.0 + r2 * (-0.5 + r2 * (1.0 / 24 + r2 * (-1.0 / 720 + r2 * (1.0 / 40320 + r2 * (-1.0 / 3628800 + r2 * (1.0 / 479001600.0 + r2 * (-1.0 / 87178291200.0)))))));
    const double co = (q == 0) ? c : (q == 1) ? -s : (q == 2) ? -c : s;
    const double si = (q == 0) ? s : (q == 1) ? c : (q == 2) ? -s : -c;
    cs[idx] = (float)co; sn[idx] = (float)si;
}

__device__ __forceinline__ void transpose64(const bf16_t* src, int sp, bf16_t* dst, int dp, LAS uchar* scr, int lane) {
#pragma unroll
    for (int i = 0; i < 8; ++i) { const int r = i * 8 + (lane >> 3), c8 = lane & 7; const u32x4 v = *(const u32x4*)(src + (size_t)r * sp + c8 * 8);
        LAS unsigned* w = (LAS unsigned*)(scr + r * 132 + c8 * 16); w[0] = v.x; w[1] = v.y; w[2] = v.z; w[3] = v.w; }
    asm volatile("s_waitcnt lgkmcnt(0)" ::: "memory");
#pragma unroll
    for (int i = 0; i < 8; ++i) { const int c = i * 8 + (lane >> 3), r8 = lane & 7; unsigned e[8];
#pragma unroll
        for (int j = 0; j < 8; ++j) e[j] = *(const LAS unsigned short*)(scr + (r8 * 8 + j) * 132 + c * 2);
        u32x4 o; o.x = e[0] | (e[1] << 16); o.y = e[2] | (e[3] << 16); o.z = e[4] | (e[5] << 16); o.w = e[6] | (e[7] << 16);
        *(u32x4*)(dst + (size_t)c * dp + r8 * 8) = o; }
    asm volatile("s_waitcnt lgkmcnt(0)" ::: "memory");
}
__device__ __forceinline__ void conv_item(const bf16_t* P, const float* cw, const float* cb, bf16_t* XC, bf16_t* XT, bf16_t* BT, LAS uchar* scr, int item, int lane) {
    const int cb16 = item & 15, tt = item >> 4, tok0 = tt * 64, s0 = tok0 & (SEQ - 1), b = tok0 >> 12, ci = s0 >> 7, l0 = s0 & 127;
    const int c8 = lane & 7, tb = lane >> 3, ch = cb16 * 64 + c8 * 8;
    float w[5][8], bias[8];
#pragma unroll
    for (int k = 0; k < 5; ++k) { const f32x4 a = *(const f32x4*)(cw + k * 1024 + ch), bq = *(const f32x4*)(cw + k * 1024 + ch + 4);
#pragma unroll
        for (int e = 0; e < 4; ++e) { w[k][e] = a[e]; w[k][4 + e] = bq[e]; } }
    { const f32x4 a = *(const f32x4*)(cb + ch), bq = *(const f32x4*)(cb + ch + 4);
#pragma unroll
      for (int e = 0; e < 4; ++e) { bias[e] = a[e]; bias[4 + e] = bq[e]; } }
    const int sb = s0 + tb * 8;
    const bf16_t* src = P + (size_t)(tok0 + tb * 8) * PLD + PC_X + ch;
    float win[5][8];
#pragma unroll
    for (int j = 0; j < 4; ++j) { const int sq = sb + j - 2; u32x4 v = {0u, 0u, 0u, 0u}; if (sq >= 0 && sq < SEQ) v = *(const u32x4*)(src + (ptrdiff_t)(j - 2) * PLD);
        win[j][0] = bflo(v.x); win[j][1] = bfhi(v.x); win[j][2] = bflo(v.y); win[j][3] = bfhi(v.y); win[j][4] = bflo(v.z); win[j][5] = bfhi(v.z); win[j][6] = bflo(v.w); win[j][7] = bfhi(v.w); }
#pragma unroll
    for (int i = 0; i < 8; ++i) {
        { const int sq = sb + i + 2; u32x4 v = {0u, 0u, 0u, 0u}; if (sq < SEQ) v = *(const u32x4*)(src + (ptrdiff_t)(i + 2) * PLD);
          float* d = win[(i + 4) % 5];
          d[0] = bflo(v.x); d[1] = bfhi(v.x); d[2] = bflo(v.y); d[3] = bfhi(v.y); d[4] = bflo(v.z); d[5] = bfhi(v.z); d[6] = bflo(v.w); d[7] = bfhi(v.w); }
        float o[8];
#pragma unroll
        for (int e = 0; e < 8; ++e) { float acc = bias[e];
#pragma unroll
            for (int k = 0; k < 5; ++k) acc += w[k][e] * win[(i + k) % 5][e];
            o[e] = silu_f(acc); }
        u32x4 ov; ov.x = cvtpk(o[0], o[1]); ov.y = cvtpk(o[2], o[3]); ov.z = cvtpk(o[4], o[5]); ov.w = cvtpk(o[6], o[7]);
        *(u32x4*)(XC + (size_t)(tok0 + tb * 8 + i) * 1024 + ch) = ov;
        LAS unsigned* wq = (LAS unsigned*)(scr + (tb * 8 + i) * 132 + c8 * 16); wq[0] = ov.x; wq[1] = ov.y; wq[2] = ov.z; wq[3] = ov.w;
    }
    asm volatile("s_waitcnt lgkmcnt(0)" ::: "memory");
    if (cb16 < 12) {
        bf16_t* dst = (cb16 < 8) ? XT + ((size_t)((b * 32 + ci) * 8 + cb16) * 64) * 128 + l0
                                 : BT + ((size_t)((b * 32 + ci) * 2 + ((cb16 - 8) >> 1)) * 128 + ((cb16 - 8) & 1) * 64) * 128 + l0;
#pragma unroll
        for (int i = 0; i < 8; ++i) { const int c = i * 8 + (lane >> 3), r8 = lane & 7; unsigned e[8];
#pragma unroll
            for (int j = 0; j < 8; ++j) e[j] = *(const LAS unsigned short*)(scr + (r8 * 8 + j) * 132 + c * 2);
            u32x4 ov; ov.x = e[0] | (e[1] << 16); ov.y = e[2] | (e[3] << 16); ov.z = e[4] | (e[5] << 16); ov.w = e[6] | (e[7] << 16);
            *(u32x4*)(dst + (size_t)c * 128 + r8 * 8) = ov; }
    }
    asm volatile("s_waitcnt lgkmcnt(0)" ::: "memory");
}

__device__ __forceinline__ float dpp_sum8(float v) {
    v += __builtin_bit_cast(float, __builtin_amdgcn_update_dpp(0, __builtin_bit_cast(int, v), 0xB1, 0xF, 0xF, true));
    v += __builtin_bit_cast(float, __builtin_amdgcn_update_dpp(0, __builtin_bit_cast(int, v), 0x4E, 0xF, 0xF, true));
    v += __builtin_bit_cast(float, __builtin_amdgcn_update_dpp(0, __builtin_bit_cast(int, v), 0x141, 0xF, 0xF, true));
    return v;
}
__device__ __forceinline__ void ssd_item(LAS uchar* lds, int b, int h, int dir, const bf16_t* XC, const float* DT, float Aneg, bf16_t* Y) {
    const int tid = opaque_tid(), p = tid >> 3, nq = tid & 7, g = h >> 2;
    LAS float* sB = (LAS float*)lds;
    LAS float* sC = sB + 64 * 128;
    LAS float* sX = sC + 64 * 128;
    LAS float* sY = sX + 64 * 64;
    LAS float* sDt = sY + 64 * 64;
    LAS float* sE = sDt + 64;
    float st[16];
#pragma unroll
    for (int k = 0; k < 16; ++k) st[k] = 0.f;
    u32x4 rb[2], rc[2], rx; float rdt = 0.f;
    const size_t tokb = (size_t)b * SEQ;
#define SSD_LOAD(blk) do { const int t0_ = dir ? (SEQ - 64 - (blk) * 64) : (blk) * 64; \
        _Pragma("unroll") for (int i_ = 0; i_ < 2; ++i_) { const int id_ = tid + 512 * i_, r_ = id_ >> 4, c_ = id_ & 15; const bf16_t* s_ = XC + (tokb + t0_ + r_) * 1024 + 512 + g * 128 + c_ * 8; \
            rb[i_] = *(const u32x4*)s_; rc[i_] = *(const u32x4*)(s_ + 256); } \
        { const int r_ = tid >> 3, c_ = tid & 7; rx = *(const u32x4*)(XC + (tokb + t0_ + r_) * 1024 + h * 64 + c_ * 8); } \
        if (tid < 64) rdt = DT[(tokb + t0_ + tid) * 16 + dir * 8 + h]; } while (0)
#define SSD_ST8(dst, v) do { f32x4 a_, b_; a_[0] = bflo((v).x); a_[1] = bfhi((v).x); a_[2] = bflo((v).y); a_[3] = bfhi((v).y); b_[0] = bflo((v).z); b_[1] = bfhi((v).z); b_[2] = bflo((v).w); b_[3] = bfhi((v).w); \
        *(LAS f32x4*)(dst) = a_; *(LAS f32x4*)((dst) + 4) = b_; } while (0)
#define SSD_STORE() do { \
        _Pragma("unroll") for (int i_ = 0; i_ < 2; ++i_) { const int id_ = tid + 512 * i_, r_ = id_ >> 4, c_ = id_ & 15; SSD_ST8(sB + r_ * 128 + c_ * 8, rb[i_]); SSD_ST8(sC + r_ * 128 + c_ * 8, rc[i_]); } \
        { const int r_ = tid >> 3, c_ = tid & 7; SSD_ST8(sX + r_ * 64 + c_ * 8, rx); } \
        if (tid < 64) { sDt[tid] = rdt; sE[tid] = __expf(rdt * Aneg); } } while (0)
    SSD_LOAD(0); SSD_STORE();
    __syncthreads();
    for (int blk = 0; blk < SEQ / 64; ++blk) {
        if (blk + 1 < SEQ / 64) SSD_LOAD(blk + 1);
        for (int j = 0; j < 64; ++j) {
            const int i = dir ? 63 - j : j;
            const float e = sE[i], xdt = sX[i * 64 + p] * sDt[i];
            const LAS f32x4* bp = (const LAS f32x4*)(sB + i * 128 + nq * 16); const LAS f32x4* cp = (const LAS f32x4*)(sC + i * 128 + nq * 16);
            float acc = 0.f;
#pragma unroll
            for (int q = 0; q < 4; ++q) { const f32x4 bv = bp[q], cv = cp[q];
#pragma unroll
                for (int k = 0; k < 4; ++k) { st[4 * q + k] = st[4 * q + k] * e + xdt * bv[k]; acc += cv[k] * st[4 * q + k]; } }
            acc = dpp_sum8(acc);
            if (nq == 0) sY[i * 64 + p] = acc;
        }
        __syncthreads();
        { const int t0 = dir ? (SEQ - 64 - blk * 64) : blk * 64; const int r = tid >> 3, c = tid & 7; const LAS f32x4* yp = (const LAS f32x4*)(sY + r * 64 + c * 8); const f32x4 a = yp[0], bq = yp[1];
          u32x4 w; w.x = cvtpk(a[0], a[1]); w.y = cvtpk(a[2], a[3]); w.z = cvtpk(bq[0], bq[1]); w.w = cvtpk(bq[2], bq[3]);
          *(u32x4*)(Y + (tokb + t0 + r) * 512 + h * 64 + c * 8) = w; }
        if (blk + 1 < SEQ / 64) SSD_STORE();
        __syncthreads();
    }
#undef SSD_LOAD
#undef SSD_ST8
#undef SSD_STORE
}

__device__ __forceinline__ int crow(int r, int hi) { return (r & 3) + 8 * (r >> 2) + 4 * hi; }
#define MFMA32(a, b, c) __builtin_amdgcn_mfma_f32_32x32x16_bf16((a), (b), (c), 0, 0, 0)
template <int DQK, int KW, int DVT, int NT, int MODE, bool PIPE>
__device__ __forceinline__ void attn_item(LAS uchar* lds, const bf16_t* qptr, int qpitch, const bf16_t* kptr, int kpitch, int kwcol, const bf16_t* vtptr, int vtpitch, int vrow,
                                          bf16_t* outp, int opitch, float lam, const float* subg) {
    constexpr int KROW = KW * 2 + 16, KBUF = 64 * KROW, VROW = 136, VBUF = DVT * VROW, NKP = 64 * (KW / 8) / 512, NVP = DVT * 8 / 512, NS = DQK / 16;
    static_assert(2 * KBUF + 2 * VBUF <= PTAB_OFF && 128 * 256 * 4 + 1024 <= PTAB_OFF, "attention LDS");
    const int tid = opaque_tid(), lane = tid & 63, wid = __builtin_amdgcn_readfirstlane(tid >> 6), qg = wid >> 1, t = wid & 1, l31 = lane & 31, hi = lane >> 5;
    bf16x8 qf[NS];
    { const bf16_t* qr = qptr + (size_t)(qg * 32 + l31) * qpitch + 8 * hi;
#pragma unroll
      for (int s = 0; s < NS; ++s) qf[s] = *(const bf16x8*)(qr + 16 * s); }
    f32x16 o[4];
#pragma unroll
    for (int d = 0; d < 4; ++d)
#pragma unroll
        for (int r = 0; r < 16; ++r) o[d][r] = 0.f;
    float m = -1e30f, l = 0.f;
    u32x4 kst[NKP], vst[NVP];
#define AT_LOAD(tile) do { \
        _Pragma("unroll") for (int i_ = 0; i_ < NKP; ++i_) { const int id_ = tid + 512 * i_, r_ = id_ / (KW / 8), c_ = id_ % (KW / 8); kst[i_] = *(const u32x4*)(kptr + (size_t)((tile) * 64 + r_) * kpitch + c_ * 8); } \
        _Pragma("unroll") for (int i_ = 0; i_ < NVP; ++i_) { const int id_ = tid + 512 * i_, r_ = id_ >> 3, c_ = id_ & 7; vst[i_] = *(const u32x4*)(vtptr + (size_t)r_ * vtpitch + (tile) * 64 + c_ * 8); } } while (0)
#define AT_STORE(buf) do { \
        _Pragma("unroll") for (int i_ = 0; i_ < NKP; ++i_) { const int id_ = tid + 512 * i_, r_ = id_ / (KW / 8), c_ = id_ % (KW / 8); *(LAS u32x4*)(lds + (buf) * KBUF + r_ * KROW + c_ * 16) = kst[i_]; } \
        _Pragma("unroll") for (int i_ = 0; i_ < NVP; ++i_) { const int id_ = tid + 512 * i_, r_ = id_ >> 3, c_ = id_ & 7; LAS u32x2* d_ = (LAS u32x2*)(lds + 2 * KBUF + (buf) * VBUF + r_ * VROW + c_ * 16); \
            d_[0] = (u32x2){vst[i_].x, vst[i_].y}; d_[1] = (u32x2){vst[i_].z, vst[i_].w}; } } while (0)
    if (PIPE) { AT_LOAD(0); AT_STORE(0); __syncthreads(); }
    for (int tile = 0; tile < NT; ++tile) {
        if (PIPE) { if (tile + 1 < NT) AT_LOAD(tile + 1); }
        else { AT_LOAD(tile); AT_STORE(tile & 1); __syncthreads(); }
        const LAS uchar* kb = lds + (tile & 1) * KBUF; const LAS uchar* vb = lds + 2 * KBUF + (tile & 1) * VBUF;
        f32x16 s0, s1;
#pragma unroll
        for (int r = 0; r < 16; ++r) { s0[r] = 0.f; s1[r] = 0.f; }
        { const LAS uchar* ka = kb + l31 * KROW + (kwcol + 8 * hi) * 2;
#pragma unroll
          for (int s = 0; s < NS; ++s) { const bf16x8 a0 = *(const LAS bf16x8*)(ka + 32 * s), a1 = *(const LAS bf16x8*)(ka + 32 * KROW + 32 * s);
              s0 = MFMA32(a0, qf[s], s0); s1 = MFMA32(a1, qf[s], s1); } }
        float mx = fmaxf(s0[0], s1[0]);
#pragma unroll
        for (int r = 1; r < 16; ++r) mx = fmaxf(mx, fmaxf(s0[r], s1[r]));
        mx = fmaxf(mx, __shfl_xor(mx, 32));
        const float mnew = fmaxf(m, mx); const float alpha = fast_exp2(m - mnew);
        if (__any(mnew > m)) {
#pragma unroll
            for (int r = 0; r < 16; ++r) { const float ar = __shfl(alpha, crow(r, hi));
#pragma unroll
                for (int d = 0; d < 4; ++d) o[d][r] *= ar; }
        }
        m = mnew; float ps = 0.f;
#pragma unroll
        for (int r = 0; r < 16; ++r) { s0[r] = fast_exp2(s0[r] - m); s1[r] = fast_exp2(s1[r] - m); ps += s0[r] + s1[r]; }
        l = l * alpha + ps;
#pragma unroll
        for (int kt = 0; kt < 2; ++kt)
#pragma unroll
            for (int j = 0; j < 2; ++j) {
                u32x4 pw;
                if (kt == 0) { pw.x = cvtpk(s0[8 * j], s0[8 * j + 1]); pw.y = cvtpk(s0[8 * j + 2], s0[8 * j + 3]); pw.z = cvtpk(s0[8 * j + 4], s0[8 * j + 5]); pw.w = cvtpk(s0[8 * j + 6], s0[8 * j + 7]); }
                else         { pw.x = cvtpk(s1[8 * j], s1[8 * j + 1]); pw.y = cvtpk(s1[8 * j + 2], s1[8 * j + 3]); pw.z = cvtpk(s1[8 * j + 4], s1[8 * j + 5]); pw.w = cvtpk(s1[8 * j + 6], s1[8 * j + 7]); }
                const bf16x8 pa = __builtin_bit_cast(bf16x8, pw);
#pragma unroll
                for (int d = 0; d < 4; ++d) { const LAS uchar* va = vb + (vrow + 32 * d + l31) * VROW + (32 * kt + 16 * j + 4 * hi) * 2;
                    const u32x2 lo = *(const LAS u32x2*)va, hh = *(const LAS u32x2*)(va + 16);
                    u32x4 vw; vw.x = lo.x; vw.y = lo.y; vw.z = hh.x; vw.w = hh.y;
                    o[d] = MFMA32(pa, __builtin_bit_cast(bf16x8, vw), o[d]); }
            }
        if (PIPE) { if (tile + 1 < NT) AT_STORE((tile + 1) & 1); __syncthreads(); }
    }
    if (!PIPE) __syncthreads();
#undef AT_LOAD
#undef AT_STORE
    l += __shfl_xor(l, 32);
    LAS float* ex = (LAS float*)lds; LAS float* lsum = (LAS float*)(lds + 128 * 256 * 4);
#pragma unroll
    for (int d = 0; d < 4; ++d)
#pragma unroll
        for (int r = 0; r < 16; ++r) ex[(qg * 32 + crow(r, hi)) * 256 + t * 128 + 32 * d + l31] = o[d][r];
    if (hi == 0) lsum[t * 128 + qg * 32 + l31] = l;
    __syncthreads();
    for (int rr = 0; rr < 16; ++rr) {
        const int q = wid * 16 + rr;
        if (MODE == 0) {
            const float i1 = 1.0f / lsum[q], i2 = lam / lsum[128 + q];
            const f32x2 o1 = ((const LAS f32x2*)(ex + q * 256))[lane], o2 = ((const LAS f32x2*)(ex + q * 256 + 128))[lane];
            const float a = o1.x * i1 - o2.x * i2, bq = o1.y * i1 - o2.y * i2;
            const float ss = wave_sum(a * a + bq * bq); const float rn = (1.0f - LAMBDA_INIT) / sqrtf(ss * (1.0f / 128.0f) + EPS);
            *(unsigned*)(outp + (size_t)q * opitch + 2 * lane) = cvtpk(a * rn * subg[2 * lane], bq * rn * subg[2 * lane + 1]);
        } else {
            const float inv = 1.0f / lsum[q]; const f32x4 v = ((const LAS f32x4*)(ex + q * 256))[lane];
            u32x2 w; w.x = cvtpk(v[0] * inv, v[1] * inv); w.y = cvtpk(v[2] * inv, v[3] * inv);
            *(u32x2*)(outp + (size_t)q * opitch + 4 * lane) = w;
        }
    }
    __syncthreads();
}

#ifndef PHASE_MASK
#define PHASE_MASK 0xFFFF
#endif
#define PH_ON(k) ((PHASE_MASK >> (k)) & 1)
#define PH_IDS const int tid = opaque_tid(), lane = tid & 63, wave = __builtin_amdgcn_readfirstlane(tid >> 6), gw = bx * 8 + wave, gtid = bx * 512 + tid; (void)lane; (void)gw; (void)gtid; (void)wave
struct Args { const float* in[32]; float* out; unsigned char* ws; int ph_lo, ph_hi; };
constexpr int N_PHASES = 14;

__global__ void __launch_bounds__(512, 2) mega_fwd(Args a) {
    extern __shared__ __attribute__((aligned(16))) unsigned char lds_raw[];
    LAS uchar* lds = (LAS uchar*)lds_raw;
    const int G = (int)gridDim.x, bx = (int)blockIdx.x, NGW = G * 8, NTHR = G * 512;
    LAS unsigned long long* ptab = (LAS unsigned long long*)(lds + PTAB_OFF);
    if (threadIdx.x < 32) ptab[threadIdx.x] = (unsigned long long)a.in[threadIdx.x];
    __syncthreads();
#define INP(k) ((const float*)(((unsigned long long)(unsigned)__builtin_amdgcn_readfirstlane((int)(ptab[k] >> 32)) << 32) | (unsigned long long)(unsigned)__builtin_amdgcn_readfirstlane((int)(ptab[k] & 0xffffffffull))))
    if (a.ph_lo == 0 && PH_ON(0)) {
        float* rope_cs = (float*)(a.ws + WS_ROPE);
        for (int i = bx * 512 + (int)threadIdx.x; i < SEQ * 8; i += NTHR) rope_entry(i, rope_cs, rope_cs + SEQ * 8);
    }
    for (int ph = a.ph_lo; ph < a.ph_hi; ++ph) {
        unsigned char* ws = a.ws; asm volatile("" : "+s"(ws));
        float* lamp = (float*)(ws + WS_CTL);
        float* rope_cs = (float*)(ws + WS_ROPE); float* rope_sn = rope_cs + SEQ * 8;
        float* SS0 = (float*)(ws + WS_SS0); float* SS1 = (float*)(ws + WS_SS1); float* SS2 = (float*)(ws + WS_SS2); float* SS3 = (float*)(ws + WS_SS3); float* SS4 = (float*)(ws + WS_SS4); float* SSM = (float*)(ws + WS_SSM);
        float* DTB = (float*)(ws + WS_DT);
        bf16_t* WGU1 = (bf16_t*)(ws + WS_WGU1); bf16_t* WD1 = (bf16_t*)(ws + WS_WD1); bf16_t* WIN = (bf16_t*)(ws + WS_WIN); bf16_t* WOUT = (bf16_t*)(ws + WS_WOUT);
        bf16_t* WQ = (bf16_t*)(ws + WS_WQ); bf16_t* WKV = (bf16_t*)(ws + WS_WKV); bf16_t* WO = (bf16_t*)(ws + WS_WO); bf16_t* WGU2 = (bf16_t*)(ws + WS_WGU2); bf16_t* WD2 = (bf16_t*)(ws + WS_WD2);
        bf16_t* MEMB = (bf16_t*)(ws + WS_MEMB); bf16_t* KVX = (bf16_t*)(ws + WS_KVX); bf16_t* VTX = (bf16_t*)(ws + WS_VTX); bf16_t* VT = (bf16_t*)(ws + WS_VT);
        float* out = a.out;
        bf16_t* XB = (bf16_t*)(ws + WS_XB);
        bf16_t* XC = (bf16_t*)out; bf16_t* XT = XC + (size_t)T * 1024; bf16_t* BTR = XT + (size_t)T * 512;
        bf16_t* YMIX = (bf16_t*)(ws + WS_YMIX); bf16_t* OX = YMIX;
        bf16_t* YF = (bf16_t*)(ws + WS_YFB); bf16_t* YB = YF + (size_t)T * 512; bf16_t* QX = YF;
        bf16_t* BIG = (bf16_t*)(ws + WS_BIG); bf16_t* U = BIG; bf16_t* PROJ = BIG;

        if (ph == 0 && PH_ON(0)) {
            PH_IDS;
            LAS float* scr = (LAS float*)(lds + wave * 16384);
            constexpr int I_G = 16 * 88, I_D = 44 * 32, I_IN = 16 * 97, I_SQ = 16 * 32, I_KV = 16 * 64;
            constexpr int NITEMS = 6 * I_G + I_IN + 3 * I_SQ + I_KV;
            static_assert(I_G == I_D, "item counts");
            for (int it = gw; it < NITEMS; it += NGW) {
                int r = it; const float* W; const float* gq = nullptr; bf16_t* WT; int K = DM, N = DM, kind = 0;
                if (r < 3 * I_G) { const int w = r / I_G; r -= w * I_G; if (w == 2) { W = INP(5); K = FF; WT = WD1; } else { W = INP(3 + w); N = FF; WT = WGU1; kind = 1 + w; gq = INP(2); } }
                else if (r < 6 * I_G) { r -= 3 * I_G; const int w = r / I_G; r -= w * I_G; if (w == 2) { W = INP(30); K = FF; WT = WD2; } else { W = INP(28 + w); N = FF; WT = WGU2; kind = 1 + w; gq = INP(27); } }
                else if (r < 6 * I_G + I_IN) { r -= 6 * I_G; W = INP(7); N = 3088; WT = WIN; kind = 3; gq = INP(6); }
                else { r -= 6 * I_G + I_IN;
                    if (r < I_SQ) { W = INP(21); WT = WOUT; }
                    else if (r < 2 * I_SQ) { r -= I_SQ; W = INP(24); WT = WQ; gq = INP(22); }
                    else if (r < 3 * I_SQ) { r -= 2 * I_SQ; W = INP(26); WT = WO; }
                    else { r -= 3 * I_SQ; W = INP(25); N = 2 * DM; WT = WKV; gq = INP(23); } }
                p0_transpose_item(W, K, N, WT, kind, gq, scr, r, lane);
            }
            for (int mrow = gw; mrow < T; mrow += NGW) row_to_bf16_ss(INP(0) + (size_t)mrow * DM, XB + (size_t)mrow * DM, SS0 + (size_t)mrow * 16, lane);
            for (int mrow = gw; mrow < TM; mrow += NGW) row_to_bf16_ss(INP(1) + (size_t)mrow * DM, MEMB + (size_t)mrow * DM, SSM + (size_t)mrow * 16, lane);
            for (int i = gtid; i < (NPROJ - 3088) * DM / 8; i += NTHR) ((u32x4*)(WIN + (size_t)3088 * DM))[i] = (u32x4){0u, 0u, 0u, 0u};
            if (bx == 0 && wave == 0) {
                const float s1 = wave_sum(INP(16)[lane] * INP(17)[lane]), s2 = wave_sum(INP(18)[lane] * INP(19)[lane]);
                if (lane == 0) lamp[0] = __expf(s1) - __expf(s2) + LAMBDA_INIT;
            }
        } else if (PH_ON(1) && (ph == 1 || ph == 2 || ph == 3 || ph == 7 || ph == 8 || ph == 10 || ph == 11 || ph == 12)) {
            for (int sub = 0; sub < 2; ++sub) {
                if (sub == 1 && ph != 1) break;
                GJob j; j.E = EpiAny{0, ws, 1.0f, 0u, 0u, 0u, 0};
                if (ph == 1 && sub == 0) { j.A = XB; j.Bt = WGU1; j.M = T; j.N = 2 * FF; j.K = DM; j.E.kind = 1; j.E.part_off = (unsigned)WS_SS0; j.E.o_off = (unsigned)WS_BIG; }
                else if (ph == 1)        { j.A = MEMB; j.Bt = WKV; j.M = TM; j.N = 2 * DM; j.K = DM; j.E.kind = 0; j.E.part_off = (unsigned)WS_SSM; j.E.o_off = (unsigned)WS_KVX; j.E.ldc = 2 * DM; }
                else if (ph == 2)        { j.A = U; j.Bt = WD1; j.M = T; j.N = DM; j.K = FF; j.E.kind = 2; j.E.scale = 0.5f; j.E.opart_off = (unsigned)WS_SS1; }
                else if (ph == 3)        { j.A = XB; j.Bt = WIN; j.M = T; j.N = NPROJ; j.K = DM; j.E.kind = 3; j.E.part_off = (unsigned)WS_SS1; j.E.o_off = (unsigned)WS_BIG; }
                else if (ph == 7)        { j.A = YMIX; j.Bt = WOUT; j.M = T; j.N = DM; j.K = DM; j.E.kind = 2; j.E.opart_off = (unsigned)WS_SS2; }
                else if (ph == 8)        { j.A = XB; j.Bt = WQ; j.M = T; j.N = DM; j.K = DM; j.E.kind = 0; j.E.part_off = (unsigned)WS_SS2; j.E.scale = 0.0625f * LOG2E; j.E.o_off = (unsigned)WS_YFB; j.E.ldc = DM; }
                else if (ph == 10)       { j.A = OX; j.Bt = WO; j.M = T; j.N = DM; j.K = DM; j.E.kind = 2; j.E.opart_off = (unsigned)WS_SS3; }
                else if (ph == 11)       { j.A = XB; j.Bt = WGU2; j.M = T; j.N = 2 * FF; j.K = DM; j.E.kind = 1; j.E.part_off = (unsigned)WS_SS3; j.E.o_off = (unsigned)WS_BIG; }
                else                     { j.A = U; j.Bt = WD2; j.M = T; j.N = DM; j.K = FF; j.E.kind = 2; j.E.scale = 0.5f; j.E.opart_off = (unsigned)WS_SS4; }
                run_gemm(lds, j.A, j.Bt, j.M, j.N, j.K, j.E);
            }
        } else if (ph == 4 && PH_ON(4)) {
            PH_IDS;
            LAS uchar* scr = lds + wave * 8448;
            { const float* cwp = INP(8); const float* cbp = INP(9); for (int it = gw; it < (T / 64) * 16; it += NGW) conv_item(PROJ, cwp, cbp, XC, XT, BTR, scr, it, lane); }
            for (int it = gw; it < NB * 4 * 2 * 64; it += NGW) { const int st = it & 63, dt = (it >> 6) & 1, bh = it >> 7, b = bh >> 2, h = bh & 3;
                transpose64(PROJ + (size_t)(b * SEQ + st * 64) * PLD + PC_V + h * 128 + dt * 64, PLD, VT + (size_t)(bh * 128 + dt * 64) * SEQ + st * 64, SEQ, scr, lane); }
            for (int it = gw; it < NB * 4 * 4 * 4; it += NGW) { const int mt = it & 3, dt = (it >> 2) & 3, bh = it >> 4, b = bh >> 2, h = bh & 3;
                transpose64(KVX + (size_t)(b * MEML + mt * 64) * (2 * DM) + DM + h * 256 + dt * 64, 2 * DM, VTX + (size_t)(bh * 256 + dt * 64) * MEML + mt * 64, MEML, scr, lane); }
        } else if (ph == 5 && PH_ON(5)) {
            PH_IDS;
#ifndef REP_SSD
#define REP_SSD 1
#endif
#ifndef REP_ATT
#define REP_ATT 1
#endif
            for (int rep = 0; rep < REP_SSD; ++rep)
            for (int it = bx; it < NB * 8 * 2; it += G) { const int dir = it & 1, h = (it >> 1) & 7, b = it >> 4;
                const float Aneg = -__expf(dir ? INP(13)[h] : INP(12)[h]);
                ssd_item(lds, b, h, dir, XC, DTB, Aneg, dir ? YB : YF); }
            for (int rep = 0; rep < REP_ATT; ++rep)
            for (int i = 0;; ++i) {
                int bh, qb;
                if (G == 256) { if (i >= 8) break; bh = i * 8 + (bx & 7); qb = bx >> 3; }
                else { const int L = i * G + bx; if (L >= 2048) break; bh = L >> 5; qb = L & 31; }
                const int b = bh >> 2, h = bh & 3; const size_t row0 = (size_t)b * SEQ + qb * 128;
                const int t = wave & 1;
                attn_item<64, 128, 128, 64, 0, true>(lds, PROJ + row0 * PLD + PC_Q + h * 128 + t * 64, PLD, PROJ + (size_t)b * SEQ * PLD + PC_K + h * 128, PLD, t * 64,
                                               VT + (size_t)bh * 128 * SEQ, SEQ, 0, YMIX + row0 * DM + 512 + h * 128, DM, lamp[0], INP(20));
            }
        } else if (ph == 6 && PH_ON(6)) {
            PH_IDS;
            for (int it = gw; it < T * 2; it += NGW) { const int tok = it >> 1, g = it & 1, c = g * 256 + 4 * lane, h = c >> 6;
                const u32x2 yf = *(const u32x2*)(YF + (size_t)tok * 512 + c), yb = *(const u32x2*)(YB + (size_t)tok * 512 + c), xv = *(const u32x2*)(XC + (size_t)tok * 1024 + c), zv = *(const u32x2*)(PROJ + (size_t)tok * PLD + PC_Z + c);
                const float D = INP(14)[h];
                float y[4];
                y[0] = (bflo(yf.x) + bflo(yb.x) + D * bflo(xv.x)) * silu_f(bflo(zv.x)); y[1] = (bfhi(yf.x) + bfhi(yb.x) + D * bfhi(xv.x)) * silu_f(bfhi(zv.x));
                y[2] = (bflo(yf.y) + bflo(yb.y) + D * bflo(xv.y)) * silu_f(bflo(zv.y)); y[3] = (bfhi(yf.y) + bfhi(yb.y) + D * bfhi(xv.y)) * silu_f(bfhi(zv.y));
                const float ss = wave_sum((y[0] * y[0] + y[1] * y[1]) + (y[2] * y[2] + y[3] * y[3])); const float rn = 1.0f / sqrtf(ss * (1.0f / 256.0f) + EPS);
                const f32x4 gv = *(const f32x4*)(INP(15) + c);
                u32x2 w; w.x = cvtpk(y[0] * rn * gv[0], y[1] * rn * gv[1]); w.y = cvtpk(y[2] * rn * gv[2], y[3] * rn * gv[3]);
                *(u32x2*)(YMIX + (size_t)tok * DM + c) = w; }
        } else if (ph == 9 && PH_ON(9)) {
            PH_IDS;
            for (int i = 0;; ++i) {
                int bh, qb;
                if (G == 256) { if (i >= 8) break; bh = i * 8 + (bx & 7); qb = bx >> 3; }
                else { const int L = i * G + bx; if (L >= 2048) break; bh = L >> 5; qb = L & 31; }
                const int b = bh >> 2, h = bh & 3; const size_t row0 = (size_t)b * SEQ + qb * 128;
                const int t = wave & 1;
                attn_item<256, 256, 256, 4, 1, false>(lds, QX + row0 * DM + h * 256, DM, KVX + (size_t)b * MEML * (2 * DM) + h * 256, 2 * DM, 0,
                                               VTX + (size_t)bh * 256 * MEML, MEML, t * 128, OX + row0 * DM + h * 256, DM, 0.f, nullptr);
            }
        } else if (ph == 13 && PH_ON(13)) {
            PH_IDS;
            for (int row = gw; row < T; row += NGW) { const float rs = row_rs(SS4, row); f32x4* xr = (f32x4*)(out + (size_t)row * DM); const u32x2* xs = (const u32x2*)(XB + (size_t)row * DM);
#pragma unroll
                for (int j = 0; j < 4; ++j) { const f32x4 gv = ((const f32x4*)INP(31))[lane + 64 * j]; const u32x2 xv = xs[lane + 64 * j]; f32x4 v; v[0] = bflo(xv.x); v[1] = bfhi(xv.x); v[2] = bflo(xv.y); v[3] = bfhi(xv.y);
                    xr[lane + 64 * j] = v * rs * gv; } }
        }
        if (ph + 1 < a.ph_hi) cg::this_grid().sync();
    }
}

extern "C" void kernel_launch(void* const* d_in, const int* in_sizes, int n_in, void* d_out, int out_size, void* d_ws, size_t ws_size, hipStream_t stream) {
    static int grid = 0;
    if (grid == 0) {
        if (n_in != 32 || in_sizes[0] != T * DM || out_size != T * DM || ws_size < WS_END) {
            fprintf(stderr, "kernel_launch: unexpected shapes (n_in %d, in0 %d, out %d, ws %zu < %zu); nothing launched\n", n_in, n_in > 0 ? in_sizes[0] : -1, out_size, ws_size, (size_t)WS_END); grid = -1; return; }
        int dev = 0, cus = 0, per_cu = 0;
        hipGetDevice(&dev); hipDeviceGetAttribute(&cus, hipDeviceAttributeMultiprocessorCount, dev);
        if (hipFuncSetAttribute((const void*)mega_fwd, hipFuncAttributeMaxDynamicSharedMemorySize, LDS_BYTES) != hipSuccess) { fprintf(stderr, "kernel_launch: hipFuncSetAttribute failed\n"); grid = -1; return; }
        if (hipOccupancyMaxActiveBlocksPerMultiprocessor(&per_cu, (const void*)mega_fwd, 512, LDS_BYTES) != hipSuccess || per_cu < 1) { fprintf(stderr, "kernel_launch: occupancy query says %d\n", per_cu); per_cu = 1; }
        (void)hipGetLastError();
        grid = cus * per_cu;
        if (grid <= 0) grid = 256;
    }
    if (grid < 0) return;
    Args a{};
    for (int i = 0; i < 32; ++i) a.in[i] = (const float*)d_in[i];
    a.out = (float*)d_out; a.ws = (unsigned char*)d_ws;
#if MK_COOP
    a.ph_lo = 0; a.ph_hi = N_PHASES;
    void* kargs[] = {&a};
    hipError_t e = hipLaunchCooperativeKernel((const void*)mega_fwd, dim3(grid), dim3(512), kargs, LDS_BYTES, stream);
    if (e != hipSuccess) fprintf(stderr, "kernel_launch: cooperative launch failed: %s (grid %d)\n", hipGetErrorString(e), grid);
#else
    for (int ph = 0; ph < N_PHASES; ++ph) { a.ph_lo = ph; a.ph_hi = ph + 1; hipLaunchKernelGGL(mega_fwd, dim3(grid), dim3(512), LDS_BYTES, stream, a); }
#endif
}
```

```cpp
#include <hip/hip_runtime.h>
#include <hip/hip_cooperative_groups.h>
#include <cstdio>
#include <cstdint>
namespace cg = cooperative_groups;
#ifndef MK_COOP
#define MK_COOP 1
#endif
namespace pg8 {
#define PG8_LAS __attribute__((address_space(3)))
typedef unsigned short bf16_t;
typedef short bf16x8 __attribute__((ext_vector_type(8)));
typedef float f32x4 __attribute__((ext_vector_type(4)));
typedef unsigned u32x4 __attribute__((ext_vector_type(4)));
constexpr int BM = 256, BK = 64, HALF = 128, HTB = HALF * BK * 2  , STAGE_BYTES = 8 * HTB, NXCD = 8, WGM = 8;

__host__ __device__ __forceinline__ int lds_byte(int r, int c) { const int st = (r >> 4) * 2 + (c >> 5), rr = r & 15, cc = c & 31, ob = rr * 64 + cc * 2; return st * 1024 + (ob ^ (((ob >> 9) & 1) << 5)); }
__host__ __device__ __forceinline__ void stage_rc(int b, int& R, int& C) { const int st = b / 1024, sb = b % 1024, swz = sb ^ (((sb >> 9) & 1) << 5); R = (st >> 1) * 16 + swz / 64; C = (st & 1) * 32 + (swz % 64) / 2; }
__host__ __device__ __forceinline__ int perm32(int rho) { const int n = rho >> 4, i = rho & 15; return 8 * (i >> 2) + 4 * n + (i & 3); }

struct Unit { int pm, pn; };
struct Gemm { const bf16_t* A; const bf16_t* Bt; int M, N, K; };

struct StaticOrder {
    int nM, nN, nwg, G, c;
    __host__ __device__ void init(int M, int N, int G_, int c_) { nM = M / BM; nN = N / BM; nwg = nM * nN; G = G_; c = c_; }
    __host__ __device__ bool next(int i, Unit& u) const {
        const long L = (long)i * G + c; if (L >= nwg) return false;
        int wgid = (int)L; { const int q = nwg / NXCD, r = nwg % NXCD, xcd = wgid % NXCD, off = wgid / NXCD; wgid = (xcd < r ? xcd * (q + 1) : r * (q + 1) + (xcd - r) * q) + off; }
        const int nig = WGM * nN, gid = wgid / nig, fm = gid * WGM, gsz = (nM - fm) < WGM ? (nM - fm) : WGM;
        u.pm = fm + ((wgid % nig) % gsz); u.pn = (wgid % nig) / gsz; return true;
    }
    __device__ __forceinline__ void a_ready(const Unit&) const {}
    __device__ __forceinline__ void done(const Unit&) const {}
};
__device__ __forceinline__ unsigned cvt_pk_bf16(float lo, float hi) { unsigned r; asm volatile("v_cvt_pk_bf16_f32 %0, %1, %2" : "=v"(r) : "v"(lo), "v"(hi)); return r; }
template <class Epi, class Sched, bool ALIGN_EPI = false, bool SP2 = false>
__device__ __forceinline__ void gemm_phase(PG8_LAS unsigned char* lds, const Gemm g, const Sched& S, const Epi& E) {
    int tid = threadIdx.x; asm volatile("" : "+v"(tid)); const int wid = __builtin_amdgcn_readfirstlane(tid >> 6), lane = tid & 63, wr = wid >> 2, wc = wid & 3, fr = lane & 15, fq = lane >> 4;
    const int K = g.K, nt = K / BK;
    unsigned voffA[2], voffB[2];
#pragma unroll
    for (int i = 0; i < 2; ++i) { int R, C; stage_rc(tid * 16 + i * 8192, R, C); const int Rb = Epi::PERM ? ((R & ~31) + perm32(R & 31)) : R;
        voffA[i] = (unsigned)(R * K + C) * 2u; voffB[i] = (unsigned)(Rb * K + C) * 2u; }
    const size_t kstep = (size_t)(BK * 2);
    const size_t hstep = (size_t)HALF * K * 2;
    const size_t tstep = 2 * hstep;
    const unsigned ldsw = (unsigned)wid * 1024u;
    const int aoff = lds_byte(wr * 64 + fr, fq * 8), boff = lds_byte(wc * 32 + fr, fq * 8);
#define PG8_SA(b, h) (((b) * 2 + (h)) * HTB)
#define PG8_SB(b, h) ((4 + (b) * 2 + (h)) * HTB)
#define PG8_STAGE(bufoff, gbase, voff) do { _Pragma("unroll") for (int _i = 0; _i < 2; ++_i) \
        __builtin_amdgcn_global_load_lds((const unsigned*)((const char*)(gbase) + (voff)[_i]), (PG8_LAS unsigned*)(lds + (bufoff) + ldsw + _i * 8192), 16, 0, 0); } while (0)
#define PG8_LDA(dst, b, h) do { _Pragma("unroll") for (int m = 0; m < 4; ++m) _Pragma("unroll") for (int k = 0; k < 2; ++k) dst[m][k] = *(const PG8_LAS bf16x8*)(lds + PG8_SA(b, h) + aoff + m * 2048 + k * 1024); } while (0)
#define PG8_LDB(dst, b, h) do { _Pragma("unroll") for (int n = 0; n < 2; ++n) _Pragma("unroll") for (int k = 0; k < 2; ++k) dst[n][k] = *(const PG8_LAS bf16x8*)(lds + PG8_SB(b, h) + boff + n * 2048 + k * 1024); } while (0)
#define PG8_MMA(ai, bj, At, Bt) do { __builtin_amdgcn_s_setprio(1); _Pragma("unroll") for (int m = 0; m < 4; ++m) _Pragma("unroll") for (int n = 0; n < 2; ++n) _Pragma("unroll") for (int k = 0; k < 2; ++k) \
        acc[ai][bj][m][n] = __builtin_amdgcn_mfma_f32_16x16x32_bf16(Bt[n][k], At[m][k], acc[ai][bj][m][n], 0, 0, 0); __builtin_amdgcn_s_setprio(0); } while (0)
#define PG8_WAIT_V(n) asm volatile("s_waitcnt vmcnt(" #n ")" ::: "memory")
#define PG8_WAIT_L(n) asm volatile("s_waitcnt lgkmcnt(" #n ")" ::: "memory")
#define PG8_BAR __builtin_amdgcn_s_barrier()
#define PG8_SCHED __builtin_amdgcn_sched_barrier(0)
    Unit cur, nxt; int ui = 0;
    if (!S.next(0, cur)) return;
    f32x4 acc[2][2][4][2];
#pragma unroll
    for (int a = 0; a < 2; ++a)
#pragma unroll
        for (int b = 0; b < 2; ++b)
#pragma unroll
            for (int m = 0; m < 4; ++m)
#pragma unroll
                for (int n = 0; n < 2; ++n) acc[a][b][m][n] = (f32x4){0.f, 0.f, 0.f, 0.f};
    bf16x8 At[4][2], B0[2][2], B1[2][2];
    const char* cA = (const char*)g.A + (size_t)cur.pm * tstep; const char* cB = (const char*)g.Bt + (size_t)cur.pn * tstep;
    S.a_ready(cur);
    if constexpr (SP2) {
        PG8_STAGE(PG8_SB(0, 0), cB, voffB); PG8_STAGE(PG8_SB(0, 1), cB + hstep, voffB); PG8_STAGE(PG8_SA(0, 0), cA, voffA); PG8_STAGE(PG8_SA(0, 1), cA + hstep, voffA);
        if (wr == 1) PG8_BAR;
        PG8_WAIT_V(2); PG8_BAR;
        PG8_STAGE(PG8_SB(1, 0), cB + kstep, voffB); PG8_STAGE(PG8_SA(1, 0), cA + kstep, voffA); PG8_STAGE(PG8_SB(1, 1), cB + hstep + kstep, voffB);
        PG8_WAIT_V(6); PG8_BAR;
    } else {
        PG8_STAGE(PG8_SB(0, 0), cB, voffB); PG8_STAGE(PG8_SA(0, 0), cA, voffA); PG8_STAGE(PG8_SB(0, 1), cB + hstep, voffB); PG8_STAGE(PG8_SA(0, 1), cA + hstep, voffA);
        if (wr == 1) PG8_BAR;
        PG8_WAIT_V(4); PG8_BAR;
        PG8_STAGE(PG8_SB(1, 0), cB + kstep, voffB); PG8_STAGE(PG8_SA(1, 0), cA + kstep, voffA); PG8_STAGE(PG8_SB(1, 1), cB + hstep + kstep, voffB);
        PG8_WAIT_V(6); PG8_BAR;
    }
    for (;;) {
        const bool has_next = S.next(ui + 1, nxt);
        const char* nA = has_next ? (const char*)g.A + (size_t)nxt.pm * tstep : cA; const char* nB = has_next ? (const char*)g.Bt + (size_t)nxt.pn * tstep : cB;
        for (int t = 0; t < nt; t += 2) {
            const bool last = (t == nt - 2);
            const char* a1 = cA + (size_t)(t + 1) * kstep;
            const char* a2 = last ? nA : cA + (size_t)(t + 2) * kstep; const char* b2 = last ? nB : cB + (size_t)(t + 2) * kstep;
            const char* a3 = a2 + kstep; const char* b3 = b2 + kstep;
            if (last && has_next) S.a_ready(nxt);
            if constexpr (SP2) {
            PG8_LDB(B0, 0, 0); PG8_LDB(B1, 0, 1); PG8_SCHED; PG8_LDA(At, 0, 0); PG8_STAGE(PG8_SA(1, 1), a1 + hstep, voffA);
            PG8_WAIT_V(8); PG8_WAIT_L(0); PG8_BAR; PG8_MMA(0, 0, At, B0); PG8_MMA(0, 1, At, B1); PG8_BAR; PG8_SCHED;
            PG8_LDA(At, 0, 1); PG8_STAGE(PG8_SB(0, 0), b2, voffB); PG8_STAGE(PG8_SB(0, 1), b2 + hstep, voffB); PG8_STAGE(PG8_SA(0, 0), a2, voffA);
            PG8_WAIT_V(8); PG8_WAIT_L(0); PG8_BAR; PG8_MMA(1, 0, At, B0); PG8_MMA(1, 1, At, B1); PG8_BAR; PG8_SCHED;
            PG8_LDB(B0, 1, 0); PG8_LDB(B1, 1, 1); PG8_SCHED; PG8_LDA(At, 1, 0); PG8_STAGE(PG8_SA(0, 1), a2 + hstep, voffA);
            PG8_WAIT_V(8); PG8_WAIT_L(0); PG8_BAR; PG8_MMA(0, 0, At, B0); PG8_MMA(0, 1, At, B1); PG8_BAR; PG8_SCHED;
            PG8_LDA(At, 1, 1); PG8_STAGE(PG8_SB(1, 0), b3, voffB); PG8_STAGE(PG8_SB(1, 1), b3 + hstep, voffB); PG8_STAGE(PG8_SA(1, 0), a3, voffA);
            PG8_WAIT_V(8); PG8_WAIT_L(0); PG8_BAR; PG8_MMA(1, 0, At, B0); PG8_MMA(1, 1, At, B1); PG8_BAR; PG8_SCHED;
            } else {
            PG8_LDB(B0, 0, 0); PG8_SCHED; PG8_LDA(At, 0, 0); PG8_STAGE(PG8_SA(1, 1), a1 + hstep, voffA);
            PG8_WAIT_L(8); PG8_BAR; PG8_WAIT_L(0); PG8_MMA(0, 0, At, B0); PG8_BAR; PG8_SCHED;
            PG8_LDB(B1, 0, 1); PG8_STAGE(PG8_SB(0, 0), b2, voffB);
            PG8_BAR; PG8_WAIT_L(0); PG8_MMA(0, 1, At, B1); PG8_BAR;
            PG8_LDA(At, 0, 1); PG8_STAGE(PG8_SA(0, 0), a2, voffA);
            PG8_BAR; PG8_WAIT_L(0); PG8_MMA(1, 0, At, B0); PG8_BAR; PG8_SCHED;
            PG8_STAGE(PG8_SB(0, 1), b2 + hstep, voffB);
            PG8_WAIT_V(6); PG8_BAR; PG8_MMA(1, 1, At, B1); PG8_BAR;
            PG8_LDB(B0, 1, 0); PG8_SCHED; PG8_LDA(At, 1, 0); PG8_STAGE(PG8_SA(0, 1), a2 + hstep, voffA);
            PG8_WAIT_L(8); PG8_BAR; PG8_WAIT_L(0); PG8_MMA(0, 0, At, B0); PG8_BAR; PG8_SCHED;
            PG8_LDB(B1, 1, 1); PG8_STAGE(PG8_SB(1, 0), b3, voffB);
            PG8_BAR; PG8_WAIT_L(0); PG8_MMA(0, 1, At, B1); PG8_BAR;
            PG8_LDA(At, 1, 1); PG8_STAGE(PG8_SA(1, 0), a3, voffA);
            PG8_BAR; PG8_WAIT_L(0); PG8_MMA(1, 0, At, B0); PG8_BAR; PG8_SCHED;
            PG8_STAGE(PG8_SB(1, 1), b3 + hstep, voffB);
            PG8_WAIT_V(6); PG8_BAR; PG8_MMA(1, 1, At, B1); PG8_BAR;
            }
        }
        if constexpr (ALIGN_EPI) { if (wr == 0) PG8_BAR; }
        if constexpr (!Epi::AFTER_DRAIN) { E(acc, cur, wr, wc, fr, fq); S.done(cur); }
        if (!has_next) break;
#pragma unroll
        for (int a = 0; a < 2; ++a)
#pragma unroll
            for (int b = 0; b < 2; ++b)
#pragma unroll
                for (int m = 0; m < 4; ++m)
#pragma unroll
                    for (int n = 0; n < 2; ++n) acc[a][b][m][n] = (f32x4){0.f, 0.f, 0.f, 0.f};
        cur = nxt; cA = nA; cB = nB; ++ui;
        if constexpr (ALIGN_EPI) { if (wr == 1) PG8_BAR; }
    }
    PG8_WAIT_V(0);
    if constexpr (!ALIGN_EPI) { if (wr == 0) PG8_BAR; }
    PG8_BAR;
    if constexpr (Epi::AFTER_DRAIN) { E.fused(acc, cur, wr, wc, fr, fq, lds, wid, lane); S.done(cur); }
#undef PG8_SA
#undef PG8_SB
#undef PG8_STAGE
#undef PG8_LDA
#undef PG8_LDB
#undef PG8_MMA
#undef PG8_WAIT_V
#undef PG8_WAIT_L
#undef PG8_BAR
#undef PG8_SCHED
}
}

#define LAS __attribute__((address_space(3)))
typedef unsigned char uchar;
typedef pg8::bf16_t bf16_t;
typedef pg8::bf16x8 bf16x8;
typedef pg8::f32x4 f32x4;
typedef pg8::u32x4 u32x4;
typedef unsigned u32x2 __attribute__((ext_vector_type(2)));
typedef float f32x2 __attribute__((ext_vector_type(2)));
typedef float f32x16 __attribute__((ext_vector_type(16)));
typedef __bf16 bf16x2_t __attribute__((ext_vector_type(2)));

constexpr int NB = 16, SEQ = 4096, T = NB * SEQ, DM = 1024, FF = 2816, MEML = 256, TM = NB * MEML;
constexpr int NPROJ = 3328, PLD = 3072;
constexpr int PC_Z = 0, PC_X = 512, PC_B = 1024, PC_C = 1280, PC_Q = 1536, PC_K = 2048, PC_V = 2560;
constexpr float EPS = 1e-5f, LOG2E = 1.4426950408889634f;
constexpr float LAMBDA_INIT = 0.2f;

constexpr size_t MiB = 1u << 20;
constexpr size_t WS_CTL = 0, WS_ROPE = 1 * MiB, WS_SS0 = 2 * MiB, WS_SS1 = 6 * MiB, WS_SS2 = 10 * MiB, WS_SS3 = 14 * MiB, WS_SS4 = 18 * MiB, WS_SSM = 22 * MiB,
                 WS_DT = 23 * MiB, WS_WGU1 = 27 * MiB, WS_WD1 = 38 * MiB, WS_WIN = 44 * MiB, WS_WOUT = 51 * MiB, WS_WQ = 53 * MiB, WS_WKV = 55 * MiB, WS_WO = 59 * MiB,
                 WS_WGU2 = 61 * MiB, WS_WD2 = 72 * MiB, WS_MEMB = 78 * MiB, WS_KVX = 86 * MiB, WS_VTX = 102 * MiB, WS_VT = 110 * MiB, WS_XB = 174 * MiB,
                 WS_YMIX = 302 * MiB, WS_YFB = 430 * MiB, WS_BIG = 558 * MiB, WS_END = 942 * MiB;
constexpr int LDS_BYTES = 147456, PTAB_OFF = LDS_BYTES - 512, LDS_PTAB_ABS = PTAB_OFF;

__device__ __forceinline__ const float* lds_inp(int k) {
    const LAS unsigned long long* ptab = (const LAS unsigned long long*)(uintptr_t)0; const unsigned long long v = *(const LAS unsigned long long*)((const LAS uchar*)ptab + LDS_PTAB_ABS + 8 * k);
    return (const float*)(((unsigned long long)(unsigned)__builtin_amdgcn_readfirstlane((int)(v >> 32)) << 32) | (unsigned long long)(unsigned)__builtin_amdgcn_readfirstlane((int)(v & 0xffffffffull)));
}
__device__ __forceinline__ int opaque_tid() { int t = threadIdx.x; asm volatile("" : "+v"(t)); return t; }
__device__ __forceinline__ unsigned cvtpk(float lo, float hi) { f32x2 v = {lo, hi}; bf16x2_t b = __builtin_convertvector(v, bf16x2_t); return __builtin_bit_cast(unsigned, b); }
__device__ __forceinline__ float bflo(unsigned w) { return __uint_as_float(w << 16); }
__device__ __forceinline__ float bfhi(unsigned w) { return __uint_as_float(w & 0xffff0000u); }
__device__ __forceinline__ float wave_sum(float v) {
#pragma unroll
    for (int o = 1; o < 64; o <<= 1) v += __shfl_xor(v, o);
    return v;
}
__device__ __forceinline__ float fast_exp2(float x) { return __builtin_amdgcn_exp2f(x); }
__device__ __forceinline__ float silu_f(float g) { return g * __builtin_amdgcn_rcpf(1.0f + fast_exp2(-LOG2E * g)); }
__device__ __forceinline__ float row_rs(const float* part, int row) {
    const f32x4* p = (const f32x4*)(part + (size_t)row * 16);
    const f32x4 a = p[0], b = p[1], c = p[2], d = p[3];
    const float s = (((a[0] + a[1]) + (a[2] + a[3])) + ((b[0] + b[1]) + (b[2] + b[3]))) + (((c[0] + c[1]) + (c[2] + c[3])) + ((d[0] + d[1]) + (d[2] + d[3])));
    return 1.0f / sqrtf(s * (1.0f / 1024.0f) + EPS);
}

struct EpiBf16RS {
    static constexpr bool PERM = true, AFTER_DRAIN = false;
    const float* part; float scale; bf16_t* O; int ldc;
    __device__ __forceinline__ void operator()(const f32x4 (&acc)[2][2][4][2], const pg8::Unit& u, int wr, int wc, int fr, int fq) const {
        const int row0 = u.pm * 256 + wr * 64 + fr, col0 = u.pn * 256 + wc * 32 + 8 * fq;
#pragma unroll
        for (int ai = 0; ai < 2; ++ai)
#pragma unroll
            for (int m = 0; m < 4; ++m) {
                const int row = row0 + ai * 128 + m * 16; const float rs = row_rs(part, row) * scale; bf16_t* rp = O + (size_t)row * ldc + col0;
#pragma unroll
                for (int bj = 0; bj < 2; ++bj) { const f32x4 v0 = acc[ai][bj][m][0] * rs, v1 = acc[ai][bj][m][1] * rs;
                    u32x4 w; w.x = cvtpk(v0[0], v0[1]); w.y = cvtpk(v0[2], v0[3]); w.z = cvtpk(v1[0], v1[1]); w.w = cvtpk(v1[2], v1[3]);
                    *(u32x4*)(rp + bj * 128) = w; }
                asm volatile("" ::: "memory");
            }
    }
};
struct EpiSwiGLU {
    static constexpr bool PERM = true, AFTER_DRAIN = false;
    const float* part; bf16_t* U;
    __device__ __forceinline__ void operator()(const f32x4 (&acc)[2][2][4][2], const pg8::Unit& u, int wr, int wc, int fr, int fq) const {
        const int row0 = u.pm * 256 + wr * 64 + fr, col0 = u.pn * 128 + wc * 32 + 8 * fq;
#pragma unroll
        for (int ai = 0; ai < 2; ++ai)
#pragma unroll
            for (int m = 0; m < 4; ++m) {
                const int row = row0 + ai * 128 + m * 16; const float rs = row_rs(part, row);
                float h[8];
#pragma unroll
                for (int n = 0; n < 2; ++n)
#pragma unroll
                    for (int e = 0; e < 4; ++e) { const float g = acc[ai][0][m][n][e] * rs, up = acc[ai][1][m][n][e] * rs; h[4 * n + e] = silu_f(g) * up; }
                u32x4 w; w.x = cvtpk(h[0], h[1]); w.y = cvtpk(h[2], h[3]); w.z = cvtpk(h[4], h[5]); w.w = cvtpk(h[6], h[7]);
                *(u32x4*)(U + (size_t)row * FF + col0) = w;
                asm volatile("" ::: "memory");
            }
    }
};
struct EpiResidual {
    static constexpr bool PERM = true, AFTER_DRAIN = false;
    float alpha; bf16_t* xb; float* part;
    __device__ __forceinline__ void operator()(const f32x4 (&acc)[2][2][4][2], const pg8::Unit& u, int wr, int wc, int fr, int fq) const {
        const int row0 = u.pm * 256 + wr * 64 + fr, col0 = u.pn * 256 + wc * 32 + 8 * fq;
#pragma unroll
        for (int ai = 0; ai < 2; ++ai)
#pragma unroll
            for (int m = 0; m < 4; ++m) {
                const int row = row0 + ai * 128 + m * 16; float ss = 0.f;
#pragma unroll
                for (int bj = 0; bj < 2; ++bj) { const size_t off = (size_t)row * DM + col0 + bj * 128;
                    const u32x4 rv = *(const u32x4*)(xb + off);
                    f32x4 v0, v1; v0[0] = bflo(rv.x); v0[1] = bfhi(rv.x); v0[2] = bflo(rv.y); v0[3] = bfhi(rv.y); v1[0] = bflo(rv.z); v1[1] = bfhi(rv.z); v1[2] = bflo(rv.w); v1[3] = bfhi(rv.w);
                    v0 = v0 + acc[ai][bj][m][0] * alpha; v1 = v1 + acc[ai][bj][m][1] * alpha;
                    u32x4 w; w.x = cvtpk(v0[0], v0[1]); w.y = cvtpk(v0[2], v0[3]); w.z = cvtpk(v1[0], v1[1]); w.w = cvtpk(v1[2], v1[3]); *(u32x4*)(xb + off) = w;
                    ss += ((v0[0] * v0[0] + v0[1] * v0[1]) + (v0[2] * v0[2] + v0[3] * v0[3])) + ((v1[0] * v1[0] + v1[1] * v1[1]) + (v1[2] * v1[2] + v1[3] * v1[3])); }
                ss += __shfl_xor(ss, 16); ss += __shfl_xor(ss, 32);
                if (fq == 0) part[(size_t)row * 16 + u.pn * 4 + wc] = ss;
                asm volatile("" ::: "memory");
            }
    }
};
struct EpiProj {
    static constexpr bool PERM = true, AFTER_DRAIN = false;
    const float* part; bf16_t* P; float* DT; const float* cs; const float* sn; const float* dtb_f; const float* dtb_b;
    __device__ __forceinline__ void operator()(const f32x4 (&acc)[2][2][4][2], const pg8::Unit& u, int wr, int wc, int fr, int fq) const {
        const int pn = u.pn; const int row0 = u.pm * 256 + wr * 64 + fr;
        if (pn == 12) {
            if (wc == 0 && fq < 2) {
                const float* bias = (fq == 0) ? dtb_f : dtb_b;
#pragma unroll
                for (int ai = 0; ai < 2; ++ai)
#pragma unroll
                    for (int m = 0; m < 4; ++m) { const int row = row0 + ai * 128 + m * 16; const float rs = row_rs(part, row);
#pragma unroll
                        for (int n = 0; n < 2; ++n) { f32x4 o;
#pragma unroll
                            for (int e = 0; e < 4; ++e) { const float x = acc[ai][0][m][n][e] * rs + bias[4 * n + e]; o[e] = x > 20.f ? x : log1pf(__expf(x)); }
                            *(f32x4*)(DT + (size_t)row * 16 + 8 * fq + 4 * n) = o; } asm volatile("" ::: "memory"); }
            }
            return;
        }
        const bool isq = (pn == 6 || pn == 7), isk = (pn == 8 || pn == 9), rope = (isq || isk) && ((wc & 1) == 0);
        const float qs = isq ? 0.125f * LOG2E : 1.0f; const float sgn = (fq == 0) ? -1.f : 1.f;
        const int col0 = pn * 256 + wc * 32 + 8 * fq;
#pragma unroll
        for (int ai = 0; ai < 2; ++ai)
#pragma unroll
            for (int m = 0; m < 4; ++m) {
                const int row = row0 + ai * 128 + m * 16; const float rs = row_rs(part, row) * qs; const int pos = row & (SEQ - 1);
                bf16_t* rp = P + (size_t)row * PLD + col0;
#pragma unroll
                for (int bj = 0; bj < 2; ++bj) { f32x4 v0 = acc[ai][bj][m][0], v1 = acc[ai][bj][m][1];
                    if (rope) { f32x4 p0, p1;
#pragma unroll
                        for (int e = 0; e < 4; ++e) { p0[e] = __shfl_xor(v0[e], 16); p1[e] = __shfl_xor(v1[e], 16); }
                        if (fq < 2) { const f32x4 c0 = *(const f32x4*)(cs + pos * 8), c1 = *(const f32x4*)(cs + pos * 8 + 4), s0 = *(const f32x4*)(sn + pos * 8), s1 = *(const f32x4*)(sn + pos * 8 + 4);
                            v0 = v0 * c0 + p0 * s0 * sgn; v1 = v1 * c1 + p1 * s1 * sgn; } }
                    v0 = v0 * rs; v1 = v1 * rs;
                    u32x4 w; w.x = cvtpk(v0[0], v0[1]); w.y = cvtpk(v0[2], v0[3]); w.z = cvtpk(v1[0], v1[1]); w.w = cvtpk(v1[2], v1[3]);
                    *(u32x4*)(rp + bj * 128) = w; }
                asm volatile("" ::: "memory");
            }
    }
};
struct EpiAny {
    static constexpr bool PERM = true, AFTER_DRAIN = false;
    int kind; unsigned char* ws; float scale; unsigned part_off, o_off, opart_off; int ldc;
    __device__ __forceinline__ void operator()(const f32x4 (&acc)[2][2][4][2], const pg8::Unit& u, int wr, int wc, int fr, int fq) const {
        if (kind == 0) { EpiBf16RS e{(const float*)(ws + part_off), scale, (bf16_t*)(ws + o_off), ldc}; e(acc, u, wr, wc, fr, fq); }
        else if (kind == 1) { EpiSwiGLU e{(const float*)(ws + part_off), (bf16_t*)(ws + o_off)}; e(acc, u, wr, wc, fr, fq); }
        else if (kind == 2) { EpiResidual e{scale, (bf16_t*)(ws + WS_XB), (float*)(ws + opart_off)}; e(acc, u, wr, wc, fr, fq); }
        else { EpiProj e{(const float*)(ws + part_off), (bf16_t*)(ws + o_off), (float*)(ws + WS_DT), (const float*)(ws + WS_ROPE), (const float*)(ws + WS_ROPE) + SEQ * 8, lds_inp(10), lds_inp(11)}; e(acc, u, wr, wc, fr, fq); }
    }
};
struct GJob { const bf16_t* A; const bf16_t* Bt; int M, N, K; EpiAny E; };
template <class Epi> __device__ __forceinline__ void run_gemm(LAS uchar* lds, const bf16_t* A, const bf16_t* Bt, int M, int N, int K, const Epi& E) {
    pg8::Gemm g{A, Bt, M, N, K}; pg8::StaticOrder S; S.init(M, N, (int)gridDim.x, (int)blockIdx.x);
    pg8::gemm_phase<Epi, pg8::StaticOrder, true, true>(lds, g, S, E);
}

__device__ __forceinline__ int map_row(int kind, int n) {
    if (kind == 1) return (n >> 7) * 256 + (n & 127);
    if (kind == 2) return (n >> 7) * 256 + 128 + (n & 127);
    if (kind == 3) return n < 1536 ? n : (n < 1552 ? 3072 + (n - 1536) : n - 16);
    return n;
}
__device__ __forceinline__ void p0_transpose_item(const float* W, int K, int N, bf16_t* WT, int kind, const float* g, LAS float* scr, int item, int lane) {
    const int nblk = (N + 31) >> 5, kb = item / nblk, nb = item - kb * nblk, k0 = 64 * kb, n0 = 32 * nb;
    const int ncol = n0 + (lane & 31); const bool valid = ncol < N;
#pragma unroll 8
    for (int i = 0; i < 32; ++i) { const int kk = 2 * i + (lane >> 5); float v = valid ? W[(size_t)(k0 + kk) * N + ncol] : 0.f; if (g) v *= g[k0 + kk]; scr[kk * 33 + (lane & 31)] = v; }
    asm volatile("s_waitcnt lgkmcnt(0)" ::: "memory");
    const int c = lane & 7;
#pragma unroll
    for (int j = 0; j < 4; ++j) { const int n = (lane >> 3) + 8 * j; const LAS float* s = scr + (8 * c) * 33 + n;
        if (n0 + n < N) { u32x4 o; o.x = cvtpk(s[0 * 33], s[1 * 33]); o.y = cvtpk(s[2 * 33], s[3 * 33]); o.z = cvtpk(s[4 * 33], s[5 * 33]); o.w = cvtpk(s[6 * 33], s[7 * 33]);
            *(u32x4*)(WT + (size_t)map_row(kind, n0 + n) * K + k0 + 8 * c) = o; } }
    asm volatile("s_waitcnt lgkmcnt(0)" ::: "memory");
}
__device__ __forceinline__ void row_to_bf16_ss(const float* xrow, bf16_t* orow, float* part, int lane) {
    f32x4 v[4]; float s = 0.f;
#pragma unroll
    for (int j = 0; j < 4; ++j) { v[j] = ((const f32x4*)xrow)[lane + 64 * j]; s += (v[j][0] * v[j][0] + v[j][1] * v[j][1]) + (v[j][2] * v[j][2] + v[j][3] * v[j][3]); }
    s = wave_sum(s);
#pragma unroll
    for (int j = 0; j < 4; ++j) { u32x2 w; w.x = cvtpk(v[j][0], v[j][1]); w.y = cvtpk(v[j][2], v[j][3]); ((u32x2*)orow)[lane + 64 * j] = w; }
    if (lane < 16) part[lane] = (lane == 0) ? s : 0.f;
}
__device__ __forceinline__ void rope_entry(int idx, float* cs, float* sn) {
    const int pos = idx >> 3, i = idx & 7;
    const float invf = (i == 0) ? 1.0f : (i == 1) ? 0.193922758102417f : (i == 2) ? 0.03760603070259094f : (i == 3) ? 0.00729266507551074f : (i == 4) ? 0.001414213445968926f
                     : (i == 5) ? 0.00027424818836152554f : (i == 6) ? 5.318296462064609e-05f : 1.0313385246263351e-05f;
    const float angf = (float)pos * invf;
    const double x = (double)angf; const double kq = rint(x * 0.6366197723675814);
    double r = fma(-kq, 1.5707963267948966, x); r = fma(-kq, 6.123233995736766e-17, r);
    const int q = ((int)kq) & 3; const double r2 = r * r;
    const double s = r * (1.0 + r2 * (-1.0 / 6 + r2 * (1.0 / 120 + r2 * (-1.0 / 5040 + r2 * (1.0 / 362880 + r2 * (-1.0 / 39916800 + r2 * (1.0 / 6227020800.0)))))));
    const double c = 1.0 + r2 * (-0.5 + r2 * (1.0 / 24 + r2 * (-1.0 / 720 + r2 * (1.0 / 40320 + r2 * (-1.0 / 3628800 + r2 * (1.0 / 479001600.0 + r2 * (-1.0 / 87178291200.0)))))));
    const double co = (q == 0) ? c : (q == 1) ? -s : (q == 2) ? -c : s;
    const double si = (q == 0) ? s : (q == 1) ? c : (q == 2) ? -s : -c;
    cs[idx] = (float)co; sn[idx] = (float)si;
}

__device__ __forceinline__ void transpose64(const bf16_t* src, int sp, bf16_t* dst, int dp, LAS uchar* scr, int lane) {
#pragma unroll
    for (int i = 0; i < 8; ++i) { const int r = i * 8 + (lane >> 3), c8 = lane & 7; const u32x4 v = *(const u32x4*)(src + (size_t)r * sp + c8 * 8);
        LAS unsigned* w = (LAS unsigned*)(scr + r * 132 + c8 * 16); w[0] = v.x; w[1] = v.y; w[2] = v.z; w[3] = v.w; }
    asm volatile("s_waitcnt lgkmcnt(0)" ::: "memory");
#pragma unroll
    for (int i = 0; i < 8; ++i) { const int c = i * 8 + (lane >> 3), r8 = lane & 7; unsigned e[8];
#pragma unroll
        for (int j = 0; j < 8; ++j) e[j] = *(const LAS unsigned short*)(scr + (r8 * 8 + j) * 132 + c * 2);
        u32x4 o; o.x = e[0] | (e[1] << 16); o.y = e[2] | (e[3] << 16); o.z = e[4] | (e[5] << 16); o.w = e[6] | (e[7] << 16);
        *(u32x4*)(dst + (size_t)c * dp + r8 * 8) = o; }
    asm volatile("s_waitcnt lgkmcnt(0)" ::: "memory");
}
__device__ __forceinline__ void conv_item(const bf16_t* P, const float* cw, const float* cb, bf16_t* XC, bf16_t* XT, bf16_t* BT, LAS uchar* scr, int item, int lane) {
    const int cb16 = item & 15, tt = item >> 4, tok0 = tt * 64, s0 = tok0 & (SEQ - 1), b = tok0 >> 12, ci = s0 >> 7, l0 = s0 & 127;
    const int c8 = lane & 7, tb = lane >> 3, ch = cb16 * 64 + c8 * 8;
    float w[5][8], bias[8];
#pragma unroll
    for (int k = 0; k < 5; ++k) { const f32x4 a = *(const f32x4*)(cw + k * 1024 + ch), bq = *(const f32x4*)(cw + k * 1024 + ch + 4);
#pragma unroll
        for (int e = 0; e < 4; ++e) { w[k][e] = a[e]; w[k][4 + e] = bq[e]; } }
    { const f32x4 a = *(const f32x4*)(cb + ch), bq = *(const f32x4*)(cb + ch + 4);
#pragma unroll
      for (int e = 0; e < 4; ++e) { bias[e] = a[e]; bias[4 + e] = bq[e]; } }
    const int sb = s0 + tb * 8;
    const bf16_t* src = P + (size_t)(tok0 + tb * 8) * PLD + PC_X + ch;
    float win[5][8];
#pragma unroll
    for (int j = 0; j < 4; ++j) { const int sq = sb + j - 2; u32x4 v = {0u, 0u, 0u, 0u}; if (sq >= 0 && sq < SEQ) v = *(const u32x4*)(src + (ptrdiff_t)(j - 2) * PLD);
        win[j][0] = bflo(v.x); win[j][1] = bfhi(v.x); win[j][2] = bflo(v.y); win[j][3] = bfhi(v.y); win[j][4] = bflo(v.z); win[j][5] = bfhi(v.z); win[j][6] = bflo(v.w); win[j][7] = bfhi(v.w); }
#pragma unroll
    for (int i = 0; i < 8; ++i) {
        { const int sq = sb + i + 2; u32x4 v = {0u, 0u, 0u, 0u}; if (sq < SEQ) v = *(const u32x4*)(src + (ptrdiff_t)(i + 2) * PLD);
          float* d = win[(i + 4) % 5];
          d[0] = bflo(v.x); d[1] = bfhi(v.x); d[2] = bflo(v.y); d[3] = bfhi(v.y); d[4] = bflo(v.z); d[5] = bfhi(v.z); d[6] = bflo(v.w); d[7] = bfhi(v.w); }
        float o[8];
#pragma unroll
        for (int e = 0; e < 8; ++e) { float acc = bias[e];
#pragma unroll
            for (int k = 0; k < 5; ++k) acc += w[k][e] * win[(i + k) % 5][e];
            o[e] = silu_f(acc); }
        u32x4 ov; ov.x = cvtpk(o[0], o[1]); ov.y = cvtpk(o[2], o[3]); ov.z = cvtpk(o[4], o[5]); ov.w = cvtpk(o[6], o[7]);
        *(u32x4*)(XC + (size_t)(tok0 + tb * 8 + i) * 1024 + ch) = ov;
        LAS unsigned* wq = (LAS unsigned*)(scr + (tb * 8 + i) * 132 + c8 * 16); wq[0] = ov.x; wq[1] = ov.y; wq[2] = ov.z; wq[3] = ov.w;
    }
    asm volatile("s_waitcnt lgkmcnt(0)" ::: "memory");
    if (cb16 < 12) {
        bf16_t* dst = (cb16 < 8) ? XT + ((size_t)((b * 32 + ci) * 8 + cb16) * 64) * 128 + l0
                                 : BT + ((size_t)((b * 32 + ci) * 2 + ((cb16 - 8) >> 1)) * 128 + ((cb16 - 8) & 1) * 64) * 128 + l0;
#pragma unroll
        for (int i = 0; i < 8; ++i) { const int c = i * 8 + (lane >> 3), r8 = lane & 7; unsigned e[8];
#pragma unroll
            for (int j = 0; j < 8; ++j) e[j] = *(const LAS unsigned short*)(scr + (r8 * 8 + j) * 132 + c * 2);
            u32x4 ov; ov.x = e[0] | (e[1] << 16); ov.y = e[2] | (e[3] << 16); ov.z = e[4] | (e[5] << 16); ov.w = e[6] | (e[7] << 16);
            *(u32x4*)(dst + (size_t)c * 128 + r8 * 8) = ov; }
    }
    asm volatile("s_waitcnt lgkmcnt(0)" ::: "memory");
}

__device__ __forceinline__ float dpp_sum8(float v) {
    v += __builtin_bit_cast(float, __builtin_amdgcn_update_dpp(0, __builtin_bit_cast(int, v), 0xB1, 0xF, 0xF, true));
    v += __builtin_bit_cast(float, __builtin_amdgcn_update_dpp(0, __builtin_bit_cast(int, v), 0x4E, 0xF, 0xF, true));
    v += __builtin_bit_cast(float, __builtin_amdgcn_update_dpp(0, __builtin_bit_cast(int, v), 0x141, 0xF, 0xF, true));
    return v;
}
__device__ __forceinline__ void ssd_item(LAS uchar* lds, int b, int h, int dir, const bf16_t* XC, const float* DT, float Aneg, bf16_t* Y) {
    const int tid = opaque_tid(), p = tid >> 3, nq = tid & 7, g = h >> 2;
    LAS float* sB = (LAS float*)lds;
    LAS float* sC = sB + 64 * 128;
    LAS float* sX = sC + 64 * 128;
    LAS float* sY = sX + 64 * 64;
    LAS float* sDt = sY + 64 * 64;
    LAS float* sE = sDt + 64;
    float st[16];
#pragma unroll
    for (int k = 0; k < 16; ++k) st[k] = 0.f;
    u32x4 rb[2], rc[2], rx; float rdt = 0.f;
    const size_t tokb = (size_t)b * SEQ;
#define SSD_LOAD(blk) do { const int t0_ = dir ? (SEQ - 64 - (blk) * 64) : (blk) * 64; \
        _Pragma("unroll") for (int i_ = 0; i_ < 2; ++i_) { const int id_ = tid + 512 * i_, r_ = id_ >> 4, c_ = id_ & 15; const bf16_t* s_ = XC + (tokb + t0_ + r_) * 1024 + 512 + g * 128 + c_ * 8; \
            rb[i_] = *(const u32x4*)s_; rc[i_] = *(const u32x4*)(s_ + 256); } \
        { const int r_ = tid >> 3, c_ = tid & 7; rx = *(const u32x4*)(XC + (tokb + t0_ + r_) * 1024 + h * 64 + c_ * 8); } \
        if (tid < 64) rdt = DT[(tokb + t0_ + tid) * 16 + dir * 8 + h]; } while (0)
#define SSD_ST8(dst, v) do { f32x4 a_, b_; a_[0] = bflo((v).x); a_[1] = bfhi((v).x); a_[2] = bflo((v).y); a_[3] = bfhi((v).y); b_[0] = bflo((v).z); b_[1] = bfhi((v).z); b_[2] = bflo((v).w); b_[3] = bfhi((v).w); \
        *(LAS f32x4*)(dst) = a_; *(LAS f32x4*)((dst) + 4) = b_; } while (0)
#define SSD_STORE() do { \
        _Pragma("unroll") for (int i_ = 0; i_ < 2; ++i_) { const int id_ = tid + 512 * i_, r_ = id_ >> 4, c_ = id_ & 15; SSD_ST8(sB + r_ * 128 + c_ * 8, rb[i_]); SSD_ST8(sC + r_ * 128 + c_ * 8, rc[i_]); } \
        { const int r_ = tid >> 3, c_ = tid & 7; SSD_ST8(sX + r_ * 64 + c_ * 8, rx); } \
        if (tid < 64) { sDt[tid] = rdt; sE[tid] = __expf(rdt * Aneg); } } while (0)
    SSD_LOAD(0); SSD_STORE();
    __syncthreads();
    for (int blk = 0; blk < SEQ / 64; ++blk) {
        if (blk + 1 < SEQ / 64) SSD_LOAD(blk + 1);
        for (int j = 0; j < 64; ++j) {
            const int i = dir ? 63 - j : j;
            const float e = sE[i], xdt = sX[i * 64 + p] * sDt[i];
            const LAS f32x4* bp = (const LAS f32x4*)(sB + i * 128 + nq * 16); const LAS f32x4* cp = (const LAS f32x4*)(sC + i * 128 + nq * 16);
            float acc = 0.f;
#pragma unroll
            for (int q = 0; q < 4; ++q) { const f32x4 bv = bp[q], cv = cp[q];
#pragma unroll
                for (int k = 0; k < 4; ++k) { st[4 * q + k] = st[4 * q + k] * e + xdt * bv[k]; acc += cv[k] * st[4 * q + k]; } }
            acc = dpp_sum8(acc);
            if (nq == 0) sY[i * 64 + p] = acc;
        }
        __syncthreads();
        { const int t0 = dir ? (SEQ - 64 - blk * 64) : blk * 64; const int r = tid >> 3, c = tid & 7; const LAS f32x4* yp = (const LAS f32x4*)(sY + r * 64 + c * 8); const f32x4 a = yp[0], bq = yp[1];
          u32x4 w; w.x = cvtpk(a[0], a[1]); w.y = cvtpk(a[2], a[3]); w.z = cvtpk(bq[0], bq[1]); w.w = cvtpk(bq[2], bq[3]);
          *(u32x4*)(Y + (tokb + t0 + r) * 512 + h * 64 + c * 8) = w; }
        if (blk + 1 < SEQ / 64) SSD_STORE();
        __syncthreads();
    }
#undef SSD_LOAD
#undef SSD_ST8
#undef SSD_STORE
}

__device__ __forceinline__ int crow(int r, int hi) { return (r & 3) + 8 * (r >> 2) + 4 * hi; }
#define MFMA32(a, b, c) __builtin_amdgcn_mfma_f32_32x32x16_bf16((a), (b), (c), 0, 0, 0)
constexpr int SS_ROW = 272, SS_B = 0, SS_BT = 34816, SS_C = 69632, SS_XT = 104448, SS_S = 121856, SS_SC = 139264, SS_SCB = 2064;
static_assert(SS_SC + 2 * SS_SCB <= PTAB_OFF, "SSD LDS map");
__device__ __forceinline__ void ssd_item2(LAS uchar* lds, int b, int h, int dir, const bf16_t* XC, const bf16_t* BT, const bf16_t* XT, const float* DT, float Aneg, bf16_t* Y) {
    const int tid = opaque_tid(), lane = tid & 63, wid = __builtin_amdgcn_readfirstlane(tid >> 6), l31 = lane & 31, hi = lane >> 5, g = h >> 2;
    const int lt = wid < 4 ? wid : 7 - wid, pt = wid >> 2;
    f32x16 S;
#pragma unroll
    for (int r = 0; r < 16; ++r) S[r] = 0.f;
    u32x4 rB[4], rC[4], rT[4], rX[2]; float dt0 = 0.f, dt1 = 0.f;
#define S2_CI(cp) (dir ? 31 - (cp) : (cp))
#define S2_LOAD(cp) do { const int ci_ = S2_CI(cp); const size_t tok0_ = (size_t)b * SEQ + ci_ * 128; \
        _Pragma("unroll") for (int i_ = 0; i_ < 4; ++i_) { const int id_ = tid + 512 * i_, r_ = id_ >> 4, c_ = id_ & 15; const bf16_t* s_ = XC + (tok0_ + r_) * 1024 + 512 + g * 128 + c_ * 8; \
            rB[i_] = *(const u32x4*)s_; rC[i_] = *(const u32x4*)(s_ + 256); \
            rT[i_] = *(const u32x4*)(BT + ((size_t)((b * 32 + ci_) * 2 + g) * 128 + r_) * 128 + c_ * 8); } \
        _Pragma("unroll") for (int i_ = 0; i_ < 2; ++i_) { const int id_ = tid + 512 * i_, r_ = id_ >> 4, c_ = id_ & 15; rX[i_] = *(const u32x4*)(XT + ((size_t)((b * 32 + ci_) * 8 + h) * 64 + r_) * 128 + c_ * 8); } } while (0)
#define S2_STORE() do { \
        _Pragma("unroll") for (int i_ = 0; i_ < 4; ++i_) { const int id_ = tid + 512 * i_, r_ = id_ >> 4, c_ = id_ & 15; \
            *(LAS u32x4*)(lds + SS_B + r_ * SS_ROW + c_ * 16) = rB[i_]; *(LAS u32x4*)(lds + SS_C + r_ * SS_ROW + c_ * 16) = rC[i_]; *(LAS u32x4*)(lds + SS_BT + r_ * SS_ROW + c_ * 16) = rT[i_]; } \
        _Pragma("unroll") for (int i_ = 0; i_ < 2; ++i_) { const int id_ = tid + 512 * i_, r_ = id_ >> 4, c_ = id_ & 15; *(LAS u32x4*)(lds + SS_XT + r_ * SS_ROW + c_ * 16) = rX[i_]; } } while (0)
#define S2_LOADDT(cp) do { const int ci_ = S2_CI(cp); const size_t tok0_ = (size_t)b * SEQ + ci_ * 128; const int la_ = dir ? 127 - 2 * lane : 2 * lane, lb_ = dir ? 126 - 2 * lane : 2 * lane + 1; \
        dt0 = DT[(tok0_ + la_) * 16 + dir * 8 + h]; dt1 = DT[(tok0_ + lb_) * 16 + dir * 8 + h]; } while (0)
#define S2_SCAN(buf) do { LAS float* sc_ = (LAS float*)(lds + SS_SC + (buf) * SS_SCB); const float a0_ = dt0 * Aneg, a1_ = dt1 * Aneg; float s_ = a0_ + a1_; \
        _Pragma("unroll") for (int o_ = 1; o_ < 64; o_ <<= 1) { const float t_ = __shfl_up(s_, o_); if (lane >= o_) s_ += t_; } \
        const float c1_ = s_, c0_ = s_ - a1_, tot_ = __shfl(s_, 63); const int la_ = dir ? 127 - 2 * lane : 2 * lane, lb_ = dir ? 126 - 2 * lane : 2 * lane + 1; \
        sc_[la_] = c0_; sc_[lb_] = c1_; sc_[128 + la_] = dt0; sc_[128 + lb_] = dt1; sc_[256 + la_] = __expf(tot_ - c0_) * dt0; sc_[256 + lb_] = __expf(tot_ - c1_) * dt1; \
        sc_[384 + la_] = __expf(c0_); sc_[384 + lb_] = __expf(c1_); if (lane == 0) sc_[512] = __expf(tot_); } while (0)
    S2_LOAD(0); S2_LOADDT(0);
    if (wid == 0) S2_SCAN(0);
    S2_LOADDT(1);
    S2_STORE();
    for (int i = tid; i < 64 * SS_ROW / 4; i += 512) ((LAS unsigned*)(lds + SS_S))[i] = 0u;
    __syncthreads();
    for (int cp = 0; cp < 32; ++cp) {
        if (cp + 1 < 32) S2_LOAD(cp + 1);
        if (wid == 0 && cp + 1 < 32) S2_SCAN((cp + 1) & 1);
        if (cp + 2 < 32) S2_LOADDT(cp + 2);
        const LAS float* sc = (const LAS float*)(lds + SS_SC + (cp & 1) * SS_SCB);
        const LAS float* sCum = sc; const LAS float* sDt = sc + 128; const LAS float* sW = sc + 256; const LAS float* sEin = sc + 384;
        bf16x8 cf[8];
#pragma unroll
        for (int k = 0; k < 8; ++k) cf[k] = *(const LAS bf16x8*)(lds + SS_C + (32 * lt + l31) * SS_ROW + (16 * k + 8 * hi) * 2);
        f32x16 Yd;
#pragma unroll
        for (int r = 0; r < 16; ++r) Yd[r] = 0.f;
        const float cum_l = sCum[32 * lt + l31];
        const int st_lo = dir ? lt : 0, st_hi = dir ? 3 : lt;
        for (int st = st_lo; st <= st_hi; ++st) {
            f32x16 G;
#pragma unroll
            for (int r = 0; r < 16; ++r) G[r] = 0.f;
#pragma unroll
            for (int k = 0; k < 8; ++k) { const bf16x8 bf = *(const LAS bf16x8*)(lds + SS_B + (32 * st + l31) * SS_ROW + (16 * k + 8 * hi) * 2); G = MFMA32(bf, cf[k], G); }
            const bool diag = (st == lt);
#pragma unroll
            for (int r4 = 0; r4 < 4; ++r4) { const f32x4 cs4 = *(const LAS f32x4*)(sCum + 32 * st + 8 * r4 + 4 * hi), dt4 = *(const LAS f32x4*)(sDt + 32 * st + 8 * r4 + 4 * hi);
#pragma unroll
                for (int e = 0; e < 4; ++e) { const int srel = 8 * r4 + 4 * hi + e; float v = G[4 * r4 + e] * __expf(cum_l - cs4[e]) * dt4[e];
                    if (diag) { const bool ok = dir ? (srel >= l31) : (srel <= l31); v = ok ? v : 0.f; }
                    G[4 * r4 + e] = v; } }
#pragma unroll
            for (int j = 0; j < 2; ++j) { u32x4 pw; pw.x = cvtpk(G[8 * j], G[8 * j + 1]); pw.y = cvtpk(G[8 * j + 2], G[8 * j + 3]); pw.z = cvtpk(G[8 * j + 4], G[8 * j + 5]); pw.w = cvtpk(G[8 * j + 6], G[8 * j + 7]);
                const LAS uchar* xa = lds + SS_XT + (32 * pt + l31) * SS_ROW + (32 * st + 16 * j + 4 * hi) * 2;
                const u32x2 lo = *(const LAS u32x2*)xa, hh = *(const LAS u32x2*)(xa + 16);
                u32x4 xw; xw.x = lo.x; xw.y = lo.y; xw.z = hh.x; xw.w = hh.y;
                Yd = MFMA32(__builtin_bit_cast(bf16x8, pw), __builtin_bit_cast(bf16x8, xw), Yd); }
        }
        f32x16 Yo;
#pragma unroll
        for (int r = 0; r < 16; ++r) Yo[r] = 0.f;
#pragma unroll
        for (int k = 0; k < 8; ++k) { const bf16x8 sf = *(const LAS bf16x8*)(lds + SS_S + (32 * pt + l31) * SS_ROW + (16 * k + 8 * hi) * 2); Yo = MFMA32(cf[k], sf, Yo); }
        { const size_t tok0 = (size_t)b * SEQ + S2_CI(cp) * 128;
#pragma unroll
          for (int r4 = 0; r4 < 4; ++r4) { const f32x4 e4 = *(const LAS f32x4*)(sEin + 32 * lt + 8 * r4 + 4 * hi);
#pragma unroll
              for (int e = 0; e < 4; ++e) { const float yv = Yd[4 * r4 + e] + e4[e] * Yo[4 * r4 + e];
                  Y[(tok0 + 32 * lt + 8 * r4 + 4 * hi + e) * 512 + h * 64 + 32 * pt + l31] = (bf16_t)(cvtpk(yv, 0.f) & 0xffffu); } } }
        { const float etot = sc[512];
#pragma unroll
          for (int r = 0; r < 16; ++r) S[r] *= etot;
#pragma unroll
          for (int k = 0; k < 8; ++k) { const u32x4 xr = *(const LAS u32x4*)(lds + SS_XT + (32 * pt + l31) * SS_ROW + (16 * k + 8 * hi) * 2);
              const f32x4 w0 = *(const LAS f32x4*)(sW + 16 * k + 8 * hi), w1 = *(const LAS f32x4*)(sW + 16 * k + 8 * hi + 4);
              u32x4 xs; xs.x = cvtpk(bflo(xr.x) * w0[0], bfhi(xr.x) * w0[1]); xs.y = cvtpk(bflo(xr.y) * w0[2], bfhi(xr.y) * w0[3]); xs.z = cvtpk(bflo(xr.z) * w1[0], bfhi(xr.z) * w1[1]); xs.w = cvtpk(bflo(xr.w) * w1[2], bfhi(xr.w) * w1[3]);
              const bf16x8 btf = *(const LAS bf16x8*)(lds + SS_BT + (32 * lt + l31) * SS_ROW + (16 * k + 8 * hi) * 2);
              S = MFMA32(__builtin_bit_cast(bf16x8, xs), btf, S); } }
        __syncthreads();
        if (cp + 1 < 32) S2_STORE();
#pragma unroll
        for (int r = 0; r < 16; ++r) *(LAS unsigned short*)(lds + SS_S + (32 * pt + crow(r, hi)) * SS_ROW + (32 * lt + l31) * 2) = (unsigned short)(cvtpk(S[r], 0.f) & 0xffffu);
        __syncthreads();
    }
#undef S2_CI
#undef S2_LOAD
#undef S2_STORE
#undef S2_LOADDT
#undef S2_SCAN
}

template <int DQK, int KW, int DVT, int NT, int MODE, bool PIPE>
__device__ __forceinline__ void attn_item(LAS uchar* lds, const bf16_t* qptr, int qpitch, const bf16_t* kptr, int kpitch, int kwcol, const bf16_t* vtptr, int vtpitch, int vrow,
                                          bf16_t* outp, int opitch, float lam, const float* subg) {
    constexpr int KROW = KW * 2 + 16, KBUF = 64 * KROW, VROW = 136, VBUF = DVT * VROW, NKP = 64 * (KW / 8) / 512, NVP = DVT * 8 / 512, NS = DQK / 16;
    static_assert(2 * KBUF + 2 * VBUF <= PTAB_OFF && 128 * 256 * 4 + 1024 <= PTAB_OFF, "attention LDS");
    const int tid = opaque_tid(), lane = tid & 63, wid = __builtin_amdgcn_readfirstlane(tid >> 6), qg = wid >> 1, t = wid & 1, l31 = lane & 31, hi = lane >> 5;
    bf16x8 qf[NS];
    { const bf16_t* qr = qptr + (size_t)(qg * 32 + l31) * qpitch + 8 * hi;
#pragma unroll
      for (int s = 0; s < NS; ++s) qf[s] = *(const bf16x8*)(qr + 16 * s); }
    f32x16 o[4];
#pragma unroll
    for (int d = 0; d < 4; ++d)
#pragma unroll
        for (int r = 0; r < 16; ++r) o[d][r] = 0.f;
    float m = -1e30f, l = 0.f;
    u32x4 kst[NKP], vst[NVP];
#define AT_LOAD(tile) do { \
        _Pragma("unroll") for (int i_ = 0; i_ < NKP; ++i_) { const int id_ = tid + 512 * i_, r_ = id_ / (KW / 8), c_ = id_ % (KW / 8); kst[i_] = *(const u32x4*)(kptr + (size_t)((tile) * 64 + r_) * kpitch + c_ * 8); } \
        _Pragma("unroll") for (int i_ = 0; i_ < NVP; ++i_) { const int id_ = tid + 512 * i_, r_ = id_ >> 3, c_ = id_ & 7; vst[i_] = *(const u32x4*)(vtptr + (size_t)r_ * vtpitch + (tile) * 64 + c_ * 8); } } while (0)
#define AT_STORE(buf) do { \
        _Pragma("unroll") for (int i_ = 0; i_ < NKP; ++i_) { const int id_ = tid + 512 * i_, r_ = id_ / (KW / 8), c_ = id_ % (KW / 8); *(LAS u32x4*)(lds + (buf) * KBUF + r_ * KROW + c_ * 16) = kst[i_]; } \
        _Pragma("unroll") for (int i_ = 0; i_ < NVP; ++i_) { const int id_ = tid + 512 * i_, r_ = id_ >> 3, c_ = id_ & 7; LAS u32x2* d_ = (LAS u32x2*)(lds + 2 * KBUF + (buf) * VBUF + r_ * VROW + c_ * 16); \
            d_[0] = (u32x2){vst[i_].x, vst[i_].y}; d_[1] = (u32x2){vst[i_].z, vst[i_].w}; } } while (0)
    if (PIPE) { AT_LOAD(0); AT_STORE(0); __syncthreads(); }
    for (int tile = 0; tile < NT; ++tile) {
        if (PIPE) { if (tile + 1 < NT) AT_LOAD(tile + 1); }
        else { AT_LOAD(tile); AT_STORE(tile & 1); __syncthreads(); }
        const LAS uchar* kb = lds + (tile & 1) * KBUF; const LAS uchar* vb = lds + 2 * KBUF + (tile & 1) * VBUF;
        f32x16 s0, s1;
#pragma unroll
        for (int r = 0; r < 16; ++r) { s0[r] = 0.f; s1[r] = 0.f; }
        { const LAS uchar* ka = kb + l31 * KROW + (kwcol + 8 * hi) * 2;
#pragma unroll
          for (int s = 0; s < NS; ++s) { const bf16x8 a0 = *(const LAS bf16x8*)(ka + 32 * s), a1 = *(const LAS bf16x8*)(ka + 32 * KROW + 32 * s);
              s0 = MFMA32(a0, qf[s], s0); s1 = MFMA32(a1, qf[s], s1); } }
        float mx = fmaxf(s0[0], s1[0]);
#pragma unroll
        for (int r = 1; r < 16; ++r) mx = fmaxf(mx, fmaxf(s0[r], s1[r]));
        mx = fmaxf(mx, __shfl_xor(mx, 32));
        const float mnew = fmaxf(m, mx); const float alpha = fast_exp2(m - mnew);
        if (__any(mnew > m)) {
#pragma unroll
            for (int r = 0; r < 16; ++r) { const float ar = __shfl(alpha, crow(r, hi));
#pragma unroll
                for (int d = 0; d < 4; ++d) o[d][r] *= ar; }
        }
        m = mnew; float ps = 0.f;
#pragma unroll
        for (int r = 0; r < 16; ++r) { s0[r] = fast_exp2(s0[r] - m); s1[r] = fast_exp2(s1[r] - m); ps += s0[r] + s1[r]; }
        l = l * alpha + ps;
#pragma unroll
        for (int kt = 0; kt < 2; ++kt)
#pragma unroll
            for (int j = 0; j < 2; ++j) {
                u32x4 pw;
                if (kt == 0) { pw.x = cvtpk(s0[8 * j], s0[8 * j + 1]); pw.y = cvtpk(s0[8 * j + 2], s0[8 * j + 3]); pw.z = cvtpk(s0[8 * j + 4], s0[8 * j + 5]); pw.w = cvtpk(s0[8 * j + 6], s0[8 * j + 7]); }
                else         { pw.x = cvtpk(s1[8 * j], s1[8 * j + 1]); pw.y = cvtpk(s1[8 * j + 2], s1[8 * j + 3]); pw.z = cvtpk(s1[8 * j + 4], s1[8 * j + 5]); pw.w = cvtpk(s1[8 * j + 6], s1[8 * j + 7]); }
                const bf16x8 pa = __builtin_bit_cast(bf16x8, pw);
#pragma unroll
                for (int d = 0; d < 4; ++d) { const LAS uchar* va = vb + (vrow + 32 * d + l31) * VROW + (32 * kt + 16 * j + 4 * hi) * 2;
                    const u32x2 lo = *(const LAS u32x2*)va, hh = *(const LAS u32x2*)(va + 16);
                    u32x4 vw; vw.x = lo.x; vw.y = lo.y; vw.z = hh.x; vw.w = hh.y;
                    o[d] = MFMA32(pa, __builtin_bit_cast(bf16x8, vw), o[d]); }
            }
        if (PIPE) { if (tile + 1 < NT) AT_STORE((tile + 1) & 1); __syncthreads(); }
    }
    if (!PIPE) __syncthreads();
#undef AT_LOAD
#undef AT_STORE
    l += __shfl_xor(l, 32);
    LAS float* ex = (LAS float*)lds; LAS float* lsum = (LAS float*)(lds + 128 * 256 * 4);
#pragma unroll
    for (int d = 0; d < 4; ++d)
#pragma unroll
        for (int r = 0; r < 16; ++r) ex[(qg * 32 + crow(r, hi)) * 256 + t * 128 + 32 * d + l31] = o[d][r];
    if (hi == 0) lsum[t * 128 + qg * 32 + l31] = l;
    __syncthreads();
    for (int rr = 0; rr < 16; ++rr) {
        const int q = wid * 16 + rr;
        if (MODE == 0) {
            const float i1 = 1.0f / lsum[q], i2 = lam / lsum[128 + q];
            const f32x2 o1 = ((const LAS f32x2*)(ex + q * 256))[lane], o2 = ((const LAS f32x2*)(ex + q * 256 + 128))[lane];
            const float a = o1.x * i1 - o2.x * i2, bq = o1.y * i1 - o2.y * i2;
            const float ss = wave_sum(a * a + bq * bq); const float rn = (1.0f - LAMBDA_INIT) / sqrtf(ss * (1.0f / 128.0f) + EPS);
            *(unsigned*)(outp + (size_t)q * opitch + 2 * lane) = cvtpk(a * rn * subg[2 * lane], bq * rn * subg[2 * lane + 1]);
        } else {
            const float inv = 1.0f / lsum[q]; const f32x4 v = ((const LAS f32x4*)(ex + q * 256))[lane];
            u32x2 w; w.x = cvtpk(v[0] * inv, v[1] * inv); w.y = cvtpk(v[2] * inv, v[3] * inv);
            *(u32x2*)(outp + (size_t)q * opitch + 4 * lane) = w;
        }
    }
    __syncthreads();
}

#ifndef PHASE_MASK
#define PHASE_MASK 0xFFFF
#endif
#define PH_ON(k) ((PHASE_MASK >> (k)) & 1)
#define PH_IDS const int tid = opaque_tid(), lane = tid & 63, wave = __builtin_amdgcn_readfirstlane(tid >> 6), gw = bx * 8 + wave, gtid = bx * 512 + tid; (void)lane; (void)gw; (void)gtid; (void)wave
struct Args { const float* in[32]; float* out; unsigned char* ws; int ph_lo, ph_hi; };
constexpr int N_PHASES = 14;

__global__ void __launch_bounds__(512, 2) mega_fwd(Args a) {
    extern __shared__ __attribute__((aligned(16))) unsigned char lds_raw[];
    LAS uchar* lds = (LAS uchar*)lds_raw;
    const int G = (int)gridDim.x, bx = (int)blockIdx.x, NGW = G * 8, NTHR = G * 512;
    LAS unsigned long long* ptab = (LAS unsigned long long*)(lds + PTAB_OFF);
    if (threadIdx.x < 32) ptab[threadIdx.x] = (unsigned long long)a.in[threadIdx.x];
    __syncthreads();
#define INP(k) ((const float*)(((unsigned long long)(unsigned)__builtin_amdgcn_readfirstlane((int)(ptab[k] >> 32)) << 32) | (unsigned long long)(unsigned)__builtin_amdgcn_readfirstlane((int)(ptab[k] & 0xffffffffull))))
    if (a.ph_lo == 0 && PH_ON(0)) {
        float* rope_cs = (float*)(a.ws + WS_ROPE);
        for (int i = bx * 512 + (int)threadIdx.x; i < SEQ * 8; i += NTHR) rope_entry(i, rope_cs, rope_cs + SEQ * 8);
    }
    for (int ph = a.ph_lo; ph < a.ph_hi; ++ph) {
        unsigned char* ws = a.ws; asm volatile("" : "+s"(ws));
        float* lamp = (float*)(ws + WS_CTL);
        float* rope_cs = (float*)(ws + WS_ROPE); float* rope_sn = rope_cs + SEQ * 8;
        float* SS0 = (float*)(ws + WS_SS0); float* SS1 = (float*)(ws + WS_SS1); float* SS2 = (float*)(ws + WS_SS2); float* SS3 = (float*)(ws + WS_SS3); float* SS4 = (float*)(ws + WS_SS4); float* SSM = (float*)(ws + WS_SSM);
        float* DTB = (float*)(ws + WS_DT);
        bf16_t* WGU1 = (bf16_t*)(ws + WS_WGU1); bf16_t* WD1 = (bf16_t*)(ws + WS_WD1); bf16_t* WIN = (bf16_t*)(ws + WS_WIN); bf16_t* WOUT = (bf16_t*)(ws + WS_WOUT);
        bf16_t* WQ = (bf16_t*)(ws + WS_WQ); bf16_t* WKV = (bf16_t*)(ws + WS_WKV); bf16_t* WO = (bf16_t*)(ws + WS_WO); bf16_t* WGU2 = (bf16_t*)(ws + WS_WGU2); bf16_t* WD2 = (bf16_t*)(ws + WS_WD2);
        bf16_t* MEMB = (bf16_t*)(ws + WS_MEMB); bf16_t* KVX = (bf16_t*)(ws + WS_KVX); bf16_t* VTX = (bf16_t*)(ws + WS_VTX); bf16_t* VT = (bf16_t*)(ws + WS_VT);
        float* out = a.out;
        bf16_t* XB = (bf16_t*)(ws + WS_XB);
        bf16_t* XC = (bf16_t*)out; bf16_t* XT = XC + (size_t)T * 1024; bf16_t* BTR = XT + (size_t)T * 512;
        bf16_t* YMIX = (bf16_t*)(ws + WS_YMIX); bf16_t* OX = YMIX;
        bf16_t* YF = (bf16_t*)(ws + WS_YFB); bf16_t* YB = YF + (size_t)T * 512; bf16_t* QX = YF;
        bf16_t* BIG = (bf16_t*)(ws + WS_BIG); bf16_t* U = BIG; bf16_t* PROJ = BIG;

        if (ph == 0 && PH_ON(0)) {
            PH_IDS;
            LAS float* scr = (LAS float*)(lds + wave * 16384);
            constexpr int I_G = 16 * 88, I_D = 44 * 32, I_IN = 16 * 97, I_SQ = 16 * 32, I_KV = 16 * 64;
            constexpr int NITEMS = 6 * I_G + I_IN + 3 * I_SQ + I_KV;
            static_assert(I_G == I_D, "item counts");
            for (int it = gw; it < NITEMS; it += NGW) {
                int r = it; const float* W; const float* gq = nullptr; bf16_t* WT; int K = DM, N = DM, kind = 0;
                if (r < 3 * I_G) { const int w = r / I_G; r -= w * I_G; if (w == 2) { W = INP(5); K = FF; WT = WD1; } else { W = INP(3 + w); N = FF; WT = WGU1; kind = 1 + w; gq = INP(2); } }
                else if (r < 6 * I_G) { r -= 3 * I_G; const int w = r / I_G; r -= w * I_G; if (w == 2) { W = INP(30); K = FF; WT = WD2; } else { W = INP(28 + w); N = FF; WT = WGU2; kind = 1 + w; gq = INP(27); } }
                else if (r < 6 * I_G + I_IN) { r -= 6 * I_G; W = INP(7); N = 3088; WT = WIN; kind = 3; gq = INP(6); }
                else { r -= 6 * I_G + I_IN;
                    if (r < I_SQ) { W = INP(21); WT = WOUT; }
                    else if (r < 2 * I_SQ) { r -= I_SQ; W = INP(24); WT = WQ; gq = INP(22); }
                    else if (r < 3 * I_SQ) { r -= 2 * I_SQ; W = INP(26); WT = WO; }
                    else { r -= 3 * I_SQ; W = INP(25); N = 2 * DM; WT = WKV; gq = INP(23); } }
                p0_transpose_item(W, K, N, WT, kind, gq, scr, r, lane);
            }
            for (int mrow = gw; mrow < T; mrow += NGW) row_to_bf16_ss(INP(0) + (size_t)mrow * DM, XB + (size_t)mrow * DM, SS0 + (size_t)mrow * 16, lane);
            for (int mrow = gw; mrow < TM; mrow += NGW) row_to_bf16_ss(INP(1) + (size_t)mrow * DM, MEMB + (size_t)mrow * DM, SSM + (size_t)mrow * 16, lane);
            for (int i = gtid; i < (NPROJ - 3088) * DM / 8; i += NTHR) ((u32x4*)(WIN + (size_t)3088 * DM))[i] = (u32x4){0u, 0u, 0u, 0u};
            if (bx == 0 && wave == 0) {
                const float s1 = wave_sum(INP(16)[lane] * INP(17)[lane]), s2 = wave_sum(INP(18)[lane] * INP(19)[lane]);
                if (lane == 0) lamp[0] = __expf(s1) - __expf(s2) + LAMBDA_INIT;
            }
        } else if (PH_ON(1) && (ph == 1 || ph == 2 || ph == 3 || ph == 7 || ph == 8 || ph == 10 || ph == 11 || ph == 12)) {
            for (int sub = 0; sub < 2; ++sub) {
                if (sub == 1 && ph != 1) break;
                GJob j; j.E = EpiAny{0, ws, 1.0f, 0u, 0u, 0u, 0};
                if (ph == 1 && sub == 0) { j.A = XB; j.Bt = WGU1; j.M = T; j.N = 2 * FF; j.K = DM; j.E.kind = 1; j.E.part_off = (unsigned)WS_SS0; j.E.o_off = (unsigned)WS_BIG; }
                else if (ph == 1)        { j.A = MEMB; j.Bt = WKV; j.M = TM; j.N = 2 * DM; j.K = DM; j.E.kind = 0; j.E.part_off = (unsigned)WS_SSM; j.E.o_off = (unsigned)WS_KVX; j.E.ldc = 2 * DM; }
                else if (ph == 2)        { j.A = U; j.Bt = WD1; j.M = T; j.N = DM; j.K = FF; j.E.kind = 2; j.E.scale = 0.5f; j.E.opart_off = (unsigned)WS_SS1; }
                else if (ph == 3)        { j.A = XB; j.Bt = WIN; j.M = T; j.N = NPROJ; j.K = DM; j.E.kind = 3; j.E.part_off = (unsigned)WS_SS1; j.E.o_off = (unsigned)WS_BIG; }
                else if (ph == 7)        { j.A = YMIX; j.Bt = WOUT; j.M = T; j.N = DM; j.K = DM; j.E.kind = 2; j.E.opart_off = (unsigned)WS_SS2; }
                else if (ph == 8)        { j.A = XB; j.Bt = WQ; j.M = T; j.N = DM; j.K = DM; j.E.kind = 0; j.E.part_off = (unsigned)WS_SS2; j.E.scale = 0.0625f * LOG2E; j.E.o_off = (unsigned)WS_YFB; j.E.ldc = DM; }
                else if (ph == 10)       { j.A = OX; j.Bt = WO; j.M = T; j.N = DM; j.K = DM; j.E.kind = 2; j.E.opart_off = (unsigned)WS_SS3; }
                else if (ph == 11)       { j.A = XB; j.Bt = WGU2; j.M = T; j.N = 2 * FF; j.K = DM; j.E.kind = 1; j.E.part_off = (unsigned)WS_SS3; j.E.o_off = (unsigned)WS_BIG; }
                else                     { j.A = U; j.Bt = WD2; j.M = T; j.N = DM; j.K = FF; j.E.kind = 2; j.E.scale = 0.5f; j.E.opart_off = (unsigned)WS_SS4; }
                run_gemm(lds, j.A, j.Bt, j.M, j.N, j.K, j.E);
            }
        } else if (ph == 4 && PH_ON(4)) {
            PH_IDS;
            LAS uchar* scr = lds + wave * 8448;
            { const float* cwp = INP(8); const float* cbp = INP(9); for (int it = gw; it < (T / 64) * 16; it += NGW) conv_item(PROJ, cwp, cbp, XC, XT, BTR, scr, it, lane); }
            for (int it = gw; it < NB * 4 * 2 * 64; it += NGW) { const int st = it & 63, dt = (it >> 6) & 1, bh = it >> 7, b = bh >> 2, h = bh & 3;
                transpose64(PROJ + (size_t)(b * SEQ + st * 64) * PLD + PC_V + h * 128 + dt * 64, PLD, VT + (size_t)(bh * 128 + dt * 64) * SEQ + st * 64, SEQ, scr, lane); }
            for (int it = gw; it < NB * 4 * 4 * 4; it += NGW) { const int mt = it & 3, dt = (it >> 2) & 3, bh = it >> 4, b = bh >> 2, h = bh & 3;
                transpose64(KVX + (size_t)(b * MEML + mt * 64) * (2 * DM) + DM + h * 256 + dt * 64, 2 * DM, VTX + (size_t)(bh * 256 + dt * 64) * MEML + mt * 64, MEML, scr, lane); }
        } else if (ph == 5 && PH_ON(5)) {
            PH_IDS;
#ifndef REP_SSD
#define REP_SSD 1
#endif
#ifndef REP_ATT
#define REP_ATT 1
#endif
            for (int rep = 0; rep < REP_SSD; ++rep)
            for (int it = bx; it < NB * 8 * 2; it += G) { const int dir = it & 1, h = (it >> 1) & 7, b = it >> 4;
                const float Aneg = -__expf(dir ? INP(13)[h] : INP(12)[h]);
#ifdef SSD_VALU
                ssd_item(lds, b, h, dir, XC, DTB, Aneg, dir ? YB : YF); }
#else
                ssd_item2(lds, b, h, dir, XC, BTR, XT, DTB, Aneg, dir ? YB : YF); }
#endif
            for (int rep = 0; rep < REP_ATT; ++rep)
            for (int i = 0;; ++i) {
                int bh, qb;
                if (G == 256) { if (i >= 8) break; bh = i * 8 + (bx & 7); qb = bx >> 3; }
                else { const int L = i * G + bx; if (L >= 2048) break; bh = L >> 5; qb = L & 31; }
                const int b = bh >> 2, h = bh & 3; const size_t row0 = (size_t)b * SEQ + qb * 128;
                const int t = wave & 1;
                attn_item<64, 128, 128, 64, 0, true>(lds, PROJ + row0 * PLD + PC_Q + h * 128 + t * 64, PLD, PROJ + (size_t)b * SEQ * PLD + PC_K + h * 128, PLD, t * 64,
                                               VT + (size_t)bh * 128 * SEQ, SEQ, 0, YMIX + row0 * DM + 512 + h * 128, DM, lamp[0], INP(20));
            }
        } else if (ph == 6 && PH_ON(6)) {
            PH_IDS;
            for (int it = gw; it < T * 2; it += NGW) { const int tok = it >> 1, g = it & 1, c = g * 256 + 4 * lane, h = c >> 6;
                const u32x2 yf = *(const u32x2*)(YF + (size_t)tok * 512 + c), yb = *(const u32x2*)(YB + (size_t)tok * 512 + c), xv = *(const u32x2*)(XC + (size_t)tok * 1024 + c), zv = *(const u32x2*)(PROJ + (size_t)tok * PLD + PC_Z + c);
                const float D = INP(14)[h];
                float y[4];
                y[0] = (bflo(yf.x) + bflo(yb.x) + D * bflo(xv.x)) * silu_f(bflo(zv.x)); y[1] = (bfhi(yf.x) + bfhi(yb.x) + D * bfhi(xv.x)) * silu_f(bfhi(zv.x));
                y[2] = (bflo(yf.y) + bflo(yb.y) + D * bflo(xv.y)) * silu_f(bflo(zv.y)); y[3] = (bfhi(yf.y) + bfhi(yb.y) + D * bfhi(xv.y)) * silu_f(bfhi(zv.y));
                const float ss = wave_sum((y[0] * y[0] + y[1] * y[1]) + (y[2] * y[2] + y[3] * y[3])); const float rn = 1.0f / sqrtf(ss * (1.0f / 256.0f) + EPS);
                const f32x4 gv = *(const f32x4*)(INP(15) + c);
                u32x2 w; w.x = cvtpk(y[0] * rn * gv[0], y[1] * rn * gv[1]); w.y = cvtpk(y[2] * rn * gv[2], y[3] * rn * gv[3]);
                *(u32x2*)(YMIX + (size_t)tok * DM + c) = w; }
        } else if (ph == 9 && PH_ON(9)) {
            PH_IDS;
            for (int i = 0;; ++i) {
                int bh, qb;
                if (G == 256) { if (i >= 8) break; bh = i * 8 + (bx & 7); qb = bx >> 3; }
                else { const int L = i * G + bx; if (L >= 2048) break; bh = L >> 5; qb = L & 31; }
                const int b = bh >> 2, h = bh & 3; const size_t row0 = (size_t)b * SEQ + qb * 128;
                const int t = wave & 1;
                attn_item<256, 256, 256, 4, 1, false>(lds, QX + row0 * DM + h * 256, DM, KVX + (size_t)b * MEML * (2 * DM) + h * 256, 2 * DM, 0,
                                               VTX + (size_t)bh * 256 * MEML, MEML, t * 128, OX + row0 * DM + h * 256, DM, 0.f, nullptr);
            }
        } else if (ph == 13 && PH_ON(13)) {
            PH_IDS;
            for (int row = gw; row < T; row += NGW) { const float rs = row_rs(SS4, row); f32x4* xr = (f32x4*)(out + (size_t)row * DM); const u32x2* xs = (const u32x2*)(XB + (size_t)row * DM);
#pragma unroll
                for (int j = 0; j < 4; ++j) { const f32x4 gv = ((const f32x4*)INP(31))[lane + 64 * j]; const u32x2 xv = xs[lane + 64 * j]; f32x4 v; v[0] = bflo(xv.x); v[1] = bfhi(xv.x); v[2] = bflo(xv.y); v[3] = bfhi(xv.y);
                    xr[lane + 64 * j] = v * rs * gv; } }
        }
        if (ph + 1 < a.ph_hi) cg::this_grid().sync();
    }
}

extern "C" void kernel_launch(void* const* d_in, const int* in_sizes, int n_in, void* d_out, int out_size, void* d_ws, size_t ws_size, hipStream_t stream) {
    static int grid = 0;
    if (grid == 0) {
        if (n_in != 32 || in_sizes[0] != T * DM || out_size != T * DM || ws_size < WS_END) {
            fprintf(stderr, "kernel_launch: unexpected shapes (n_in %d, in0 %d, out %d, ws %zu < %zu); nothing launched\n", n_in, n_in > 0 ? in_sizes[0] : -1, out_size, ws_size, (size_t)WS_END); grid = -1; return; }
        int dev = 0, cus = 0, per_cu = 0;
        hipGetDevice(&dev); hipDeviceGetAttribute(&cus, hipDeviceAttributeMultiprocessorCount, dev);
        if (hipFuncSetAttribute((const void*)mega_fwd, hipFuncAttributeMaxDynamicSharedMemorySize, LDS_BYTES) != hipSuccess) { fprintf(stderr, "kernel_launch: hipFuncSetAttribute failed\n"); grid = -1; return; }
        if (hipOccupancyMaxActiveBlocksPerMultiprocessor(&per_cu, (const void*)mega_fwd, 512, LDS_BYTES) != hipSuccess || per_cu < 1) { fprintf(stderr, "kernel_launch: occupancy query says %d\n", per_cu); per_cu = 1; }
        (void)hipGetLastError();
        grid = cus * per_cu;
        if (grid <= 0) grid = 256;
    }
    if (grid < 0) return;
    Args a{};
    for (int i = 0; i < 32; ++i) a.in[i] = (const float*)d_in[i];
    a.out = (float*)d_out; a.ws = (unsigned char*)d_ws;
#if MK_COOP
    a.ph_lo = 0; a.ph_hi = N_PHASES;
    void* kargs[] = {&a};
    hipError_t e = hipLaunchCooperativeKernel((const void*)mega_fwd, dim3(grid), dim3(512), kargs, LDS_BYTES, stream);
    if (e != hipSuccess) fprintf(stderr, "kernel_launch: cooperative launch failed: %s (grid %d)\n", hipGetErrorString(e), grid);
#else
    for (int ph = 0; ph < N_PHASES; ++ph) { a.ph_lo = ph; a.ph_hi = ph + 1; hipLaunchKernelGGL(mega_fwd, dim3(grid), dim3(512), LDS_BYTES, stream, a); }
#endif
}
```

```cpp
#include <hip/hip_runtime.h>
#include <hip/hip_cooperative_groups.h>
#include <cstdio>
#include <cstdint>
namespace cg = cooperative_groups;
#ifndef MK_COOP
#define MK_COOP 1
#endif
namespace pg8 {
#define PG8_LAS __attribute__((address_space(3)))
typedef unsigned short bf16_t;
typedef short bf16x8 __attribute__((ext_vector_type(8)));
typedef float f32x4 __attribute__((ext_vector_type(4)));
typedef unsigned u32x4 __attribute__((ext_vector_type(4)));
constexpr int BM = 256, BK = 64, HALF = 128, HTB = HALF * BK * 2  , STAGE_BYTES = 8 * HTB, NXCD = 8, WGM = 8;

__host__ __device__ __forceinline__ int lds_byte(int r, int c) { const int st = (r >> 4) * 2 + (c >> 5), rr = r & 15, cc = c & 31, ob = rr * 64 + cc * 2; return st * 1024 + (ob ^ (((ob >> 9) & 1) << 5)); }
__host__ __device__ __forceinline__ void stage_rc(int b, int& R, int& C) { const int st = b / 1024, sb = b % 1024, swz = sb ^ (((sb >> 9) & 1) << 5); R = (st >> 1) * 16 + swz / 64; C = (st & 1) * 32 + (swz % 64) / 2; }
__host__ __device__ __forceinline__ int perm32(int rho) { const int n = rho >> 4, i = rho & 15; return 8 * (i >> 2) + 4 * n + (i & 3); }

struct Unit { int pm, pn; };
struct Gemm { const bf16_t* A; const bf16_t* Bt; int M, N, K; };

struct StaticOrder {
    int nM, nN, nwg, G, c;
    __host__ __device__ void init(int M, int N, int G_, int c_) { nM = M / BM; nN = N / BM; nwg = nM * nN; G = G_; c = c_; }
    __host__ __device__ bool next(int i, Unit& u) const {
        const long L = (long)i * G + c; if (L >= nwg) return false;
        int wgid = (int)L; { const int q = nwg / NXCD, r = nwg % NXCD, xcd = wgid % NXCD, off = wgid / NXCD; wgid = (xcd < r ? xcd * (q + 1) : r * (q + 1) + (xcd - r) * q) + off; }
        const int nig = WGM * nN, gid = wgid / nig, fm = gid * WGM, gsz = (nM - fm) < WGM ? (nM - fm) : WGM;
        u.pm = fm + ((wgid % nig) % gsz); u.pn = (wgid % nig) / gsz; return true;
    }
    __device__ __forceinline__ void a_ready(const Unit&) const {}
    __device__ __forceinline__ void done(const Unit&) const {}
};
__device__ __forceinline__ unsigned cvt_pk_bf16(float lo, float hi) { unsigned r; asm volatile("v_cvt_pk_bf16_f32 %0, %1, %2" : "=v"(r) : "v"(lo), "v"(hi)); return r; }
template <class Epi, class Sched, bool ALIGN_EPI = false, bool SP2 = false>
__device__ __forceinline__ void gemm_phase(PG8_LAS unsigned char* lds, const Gemm g, const Sched& S, const Epi& E) {
    int tid = threadIdx.x; asm volatile("" : "+v"(tid)); const int wid = __builtin_amdgcn_readfirstlane(tid >> 6), lane = tid & 63, wr = wid >> 2, wc = wid & 3, fr = lane & 15, fq = lane >> 4;
    const int K = g.K, nt = K / BK;
    unsigned voffA[2], voffB[2];
#pragma unroll
    for (int i = 0; i < 2; ++i) { int R, C; stage_rc(tid * 16 + i * 8192, R, C); const int Rb = Epi::PERM ? ((R & ~31) + perm32(R & 31)) : R;
        voffA[i] = (unsigned)(R * K + C) * 2u; voffB[i] = (unsigned)(Rb * K + C) * 2u; }
    const size_t kstep = (size_t)(BK * 2);
    const size_t hstep = (size_t)HALF * K * 2;
    const size_t tstep = 2 * hstep;
    const unsigned ldsw = (unsigned)wid * 1024u;
    const int aoff = lds_byte(wr * 64 + fr, fq * 8), boff = lds_byte(wc * 32 + fr, fq * 8);
#define PG8_SA(b, h) (((b) * 2 + (h)) * HTB)
#define PG8_SB(b, h) ((4 + (b) * 2 + (h)) * HTB)
#define PG8_STAGE(bufoff, gbase, voff) do { _Pragma("unroll") for (int _i = 0; _i < 2; ++_i) \
        __builtin_amdgcn_global_load_lds((const unsigned*)((const char*)(gbase) + (voff)[_i]), (PG8_LAS unsigned*)(lds + (bufoff) + ldsw + _i * 8192), 16, 0, 0); } while (0)
#define PG8_LDA(dst, b, h) do { _Pragma("unroll") for (int m = 0; m < 4; ++m) _Pragma("unroll") for (int k = 0; k < 2; ++k) dst[m][k] = *(const PG8_LAS bf16x8*)(lds + PG8_SA(b, h) + aoff + m * 2048 + k * 1024); } while (0)
#define PG8_LDB(dst, b, h) do { _Pragma("unroll") for (int n = 0; n < 2; ++n) _Pragma("unroll") for (int k = 0; k < 2; ++k) dst[n][k] = *(const PG8_LAS bf16x8*)(lds + PG8_SB(b, h) + boff + n * 2048 + k * 1024); } while (0)
#define PG8_MMA(ai, bj, At, Bt) do { __builtin_amdgcn_s_setprio(1); _Pragma("unroll") for (int m = 0; m < 4; ++m) _Pragma("unroll") for (int n = 0; n < 2; ++n) _Pragma("unroll") for (int k = 0; k < 2; ++k) \
        acc[ai][bj][m][n] = __builtin_amdgcn_mfma_f32_16x16x32_bf16(Bt[n][k], At[m][k], acc[ai][bj][m][n], 0, 0, 0); __builtin_amdgcn_s_setprio(0); } while (0)
#define PG8_WAIT_V(n) asm volatile("s_waitcnt vmcnt(" #n ")" ::: "memory")
#define PG8_WAIT_L(n) asm volatile("s_waitcnt lgkmcnt(" #n ")" ::: "memory")
#define PG8_BAR __builtin_amdgcn_s_barrier()
#define PG8_SCHED __builtin_amdgcn_sched_barrier(0)
    Unit cur, nxt; int ui = 0;
    if (!S.next(0, cur)) return;
    f32x4 acc[2][2][4][2];
#pragma unroll
    for (int a = 0; a < 2; ++a)
#pragma unroll
        for (int b = 0; b < 2; ++b)
#pragma unroll
            for (int m = 0; m < 4; ++m)
#pragma unroll
                for (int n = 0; n < 2; ++n) acc[a][b][m][n] = (f32x4){0.f, 0.f, 0.f, 0.f};
    bf16x8 At[4][2], B0[2][2], B1[2][2];
    const char* cA = (const char*)g.A + (size_t)cur.pm * tstep; const char* cB = (const char*)g.Bt + (size_t)cur.pn * tstep;
    S.a_ready(cur);
    if constexpr (SP2) {
        PG8_STAGE(PG8_SB(0, 0), cB, voffB); PG8_STAGE(PG8_SB(0, 1), cB + hstep, voffB); PG8_STAGE(PG8_SA(0, 0), cA, voffA); PG8_STAGE(PG8_SA(0, 1), cA + hstep, voffA);
        if (wr == 1) PG8_BAR;
        PG8_WAIT_V(2); PG8_BAR;
        PG8_STAGE(PG8_SB(1, 0), cB + kstep, voffB); PG8_STAGE(PG8_SA(1, 0), cA + kstep, voffA); PG8_STAGE(PG8_SB(1, 1), cB + hstep + kstep, voffB);
        PG8_WAIT_V(6); PG8_BAR;
    } else {
        PG8_STAGE(PG8_SB(0, 0), cB, voffB); PG8_STAGE(PG8_SA(0, 0), cA, voffA); PG8_STAGE(PG8_SB(0, 1), cB + hstep, voffB); PG8_STAGE(PG8_SA(0, 1), cA + hstep, voffA);
        if (wr == 1) PG8_BAR;
        PG8_WAIT_V(4); PG8_BAR;
        PG8_STAGE(PG8_SB(1, 0), cB + kstep, voffB); PG8_STAGE(PG8_SA(1, 0), cA + kstep, voffA); PG8_STAGE(PG8_SB(1, 1), cB + hstep + kstep, voffB);
        PG8_WAIT_V(6); PG8_BAR;
    }
    for (;;) {
        const bool has_next = S.next(ui + 1, nxt);
        const char* nA = has_next ? (const char*)g.A + (size_t)nxt.pm * tstep : cA; const char* nB = has_next ? (const char*)g.Bt + (size_t)nxt.pn * tstep : cB;
        for (int t = 0; t < nt; t += 2) {
            const bool last = (t == nt - 2);
            const char* a1 = cA + (size_t)(t + 1) * kstep;
            const char* a2 = last ? nA : cA + (size_t)(t + 2) * kstep; const char* b2 = last ? nB : cB + (size_t)(t + 2) * kstep;
            const char* a3 = a2 + kstep; const char* b3 = b2 + kstep;
            if (last && has_next) S.a_ready(nxt);
            if constexpr (SP2) {
            PG8_LDB(B0, 0, 0); PG8_LDB(B1, 0, 1); PG8_SCHED; PG8_LDA(At, 0, 0); PG8_STAGE(PG8_SA(1, 1), a1 + hstep, voffA);
            PG8_WAIT_V(8); PG8_WAIT_L(0); PG8_BAR; PG8_MMA(0, 0, At, B0); PG8_MMA(0, 1, At, B1); PG8_BAR; PG8_SCHED;
            PG8_LDA(At, 0, 1); PG8_STAGE(PG8_SB(0, 0), b2, voffB); PG8_STAGE(PG8_SB(0, 1), b2 + hstep, voffB); PG8_STAGE(PG8_SA(0, 0), a2, voffA);
            PG8_WAIT_V(8); PG8_WAIT_L(0); PG8_BAR; PG8_MMA(1, 0, At, B0); PG8_MMA(1, 1, At, B1); PG8_BAR; PG8_SCHED;
            PG8_LDB(B0, 1, 0); PG8_LDB(B1, 1, 1); PG8_SCHED; PG8_LDA(At, 1, 0); PG8_STAGE(PG8_SA(0, 1), a2 + hstep, voffA);
            PG8_WAIT_V(8); PG8_WAIT_L(0); PG8_BAR; PG8_MMA(0, 0, At, B0); PG8_MMA(0, 1, At, B1); PG8_BAR; PG8_SCHED;
            PG8_LDA(At, 1, 1); PG8_STAGE(PG8_SB(1, 0), b3, voffB); PG8_STAGE(PG8_SB(1, 1), b3 + hstep, voffB); PG8_STAGE(PG8_SA(1, 0), a3, voffA);
            PG8_WAIT_V(8); PG8_WAIT_L(0); PG8_BAR; PG8_MMA(1, 0, At, B0); PG8_MMA(1, 1, At, B1); PG8_BAR; PG8_SCHED;
            } else {
            PG8_LDB(B0, 0, 0); PG8_SCHED; PG8_LDA(At, 0, 0); PG8_STAGE(PG8_SA(1, 1), a1 + hstep, voffA);
            PG8_WAIT_L(8); PG8_BAR; PG8_WAIT_L(0); PG8_MMA(0, 0, At, B0); PG8_BAR; PG8_SCHED;
            PG8_LDB(B1, 0, 1); PG8_STAGE(PG8_SB(0, 0), b2, voffB);
            PG8_BAR; PG8_WAIT_L(0); PG8_MMA(0, 1, At, B1); PG8_BAR;
            PG8_LDA(At, 0, 1); PG8_STAGE(PG8_SA(0, 0), a2, voffA);
            PG8_BAR; PG8_WAIT_L(0); PG8_MMA(1, 0, At, B0); PG8_BAR; PG8_SCHED;
            PG8_STAGE(PG8_SB(0, 1), b2 + hstep, voffB);
            PG8_WAIT_V(6); PG8_BAR; PG8_MMA(1, 1, At, B1); PG8_BAR;
            PG8_LDB(B0, 1, 0); PG8_SCHED; PG8_LDA(At, 1, 0); PG8_STAGE(PG8_SA(0, 1), a2 + hstep, voffA);
            PG8_WAIT_L(8); PG8_BAR; PG8_WAIT_L(0); PG8_MMA(0, 0, At, B0); PG8_BAR; PG8_SCHED;
            PG8_LDB(B1, 1, 1); PG8_STAGE(PG8_SB(1, 0), b3, voffB);
            PG8_BAR; PG8_WAIT_L(0); PG8_MMA(0, 1, At, B1); PG8_BAR;
            PG8_LDA(At, 1, 1); PG8_STAGE(PG8_SA(1, 0), a3, voffA);
            PG8_BAR; PG8_WAIT_L(0); PG8_MMA(1, 0, At, B0); PG8_BAR; PG8_SCHED;
            PG8_STAGE(PG8_SB(1, 1), b3 + hstep, voffB);
            PG8_WAIT_V(6); PG8_BAR; PG8_MMA(1, 1, At, B1); PG8_BAR;
            }
        }
        if constexpr (ALIGN_EPI) { if (wr == 0) PG8_BAR; }
        if constexpr (!Epi::AFTER_DRAIN) { E(acc, cur, wr, wc, fr, fq); S.done(cur); }
        if (!has_next) break;
#pragma unroll
        for (int a = 0; a < 2; ++a)
#pragma unroll
            for (int b = 0; b < 2; ++b)
#pragma unroll
                for (int m = 0; m < 4; ++m)
#pragma unroll
                    for (int n = 0; n < 2; ++n) acc[a][b][m][n] = (f32x4){0.f, 0.f, 0.f, 0.f};
        cur = nxt; cA = nA; cB = nB; ++ui;
        if constexpr (ALIGN_EPI) { if (wr == 1) PG8_BAR; }
    }
    PG8_WAIT_V(0);
    if constexpr (!ALIGN_EPI) { if (wr == 0) PG8_BAR; }
    PG8_BAR;
    if constexpr (Epi::AFTER_DRAIN) { E.fused(acc, cur, wr, wc, fr, fq, lds, wid, lane); S.done(cur); }
#undef PG8_SA
#undef PG8_SB
#undef PG8_STAGE
#undef PG8_LDA
#undef PG8_LDB
#undef PG8_MMA
#undef PG8_WAIT_V
#undef PG8_WAIT_L
#undef PG8_BAR
#undef PG8_SCHED
}
}

#define LAS __attribute__((address_space(3)))
#define GAS __attribute__((address_space(1)))
typedef unsigned char uchar;
typedef pg8::bf16_t bf16_t;
typedef pg8::bf16x8 bf16x8;
typedef pg8::f32x4 f32x4;
typedef pg8::u32x4 u32x4;
typedef unsigned u32x2 __attribute__((ext_vector_type(2)));
typedef float f32x2 __attribute__((ext_vector_type(2)));
typedef float f32x16 __attribute__((ext_vector_type(16)));
typedef __bf16 bf16x2_t __attribute__((ext_vector_type(2)));

constexpr int NB = 16, SEQ = 4096, T = NB * SEQ, DM = 1024, FF = 2816, MEML = 256, TM = NB * MEML;
constexpr int NPROJ = 3328, PLD = 3072;
constexpr int PC_Z = 0, PC_X = 512, PC_B = 1024, PC_C = 1280, PC_Q = 1536, PC_K = 2048, PC_V = 2560;
constexpr float EPS = 1e-5f, LOG2E = 1.4426950408889634f;
constexpr float LAMBDA_INIT = 0.2f;

constexpr size_t MiB = 1u << 20;
constexpr size_t WS_CTL = 0, WS_ROPE = 1 * MiB, WS_SS0 = 2 * MiB, WS_SS1 = 6 * MiB, WS_SS2 = 10 * MiB, WS_SS3 = 14 * MiB, WS_SS4 = 18 * MiB, WS_SSM = 22 * MiB,
                 WS_DT = 23 * MiB, WS_WGU1 = 27 * MiB, WS_WD1 = 38 * MiB, WS_WIN = 44 * MiB, WS_WOUT = 51 * MiB, WS_WQ = 53 * MiB, WS_WKV = 55 * MiB, WS_WO = 59 * MiB,
                 WS_WGU2 = 61 * MiB, WS_WD2 = 72 * MiB, WS_MEMB = 78 * MiB, WS_KVX = 86 * MiB, WS_VTX = 102 * MiB, WS_VT = 110 * MiB, WS_XB = 174 * MiB,
                 WS_YMIX = 302 * MiB, WS_YFB = 430 * MiB, WS_BIG = 558 * MiB, WS_END = 942 * MiB;
constexpr int LDS_BYTES = 147456, PTAB_OFF = LDS_BYTES - 512, LDS_PTAB_ABS = PTAB_OFF;

__device__ __forceinline__ const GAS float* lds_inp(int k) {
    const LAS unsigned long long* ptab = (const LAS unsigned long long*)(uintptr_t)0; const unsigned long long v = *(const LAS unsigned long long*)((const LAS uchar*)ptab + LDS_PTAB_ABS + 8 * k);
    return (const GAS float*)(((unsigned long long)(unsigned)__builtin_amdgcn_readfirstlane((int)(v >> 32)) << 32) | (unsigned long long)(unsigned)__builtin_amdgcn_readfirstlane((int)(v & 0xffffffffull)));
}
__device__ __forceinline__ int opaque_tid() { int t = threadIdx.x; asm volatile("" : "+v"(t)); return t; }
__device__ __forceinline__ unsigned cvtpk(float lo, float hi) { f32x2 v = {lo, hi}; bf16x2_t b = __builtin_convertvector(v, bf16x2_t); return __builtin_bit_cast(unsigned, b); }
__device__ __forceinline__ float bflo(unsigned w) { return __uint_as_float(w << 16); }
__device__ __forceinline__ float bfhi(unsigned w) { return __uint_as_float(w & 0xffff0000u); }
__device__ __forceinline__ float wave_sum(float v) {
#pragma unroll
    for (int o = 1; o < 64; o <<= 1) v += __shfl_xor(v, o);
    return v;
}
__device__ __forceinline__ float fast_exp2(float x) { return __builtin_amdgcn_exp2f(x); }
__device__ __forceinline__ float silu_f(float g) { return g * __builtin_amdgcn_rcpf(1.0f + fast_exp2(-LOG2E * g)); }
__device__ __forceinline__ float row_rs(const GAS float* part, int row) {
    const GAS f32x4* p = (const GAS f32x4*)(part + (size_t)row * 16);
    const f32x4 a = p[0], b = p[1], c = p[2], d = p[3];
    const float s = (((a[0] + a[1]) + (a[2] + a[3])) + ((b[0] + b[1]) + (b[2] + b[3]))) + (((c[0] + c[1]) + (c[2] + c[3])) + ((d[0] + d[1]) + (d[2] + d[3])));
    return 1.0f / sqrtf(s * (1.0f / 1024.0f) + EPS);
}

__device__ __forceinline__ void rows_rs8(const GAS float* part, int row0, int fq, float scale, float (&rs)[8]) {
    f32x4 p[8];
#pragma unroll
    for (int i = 0; i < 8; ++i) p[i] = *(const GAS f32x4*)(part + (size_t)(row0 + (i >> 2) * 128 + (i & 3) * 16) * 16 + 4 * fq);
#pragma unroll
    for (int i = 0; i < 8; ++i) { float sm = (p[i][0] + p[i][1]) + (p[i][2] + p[i][3]); sm += __shfl_xor(sm, 16); sm += __shfl_xor(sm, 32); rs[i] = scale / sqrtf(sm * (1.0f / 1024.0f) + EPS); }
}
struct EpiBf16RS {
    static constexpr bool PERM = true, AFTER_DRAIN = false;
    const GAS float* part; float scale; GAS bf16_t* O; int ldc;
    __device__ __forceinline__ void operator()(const f32x4 (&acc)[2][2][4][2], const pg8::Unit& u, int wr, int wc, int fr, int fq) const {
        const int row0 = u.pm * 256 + wr * 64 + fr, col0 = u.pn * 256 + wc * 32 + 8 * fq;
        float rs8[8]; rows_rs8(part, row0, fq, scale, rs8);
#pragma unroll
        for (int ai = 0; ai < 2; ++ai)
#pragma unroll
            for (int m = 0; m < 4; ++m) {
                const int row = row0 + ai * 128 + m * 16; const float rs = rs8[ai * 4 + m]; GAS bf16_t* rp = O + (size_t)row * ldc + col0;
#pragma unroll
                for (int bj = 0; bj < 2; ++bj) { const f32x4 v0 = acc[ai][bj][m][0] * rs, v1 = acc[ai][bj][m][1] * rs;
                    u32x4 w; w.x = cvtpk(v0[0], v0[1]); w.y = cvtpk(v0[2], v0[3]); w.z = cvtpk(v1[0], v1[1]); w.w = cvtpk(v1[2], v1[3]);
                    *(GAS u32x4*)(rp + bj * 128) = w; }
            }
    }
};
struct EpiSwiGLU {
    static constexpr bool PERM = true, AFTER_DRAIN = false;
    const GAS float* part; GAS bf16_t* U;
    __device__ __forceinline__ void operator()(const f32x4 (&acc)[2][2][4][2], const pg8::Unit& u, int wr, int wc, int fr, int fq) const {
        const int row0 = u.pm * 256 + wr * 64 + fr, col0 = u.pn * 128 + wc * 32 + 8 * fq;
        float rs8[8]; rows_rs8(part, row0, fq, 1.0f, rs8);
#pragma unroll
        for (int ai = 0; ai < 2; ++ai)
#pragma unroll
            for (int m = 0; m < 4; ++m) {
                const int row = row0 + ai * 128 + m * 16; const float rs = rs8[ai * 4 + m];
                float h[8];
#pragma unroll
                for (int n = 0; n < 2; ++n)
#pragma unroll
                    for (int e = 0; e < 4; ++e) { const float g = acc[ai][0][m][n][e] * rs, up = acc[ai][1][m][n][e] * rs; h[4 * n + e] = silu_f(g) * up; }
                u32x4 w; w.x = cvtpk(h[0], h[1]); w.y = cvtpk(h[2], h[3]); w.z = cvtpk(h[4], h[5]); w.w = cvtpk(h[6], h[7]);
                *(GAS u32x4*)(U + (size_t)row * FF + col0) = w;
            }
    }
};
struct EpiResidual {
    static constexpr bool PERM = true, AFTER_DRAIN = false;
    float alpha; GAS bf16_t* xb; GAS float* part;
    __device__ __forceinline__ void operator()(const f32x4 (&acc)[2][2][4][2], const pg8::Unit& u, int wr, int wc, int fr, int fq) const {
        const int row0 = u.pm * 256 + wr * 64 + fr, col0 = u.pn * 256 + wc * 32 + 8 * fq;
#pragma unroll
        for (int ai = 0; ai < 2; ++ai)
#pragma unroll
            for (int m = 0; m < 4; ++m) {
                const int row = row0 + ai * 128 + m * 16; float ss = 0.f;
#pragma unroll
                for (int bj = 0; bj < 2; ++bj) { const size_t off = (size_t)row * DM + col0 + bj * 128;
                    const u32x4 rv = *(const GAS u32x4*)(xb + off);
                    f32x4 v0, v1; v0[0] = bflo(rv.x); v0[1] = bfhi(rv.x); v0[2] = bflo(rv.y); v0[3] = bfhi(rv.y); v1[0] = bflo(rv.z); v1[1] = bfhi(rv.z); v1[2] = bflo(rv.w); v1[3] = bfhi(rv.w);
                    v0 = v0 + acc[ai][bj][m][0] * alpha; v1 = v1 + acc[ai][bj][m][1] * alpha;
                    u32x4 w; w.x = cvtpk(v0[0], v0[1]); w.y = cvtpk(v0[2], v0[3]); w.z = cvtpk(v1[0], v1[1]); w.w = cvtpk(v1[2], v1[3]); *(GAS u32x4*)(xb + off) = w;
                    ss += ((v0[0] * v0[0] + v0[1] * v0[1]) + (v0[2] * v0[2] + v0[3] * v0[3])) + ((v1[0] * v1[0] + v1[1] * v1[1]) + (v1[2] * v1[2] + v1[3] * v1[3])); }
                ss += __shfl_xor(ss, 16); ss += __shfl_xor(ss, 32);
                if (fq == 0) part[(size_t)row * 16 + u.pn * 4 + wc] = ss;
            }
    }
};
struct EpiProj {
    static constexpr bool PERM = true, AFTER_DRAIN = false;
    const GAS float* part; GAS bf16_t* P; GAS float* DT; const GAS float* cs; const GAS float* sn; const GAS float* dtb_f; const GAS float* dtb_b;
    __device__ __forceinline__ void operator()(const f32x4 (&acc)[2][2][4][2], const pg8::Unit& u, int wr, int wc, int fr, int fq) const {
        const int pn = u.pn; const int row0 = u.pm * 256 + wr * 64 + fr;
        const bool isq = (pn == 6 || pn == 7), isk = (pn == 8 || pn == 9), rope = (isq || isk) && ((wc & 1) == 0);
        const float qs = isq ? 0.125f * LOG2E : 1.0f; const float sgn = (fq == 0) ? -1.f : 1.f;
        float rs8[8]; rows_rs8(part, row0, fq, qs, rs8);
        if (pn == 12) {
            if (wc == 0 && fq < 2) {
                const GAS float* bias = (fq == 0) ? dtb_f : dtb_b;
#pragma unroll
                for (int ai = 0; ai < 2; ++ai)
#pragma unroll
                    for (int m = 0; m < 4; ++m) { const int row = row0 + ai * 128 + m * 16; const float rs = rs8[ai * 4 + m];
#pragma unroll
                        for (int n = 0; n < 2; ++n) { f32x4 o;
#pragma unroll
                            for (int e = 0; e < 4; ++e) { const float x = acc[ai][0][m][n][e] * rs + bias[4 * n + e]; o[e] = x > 20.f ? x : log1pf(__expf(x)); }
                            *(GAS f32x4*)(DT + (size_t)row * 16 + 8 * fq + 4 * n) = o; } }
            }
            return;
        }
        const int col0 = pn * 256 + wc * 32 + 8 * fq;
#pragma unroll
        for (int ai = 0; ai < 2; ++ai)
#pragma unroll
            for (int m = 0; m < 4; ++m) {
                const int row = row0 + ai * 128 + m * 16; const float rs = rs8[ai * 4 + m]; const int pos = row & (SEQ - 1);
                GAS bf16_t* rp = P + (size_t)row * PLD + col0;
#pragma unroll
                for (int bj = 0; bj < 2; ++bj) { f32x4 v0 = acc[ai][bj][m][0], v1 = acc[ai][bj][m][1];
                    if (rope) { f32x4 p0, p1;
#pragma unroll
                        for (int e = 0; e < 4; ++e) { p0[e] = __shfl_xor(v0[e], 16); p1[e] = __shfl_xor(v1[e], 16); }
                        if (fq < 2) { const f32x4 c0 = *(const GAS f32x4*)(cs + pos * 8), c1 = *(const GAS f32x4*)(cs + pos * 8 + 4), s0 = *(const GAS f32x4*)(sn + pos * 8), s1 = *(const GAS f32x4*)(sn + pos * 8 + 4);
                            v0 = v0 * c0 + p0 * s0 * sgn; v1 = v1 * c1 + p1 * s1 * sgn; } }
                    v0 = v0 * rs; v1 = v1 * rs;
                    u32x4 w; w.x = cvtpk(v0[0], v0[1]); w.y = cvtpk(v0[2], v0[3]); w.z = cvtpk(v1[0], v1[1]); w.w = cvtpk(v1[2], v1[3]);
                    *(GAS u32x4*)(rp + bj * 128) = w; }
            }
    }
};
struct EpiAny {
    static constexpr bool PERM = true, AFTER_DRAIN = false;
    int kind; GAS unsigned char* ws; float scale; unsigned part_off, o_off, opart_off; int ldc;
    __device__ __forceinline__ void operator()(const f32x4 (&acc)[2][2][4][2], const pg8::Unit& u, int wr, int wc, int fr, int fq) const {
        if (kind == 0) { EpiBf16RS e{(const GAS float*)(ws + part_off), scale, (GAS bf16_t*)(ws + o_off), ldc}; e(acc, u, wr, wc, fr, fq); }
        else if (kind == 1) { EpiSwiGLU e{(const GAS float*)(ws + part_off), (GAS bf16_t*)(ws + o_off)}; e(acc, u, wr, wc, fr, fq); }
        else if (kind == 2) { EpiResidual e{scale, (GAS bf16_t*)(ws + WS_XB), (GAS float*)(ws + opart_off)}; e(acc, u, wr, wc, fr, fq); }
        else { EpiProj e{(const GAS float*)(ws + part_off), (GAS bf16_t*)(ws + o_off), (GAS float*)(ws + WS_DT), (const GAS float*)(ws + WS_ROPE), (const GAS float*)(ws + WS_ROPE) + SEQ * 8, lds_inp(10), lds_inp(11)}; e(acc, u, wr, wc, fr, fq); }
    }
};
struct GJob { const GAS bf16_t* A; const GAS bf16_t* Bt; int M, N, K; EpiAny E; };
template <class Epi> __device__ __forceinline__ void run_gemm(LAS uchar* lds, const GAS bf16_t* A, const GAS bf16_t* Bt, int M, int N, int K, const Epi& E) {
    pg8::Gemm g{(const bf16_t*)A, (const bf16_t*)Bt, M, N, K}; pg8::StaticOrder S; S.init(M, N, (int)gridDim.x, (int)blockIdx.x);
    pg8::gemm_phase<Epi, pg8::StaticOrder, true, true>(lds, g, S, E);
}

__device__ __forceinline__ int map_row(int kind, int n) {
    if (kind == 1) return (n >> 7) * 256 + (n & 127);
    if (kind == 2) return (n >> 7) * 256 + 128 + (n & 127);
    if (kind == 3) return n < 1536 ? n : (n < 1552 ? 3072 + (n - 1536) : n - 16);
    return n;
}
__device__ __forceinline__ void p0_transpose_item(const GAS float* W, int K, int N, GAS bf16_t* WT, int kind, const GAS float* g, LAS float* scr, int item, int lane) {
    const int nblk = (N + 31) >> 5, kb = item / nblk, nb = item - kb * nblk, k0 = 64 * kb, n0 = 32 * nb;
    const int ncol = n0 + (lane & 31); const bool valid = ncol < N;
#pragma unroll 8
    for (int i = 0; i < 32; ++i) { const int kk = 2 * i + (lane >> 5); float v = valid ? W[(size_t)(k0 + kk) * N + ncol] : 0.f; if (g) v *= g[k0 + kk]; scr[kk * 33 + (lane & 31)] = v; }
    asm volatile("s_waitcnt lgkmcnt(0)" ::: "memory");
    const int c = lane & 7;
#pragma unroll
    for (int j = 0; j < 4; ++j) { const int n = (lane >> 3) + 8 * j; const LAS float* s = scr + (8 * c) * 33 + n;
        if (n0 + n < N) { u32x4 o; o.x = cvtpk(s[0 * 33], s[1 * 33]); o.y = cvtpk(s[2 * 33], s[3 * 33]); o.z = cvtpk(s[4 * 33], s[5 * 33]); o.w = cvtpk(s[6 * 33], s[7 * 33]);
            *(GAS u32x4*)(WT + (size_t)map_row(kind, n0 + n) * K + k0 + 8 * c) = o; } }
    asm volatile("s_waitcnt lgkmcnt(0)" ::: "memory");
}
__device__ __forceinline__ void rows4_to_bf16_ss(const GAS float* x, GAS bf16_t* o, GAS float* part, int row, int lane) {
    f32x4 v[4][4]; float sm[4];
#pragma unroll
    for (int r = 0; r < 4; ++r)
#pragma unroll
        for (int j = 0; j < 4; ++j) v[r][j] = ((const GAS f32x4*)(x + (size_t)(row + r) * DM))[lane + 64 * j];
#pragma unroll
    for (int r = 0; r < 4; ++r) { float a = 0.f;
#pragma unroll
        for (int j = 0; j < 4; ++j) a += (v[r][j][0] * v[r][j][0] + v[r][j][1] * v[r][j][1]) + (v[r][j][2] * v[r][j][2] + v[r][j][3] * v[r][j][3]);
        sm[r] = wave_sum(a); }
#pragma unroll
    for (int r = 0; r < 4; ++r) {
#pragma unroll
        for (int j = 0; j < 4; ++j) { u32x2 w; w.x = cvtpk(v[r][j][0], v[r][j][1]); w.y = cvtpk(v[r][j][2], v[r][j][3]); ((GAS u32x2*)(o + (size_t)(row + r) * DM))[lane + 64 * j] = w; }
        if (lane < 16) part[(size_t)(row + r) * 16 + lane] = (lane == 0) ? sm[r] : 0.f; }
}
__device__ __forceinline__ void rope_entry(int idx, GAS float* cs, GAS float* sn) {
    const int pos = idx >> 3, i = idx & 7;
    const float invf = (i == 0) ? 1.0f : (i == 1) ? 0.193922758102417f : (i == 2) ? 0.03760603070259094f : (i == 3) ? 0.00729266507551074f : (i == 4) ? 0.001414213445968926f
                     : (i == 5) ? 0.00027424818836152554f : (i == 6) ? 5.318296462064609e-05f : 1.0313385246263351e-05f;
    const float angf = (float)pos * invf;
    const double x = (double)angf; const double kq = rint(x * 0.6366197723675814);
    double r = fma(-kq, 1.5707963267948966, x); r = fma(-kq, 6.123233995736766e-17, r);
    const int q = ((int)kq) & 3; const double r2 = r * r;
    const double s = r * (1.0 + r2 * (-1.0 / 6 + r2 * (1.0 / 120 + r2 * (-1.0 / 5040 + r2 * (1.0 / 362880 + r2 * (-1.0 / 39916800 + r2 * (1.0 / 6227020800.0)))))));
    const double c = 1.0 + r2 * (-0.5 + r2 * (1.0 / 24 + r2 * (-1.0 / 720 + r2 * (1.0 / 40320 + r2 * (-1.0 / 3628800 + r2 * (1.0 / 479001600.0 + r2 * (-1.0 / 87178291200.0)))))));
    const double co = (q == 0) ? c : (q == 1) ? -s : (q == 2) ? -c : s;
    const double si = (q == 0) ? s : (q == 1) ? c : (q == 2) ? -s : -c;
    cs[idx] = (float)co; sn[idx] = (float)si;
}

__device__ __forceinline__ void transpose64(const GAS bf16_t* src, int sp, GAS bf16_t* dst, int dp, LAS uchar* scr, int lane) {
#pragma unroll
    for (int i = 0; i < 8; ++i) { const int r = i * 8 + (lane >> 3), c8 = lane & 7; const u32x4 v = *(const GAS u32x4*)(src + (size_t)r * sp + c8 * 8);
        LAS unsigned* w = (LAS unsigned*)(scr + r * 132 + c8 * 16); w[0] = v.x; w[1] = v.y; w[2] = v.z; w[3] = v.w; }
    asm volatile("s_waitcnt lgkmcnt(0)" ::: "memory");
#pragma unroll
    for (int i = 0; i < 8; ++i) { const int c = i * 8 + (lane >> 3), r8 = lane & 7; unsigned e[8];
#pragma unroll
        for (int j = 0; j < 8; ++j) e[j] = *(const LAS unsigned short*)(scr + (r8 * 8 + j) * 132 + c * 2);
        u32x4 o; o.x = e[0] | (e[1] << 16); o.y = e[2] | (e[3] << 16); o.z = e[4] | (e[5] << 16); o.w = e[6] | (e[7] << 16);
        *(GAS u32x4*)(dst + (size_t)c * dp + r8 * 8) = o; }
    asm volatile("s_waitcnt lgkmcnt(0)" ::: "memory");
}
__device__ __forceinline__ void conv_item(const GAS bf16_t* P, const GAS float* cw, const GAS float* cb, GAS bf16_t* XC, GAS bf16_t* XT, GAS bf16_t* BT, LAS uchar* scr, int item, int lane) {
    const int cb16 = item & 15, tt = item >> 4, tok0 = tt * 64, s0 = tok0 & (SEQ - 1), b = tok0 >> 12, ci = s0 >> 7, l0 = s0 & 127;
    const int c8 = lane & 7, tb = lane >> 3, ch = cb16 * 64 + c8 * 8;
    float w[5][8], bias[8];
#pragma unroll
    for (int k = 0; k < 5; ++k) { const f32x4 a = *(const GAS f32x4*)(cw + k * 1024 + ch), bq = *(const GAS f32x4*)(cw + k * 1024 + ch + 4);
#pragma unroll
        for (int e = 0; e < 4; ++e) { w[k][e] = a[e]; w[k][4 + e] = bq[e]; } }
    { const f32x4 a = *(const GAS f32x4*)(cb + ch), bq = *(const GAS f32x4*)(cb + ch + 4);
#pragma unroll
      for (int e = 0; e < 4; ++e) { bias[e] = a[e]; bias[4 + e] = bq[e]; } }
    const int sb = s0 + tb * 8;
    const GAS bf16_t* src = P + (size_t)(tok0 + tb * 8) * PLD + PC_X + ch;
    float win[5][8];
#pragma unroll
    for (int j = 0; j < 4; ++j) { const int sq = sb + j - 2; u32x4 v = {0u, 0u, 0u, 0u}; if (sq >= 0 && sq < SEQ) v = *(const GAS u32x4*)(src + (ptrdiff_t)(j - 2) * PLD);
        win[j][0] = bflo(v.x); win[j][1] = bfhi(v.x); win[j][2] = bflo(v.y); win[j][3] = bfhi(v.y); win[j][4] = bflo(v.z); win[j][5] = bfhi(v.z); win[j][6] = bflo(v.w); win[j][7] = bfhi(v.w); }
#pragma unroll
    for (int i = 0; i < 8; ++i) {
        { const int sq = sb + i + 2; u32x4 v = {0u, 0u, 0u, 0u}; if (sq < SEQ) v = *(const GAS u32x4*)(src + (ptrdiff_t)(i + 2) * PLD);
          float* d = win[(i + 4) % 5];
          d[0] = bflo(v.x); d[1] = bfhi(v.x); d[2] = bflo(v.y); d[3] = bfhi(v.y); d[4] = bflo(v.z); d[5] = bfhi(v.z); d[6] = bflo(v.w); d[7] = bfhi(v.w); }
        float o[8];
#pragma unroll
        for (int e = 0; e < 8; ++e) { float acc = bias[e];
#pragma unroll
            for (int k = 0; k < 5; ++k) acc += w[k][e] * win[(i + k) % 5][e];
            o[e] = silu_f(acc); }
        u32x4 ov; ov.x = cvtpk(o[0], o[1]); ov.y = cvtpk(o[2], o[3]); ov.z = cvtpk(o[4], o[5]); ov.w = cvtpk(o[6], o[7]);
        *(GAS u32x4*)(XC + (size_t)(tok0 + tb * 8 + i) * 1024 + ch) = ov;
        LAS unsigned* wq = (LAS unsigned*)(scr + (tb * 8 + i) * 132 + c8 * 16); wq[0] = ov.x; wq[1] = ov.y; wq[2] = ov.z; wq[3] = ov.w;
    }
    asm volatile("s_waitcnt lgkmcnt(0)" ::: "memory");
    if (cb16 < 12) {
        GAS bf16_t* dst = (cb16 < 8) ? XT + ((size_t)((b * 32 + ci) * 8 + cb16) * 64) * 128 + l0
                                 : BT + ((size_t)((b * 32 + ci) * 2 + ((cb16 - 8) >> 1)) * 128 + ((cb16 - 8) & 1) * 64) * 128 + l0;
#pragma unroll
        for (int i = 0; i < 8; ++i) { const int c = i * 8 + (lane >> 3), r8 = lane & 7; unsigned e[8];
#pragma unroll
            for (int j = 0; j < 8; ++j) e[j] = *(const LAS unsigned short*)(scr + (r8 * 8 + j) * 132 + c * 2);
            u32x4 ov; ov.x = e[0] | (e[1] << 16); ov.y = e[2] | (e[3] << 16); ov.z = e[4] | (e[5] << 16); ov.w = e[6] | (e[7] << 16);
            *(GAS u32x4*)(dst + (size_t)c * 128 + r8 * 8) = ov; }
    }
    asm volatile("s_waitcnt lgkmcnt(0)" ::: "memory");
}

__device__ __forceinline__ float dpp_sum8(float v) {
    v += __builtin_bit_cast(float, __builtin_amdgcn_update_dpp(0, __builtin_bit_cast(int, v), 0xB1, 0xF, 0xF, true));
    v += __builtin_bit_cast(float, __builtin_amdgcn_update_dpp(0, __builtin_bit_cast(int, v), 0x4E, 0xF, 0xF, true));
    v += __builtin_bit_cast(float, __builtin_amdgcn_update_dpp(0, __builtin_bit_cast(int, v), 0x141, 0xF, 0xF, true));
    return v;
}
__device__ __forceinline__ void ssd_item(LAS uchar* lds, int b, int h, int dir, const GAS bf16_t* XC, const GAS float* DT, float Aneg, GAS bf16_t* Y) {
    const int tid = opaque_tid(), p = tid >> 3, nq = tid & 7, g = h >> 2;
    LAS float* sB = (LAS float*)lds;
    LAS float* sC = sB + 64 * 128;
    LAS float* sX = sC + 64 * 128;
    LAS float* sY = sX + 64 * 64;
    LAS float* sDt = sY + 64 * 64;
    LAS float* sE = sDt + 64;
    float st[16];
#pragma unroll
    for (int k = 0; k < 16; ++k) st[k] = 0.f;
    u32x4 rb[2], rc[2], rx; float rdt = 0.f;
    const size_t tokb = (size_t)b * SEQ;
#define SSD_LOAD(blk) do { const int t0_ = dir ? (SEQ - 64 - (blk) * 64) : (blk) * 64; \
        _Pragma("unroll") for (int i_ = 0; i_ < 2; ++i_) { const int id_ = tid + 512 * i_, r_ = id_ >> 4, c_ = id_ & 15; const GAS bf16_t* s_ = XC + (tokb + t0_ + r_) * 1024 + 512 + g * 128 + c_ * 8; \
            rb[i_] = *(const GAS u32x4*)s_; rc[i_] = *(const GAS u32x4*)(s_ + 256); } \
        { const int r_ = tid >> 3, c_ = tid & 7; rx = *(const GAS u32x4*)(XC + (tokb + t0_ + r_) * 1024 + h * 64 + c_ * 8); } \
        if (tid < 64) rdt = DT[(tokb + t0_ + tid) * 16 + dir * 8 + h]; } while (0)
#define SSD_ST8(dst, v) do { f32x4 a_, b_; a_[0] = bflo((v).x); a_[1] = bfhi((v).x); a_[2] = bflo((v).y); a_[3] = bfhi((v).y); b_[0] = bflo((v).z); b_[1] = bfhi((v).z); b_[2] = bflo((v).w); b_[3] = bfhi((v).w); \
        *(LAS f32x4*)(dst) = a_; *(LAS f32x4*)((dst) + 4) = b_; } while (0)
#define SSD_STORE() do { \
        _Pragma("unroll") for (int i_ = 0; i_ < 2; ++i_) { const int id_ = tid + 512 * i_, r_ = id_ >> 4, c_ = id_ & 15; SSD_ST8(sB + r_ * 128 + c_ * 8, rb[i_]); SSD_ST8(sC + r_ * 128 + c_ * 8, rc[i_]); } \
        { const int r_ = tid >> 3, c_ = tid & 7; SSD_ST8(sX + r_ * 64 + c_ * 8, rx); } \
        if (tid < 64) { sDt[tid] = rdt; sE[tid] = __expf(rdt * Aneg); } } while (0)
    SSD_LOAD(0); SSD_STORE();
    __syncthreads();
    for (int blk = 0; blk < SEQ / 64; ++blk) {
        if (blk + 1 < SEQ / 64) SSD_LOAD(blk + 1);
        for (int j = 0; j < 64; ++j) {
            const int i = dir ? 63 - j : j;
            const float e = sE[i], xdt = sX[i * 64 + p] * sDt[i];
            const LAS f32x4* bp = (const LAS f32x4*)(sB + i * 128 + nq * 16); const LAS f32x4* cp = (const LAS f32x4*)(sC + i * 128 + nq * 16);
            float acc = 0.f;
#pragma unroll
            for (int q = 0; q < 4; ++q) { const f32x4 bv = bp[q], cv = cp[q];
#pragma unroll
                for (int k = 0; k < 4; ++k) { st[4 * q + k] = st[4 * q + k] * e + xdt * bv[k]; acc += cv[k] * st[4 * q + k]; } }
            acc = dpp_sum8(acc);
            if (nq == 0) sY[i * 64 + p] = acc;
        }
        __syncthreads();
        { const int t0 = dir ? (SEQ - 64 - blk * 64) : blk * 64; const int r = tid >> 3, c = tid & 7; const LAS f32x4* yp = (const LAS f32x4*)(sY + r * 64 + c * 8); const f32x4 a = yp[0], bq = yp[1];
          u32x4 w; w.x = cvtpk(a[0], a[1]); w.y = cvtpk(a[2], a[3]); w.z = cvtpk(bq[0], bq[1]); w.w = cvtpk(bq[2], bq[3]);
          *(GAS u32x4*)(Y + (tokb + t0 + r) * 512 + h * 64 + c * 8) = w; }
        if (blk + 1 < SEQ / 64) SSD_STORE();
        __syncthreads();
    }
#undef SSD_LOAD
#undef SSD_ST8
#undef SSD_STORE
}

__device__ __forceinline__ int crow(int r, int hi) { return (r & 3) + 8 * (r >> 2) + 4 * hi; }
#define MFMA32(a, b, c) __builtin_amdgcn_mfma_f32_32x32x16_bf16((a), (b), (c), 0, 0, 0)
constexpr int SS_ROW = 272, SS_B = 0, SS_BT = 34816, SS_C = 69632, SS_XT = 104448, SS_S = 121856, SS_SC = 139264, SS_SCB = 2064;
static_assert(SS_SC + 2 * SS_SCB <= PTAB_OFF, "SSD LDS map");
__device__ __forceinline__ void ssd_item2(LAS uchar* lds, int b, int h, int dir, const GAS bf16_t* XC, const GAS bf16_t* BT, const GAS bf16_t* XT, const GAS float* DT, float Aneg, GAS bf16_t* Y) {
    const int tid = opaque_tid(), lane = tid & 63, wid = __builtin_amdgcn_readfirstlane(tid >> 6), l31 = lane & 31, hi = lane >> 5, g = h >> 2;
    const int lt = wid < 4 ? wid : 7 - wid, pt = wid >> 2;
    f32x16 S;
#pragma unroll
    for (int r = 0; r < 16; ++r) S[r] = 0.f;
    u32x4 rB[4], rC[4], rT[4], rX[2]; float dt0 = 0.f, dt1 = 0.f;
#define S2_CI(cp) (dir ? 31 - (cp) : (cp))
#define S2_LOAD(cp) do { const int ci_ = S2_CI(cp); const size_t tok0_ = (size_t)b * SEQ + ci_ * 128; \
        _Pragma("unroll") for (int i_ = 0; i_ < 4; ++i_) { const int id_ = tid + 512 * i_, r_ = id_ >> 4, c_ = id_ & 15; const GAS bf16_t* s_ = XC + (tok0_ + r_) * 1024 + 512 + g * 128 + c_ * 8; \
            rB[i_] = *(const GAS u32x4*)s_; rC[i_] = *(const GAS u32x4*)(s_ + 256); \
            rT[i_] = *(const GAS u32x4*)(BT + ((size_t)((b * 32 + ci_) * 2 + g) * 128 + r_) * 128 + c_ * 8); } \
        _Pragma("unroll") for (int i_ = 0; i_ < 2; ++i_) { const int id_ = tid + 512 * i_, r_ = id_ >> 4, c_ = id_ & 15; rX[i_] = *(const GAS u32x4*)(XT + ((size_t)((b * 32 + ci_) * 8 + h) * 64 + r_) * 128 + c_ * 8); } } while (0)
#define S2_STORE() do { \
        _Pragma("unroll") for (int i_ = 0; i_ < 4; ++i_) { const int id_ = tid + 512 * i_, r_ = id_ >> 4, c_ = id_ & 15; \
            *(LAS u32x4*)(lds + SS_B + r_ * SS_ROW + c_ * 16) = rB[i_]; *(LAS u32x4*)(lds + SS_C + r_ * SS_ROW + c_ * 16) = rC[i_]; *(LAS u32x4*)(lds + SS_BT + r_ * SS_ROW + c_ * 16) = rT[i_]; } \
        _Pragma("unroll") for (int i_ = 0; i_ < 2; ++i_) { const int id_ = tid + 512 * i_, r_ = id_ >> 4, c_ = id_ & 15; *(LAS u32x4*)(lds + SS_XT + r_ * SS_ROW + c_ * 16) = rX[i_]; } } while (0)
#define S2_LOADDT(cp) do { const int ci_ = S2_CI(cp); const size_t tok0_ = (size_t)b * SEQ + ci_ * 128; const int la_ = dir ? 127 - 2 * lane : 2 * lane, lb_ = dir ? 126 - 2 * lane : 2 * lane + 1; \
        dt0 = DT[(tok0_ + la_) * 16 + dir * 8 + h]; dt1 = DT[(tok0_ + lb_) * 16 + dir * 8 + h]; } while (0)
#define S2_SCAN(buf) do { LAS float* sc_ = (LAS float*)(lds + SS_SC + (buf) * SS_SCB); const float a0_ = dt0 * Aneg, a1_ = dt1 * Aneg; float s_ = a0_ + a1_; \
        _Pragma("unroll") for (int o_ = 1; o_ < 64; o_ <<= 1) { const float t_ = __shfl_up(s_, o_); if (lane >= o_) s_ += t_; } \
        const float c1_ = s_, c0_ = s_ - a1_, tot_ = __shfl(s_, 63); const int la_ = dir ? 127 - 2 * lane : 2 * lane, lb_ = dir ? 126 - 2 * lane : 2 * lane + 1; \
        sc_[la_] = c0_; sc_[lb_] = c1_; sc_[128 + la_] = dt0; sc_[128 + lb_] = dt1; sc_[256 + la_] = __expf(tot_ - c0_) * dt0; sc_[256 + lb_] = __expf(tot_ - c1_) * dt1; \
        sc_[384 + la_] = __expf(c0_); sc_[384 + lb_] = __expf(c1_); if (lane == 0) sc_[512] = __expf(tot_); } while (0)
    S2_LOAD(0); S2_LOADDT(0);
    if (wid == 0) S2_SCAN(0);
    S2_LOADDT(1);
    S2_STORE();
    for (int i = tid; i < 64 * SS_ROW / 4; i += 512) ((LAS unsigned*)(lds + SS_S))[i] = 0u;
    __syncthreads();
    for (int cp = 0; cp < 32; ++cp) {
        if (wid == 0 && cp + 1 < 32) S2_SCAN((cp + 1) & 1);
        if (cp + 2 < 32) S2_LOADDT(cp + 2);
        if (cp + 1 < 32) S2_LOAD(cp + 1);
        const LAS float* sc = (const LAS float*)(lds + SS_SC + (cp & 1) * SS_SCB);
        const LAS float* sCum = sc; const LAS float* sDt = sc + 128; const LAS float* sW = sc + 256; const LAS float* sEin = sc + 384;
        bf16x8 cf[8];
#pragma unroll
        for (int k = 0; k < 8; ++k) cf[k] = *(const LAS bf16x8*)(lds + SS_C + (32 * lt + l31) * SS_ROW + (16 * k + 8 * hi) * 2);
        f32x16 Yd;
#pragma unroll
        for (int r = 0; r < 16; ++r) Yd[r] = 0.f;
        const float cum_l = sCum[32 * lt + l31];
        const int st_lo = dir ? lt : 0, st_hi = dir ? 3 : lt;
        for (int st = st_lo; st <= st_hi; ++st) {
            f32x16 G;
#pragma unroll
            for (int r = 0; r < 16; ++r) G[r] = 0.f;
#pragma unroll
            for (int k = 0; k < 8; ++k) { const bf16x8 bf = *(const LAS bf16x8*)(lds + SS_B + (32 * st + l31) * SS_ROW + (16 * k + 8 * hi) * 2); G = MFMA32(bf, cf[k], G); }
            const bool diag = (st == lt);
#pragma unroll
            for (int r4 = 0; r4 < 4; ++r4) { const f32x4 cs4 = *(const LAS f32x4*)(sCum + 32 * st + 8 * r4 + 4 * hi), dt4 = *(const LAS f32x4*)(sDt + 32 * st + 8 * r4 + 4 * hi);
#pragma unroll
                for (int e = 0; e < 4; ++e) { const int srel = 8 * r4 + 4 * hi + e; float v = G[4 * r4 + e] * __expf(cum_l - cs4[e]) * dt4[e];
                    if (diag) { const bool ok = dir ? (srel >= l31) : (srel <= l31); v = ok ? v : 0.f; }
                    G[4 * r4 + e] = v; } }
#pragma unroll
            for (int j = 0; j < 2; ++j) { u32x4 pw; pw.x = cvtpk(G[8 * j], G[8 * j + 1]); pw.y = cvtpk(G[8 * j + 2], G[8 * j + 3]); pw.z = cvtpk(G[8 * j + 4], G[8 * j + 5]); pw.w = cvtpk(G[8 * j + 6], G[8 * j + 7]);
                const LAS uchar* xa = lds + SS_XT + (32 * pt + l31) * SS_ROW + (32 * st + 16 * j + 4 * hi) * 2;
                const u32x2 lo = *(const LAS u32x2*)xa, hh = *(const LAS u32x2*)(xa + 16);
                u32x4 xw; xw.x = lo.x; xw.y = lo.y; xw.z = hh.x; xw.w = hh.y;
                Yd = MFMA32(__builtin_bit_cast(bf16x8, pw), __builtin_bit_cast(bf16x8, xw), Yd); }
        }
        f32x16 Yo;
#pragma unroll
        for (int r = 0; r < 16; ++r) Yo[r] = 0.f;
#pragma unroll
        for (int k = 0; k < 8; ++k) { const bf16x8 sf = *(const LAS bf16x8*)(lds + SS_S + (32 * pt + l31) * SS_ROW + (16 * k + 8 * hi) * 2); Yo = MFMA32(cf[k], sf, Yo); }
        { const size_t tok0 = (size_t)b * SEQ + S2_CI(cp) * 128;
#pragma unroll
          for (int r4 = 0; r4 < 4; ++r4) { const f32x4 e4 = *(const LAS f32x4*)(sEin + 32 * lt + 8 * r4 + 4 * hi);
#pragma unroll
              for (int e = 0; e < 4; ++e) { const float yv = Yd[4 * r4 + e] + e4[e] * Yo[4 * r4 + e];
                  Y[(tok0 + 32 * lt + 8 * r4 + 4 * hi + e) * 512 + h * 64 + 32 * pt + l31] = (bf16_t)(cvtpk(yv, 0.f) & 0xffffu); } } }
        { const float etot = sc[512];
#pragma unroll
          for (int r = 0; r < 16; ++r) S[r] *= etot;
#pragma unroll
          for (int k = 0; k < 8; ++k) { const u32x4 xr = *(const LAS u32x4*)(lds + SS_XT + (32 * pt + l31) * SS_ROW + (16 * k + 8 * hi) * 2);
              const f32x4 w0 = *(const LAS f32x4*)(sW + 16 * k + 8 * hi), w1 = *(const LAS f32x4*)(sW + 16 * k + 8 * hi + 4);
              u32x4 xs; xs.x = cvtpk(bflo(xr.x) * w0[0], bfhi(xr.x) * w0[1]); xs.y = cvtpk(bflo(xr.y) * w0[2], bfhi(xr.y) * w0[3]); xs.z = cvtpk(bflo(xr.z) * w1[0], bfhi(xr.z) * w1[1]); xs.w = cvtpk(bflo(xr.w) * w1[2], bfhi(xr.w) * w1[3]);
              const bf16x8 btf = *(const LAS bf16x8*)(lds + SS_BT + (32 * lt + l31) * SS_ROW + (16 * k + 8 * hi) * 2);
              S = MFMA32(__builtin_bit_cast(bf16x8, xs), btf, S); } }
        __syncthreads();
        if (cp + 1 < 32) S2_STORE();
#pragma unroll
        for (int r = 0; r < 16; ++r) *(LAS unsigned short*)(lds + SS_S + (32 * pt + crow(r, hi)) * SS_ROW + (32 * lt + l31) * 2) = (unsigned short)(cvtpk(S[r], 0.f) & 0xffffu);
        __syncthreads();
    }
#undef S2_CI
#undef S2_LOAD
#undef S2_STORE
#undef S2_LOADDT
#undef S2_SCAN
}

template <int DQK, int KW, int DVT, int NT, int MODE, bool PIPE>
__device__ __forceinline__ void attn_item(LAS uchar* lds, const GAS bf16_t* qptr, int qpitch, const GAS bf16_t* kptr, int kpitch, int kwcol, const GAS bf16_t* vtptr, int vtpitch, int vrow,
                                          GAS bf16_t* outp, int opitch, float lam, const GAS float* subg) {
    constexpr int KROW = KW * 2 + 16, KBUF = 64 * KROW, VROW = 136, VBUF = DVT * VROW, NKP = 64 * (KW / 8) / 512, NVP = DVT * 8 / 512, NS = DQK / 16;
    static_assert(2 * KBUF + 2 * VBUF <= PTAB_OFF && 128 * 256 * 4 + 1024 <= PTAB_OFF, "attention LDS");
    const int tid = opaque_tid(), lane = tid & 63, wid = __builtin_amdgcn_readfirstlane(tid >> 6), qg = wid >> 1, t = wid & 1, l31 = lane & 31, hi = lane >> 5;
    bf16x8 qf[NS];
    { const GAS bf16_t* qr = qptr + (size_t)(qg * 32 + l31) * qpitch + 8 * hi;
#pragma unroll
      for (int s = 0; s < NS; ++s) qf[s] = *(const GAS bf16x8*)(qr + 16 * s); }
    f32x16 o[4];
#pragma unroll
    for (int d = 0; d < 4; ++d)
#pragma unroll
        for (int r = 0; r < 16; ++r) o[d][r] = 0.f;
    float m = -1e30f, l = 0.f;
    u32x4 kst[NKP], vst[NVP];
#define AT_LOAD(tile) do { \
        _Pragma("unroll") for (int i_ = 0; i_ < NKP; ++i_) { const int id_ = tid + 512 * i_, r_ = id_ / (KW / 8), c_ = id_ % (KW / 8); kst[i_] = *(const GAS u32x4*)(kptr + (size_t)((tile) * 64 + r_) * kpitch + c_ * 8); } \
        _Pragma("unroll") for (int i_ = 0; i_ < NVP; ++i_) { const int id_ = tid + 512 * i_, r_ = id_ >> 3, c_ = id_ & 7; vst[i_] = *(const GAS u32x4*)(vtptr + (size_t)r_ * vtpitch + (tile) * 64 + c_ * 8); } } while (0)
#define AT_STORE(buf) do { \
        _Pragma("unroll") for (int i_ = 0; i_ < NKP; ++i_) { const int id_ = tid + 512 * i_, r_ = id_ / (KW / 8), c_ = id_ % (KW / 8); *(LAS u32x4*)(lds + (buf) * KBUF + r_ * KROW + c_ * 16) = kst[i_]; } \
        _Pragma("unroll") for (int i_ = 0; i_ < NVP; ++i_) { const int id_ = tid + 512 * i_, r_ = id_ >> 3, c_ = id_ & 7; LAS u32x2* d_ = (LAS u32x2*)(lds + 2 * KBUF + (buf) * VBUF + r_ * VROW + c_ * 16); \
            d_[0] = (u32x2){vst[i_].x, vst[i_].y}; d_[1] = (u32x2){vst[i_].z, vst[i_].w}; } } while (0)
    if (PIPE) { AT_LOAD(0); AT_STORE(0); __syncthreads(); }
#pragma unroll
    for (int s = 0; s < NS; ++s) asm volatile("" :: "v"(qf[s]));
    for (int tile = 0; tile < NT; ++tile) {
        if (PIPE) { if (tile + 1 < NT) AT_LOAD(tile + 1); }
        else { AT_LOAD(tile); AT_STORE(tile & 1); __syncthreads(); }
        const LAS uchar* kb = lds + (tile & 1) * KBUF; const LAS uchar* vb = lds + 2 * KBUF + (tile & 1) * VBUF;
        f32x16 s0, s1;
#pragma unroll
        for (int r = 0; r < 16; ++r) { s0[r] = 0.f; s1[r] = 0.f; }
        { const LAS uchar* ka = kb + l31 * KROW + (kwcol + 8 * hi) * 2;
          constexpr int GS = (NS > 4) ? 2 : 4;
#pragma unroll
          for (int g4 = 0; g4 < NS / GS; ++g4) { bf16x8 kf[2 * GS];
#pragma unroll
              for (int s = 0; s < GS; ++s) { kf[2 * s] = *(const LAS bf16x8*)(ka + 32 * (GS * g4 + s)); kf[2 * s + 1] = *(const LAS bf16x8*)(ka + 32 * KROW + 32 * (GS * g4 + s)); }
              __builtin_amdgcn_sched_barrier(0);
#pragma unroll
              for (int s = 0; s < GS; ++s) { s0 = MFMA32(kf[2 * s], qf[GS * g4 + s], s0); s1 = MFMA32(kf[2 * s + 1], qf[GS * g4 + s], s1); }
              __builtin_amdgcn_sched_barrier(0); } }
        u32x4 vfA[4], vfB[4];
#define AT_VLOAD(dst, kt, j) do { _Pragma("unroll") for (int d_ = 0; d_ < 4; ++d_) { const LAS uchar* va_ = vb + (vrow + 32 * d_ + l31) * VROW + (32 * (kt) + 16 * (j) + 4 * hi) * 2; \
            const u32x2 lo_ = *(const LAS u32x2*)va_, hh_ = *(const LAS u32x2*)(va_ + 16); dst[d_].x = lo_.x; dst[d_].y = lo_.y; dst[d_].z = hh_.x; dst[d_].w = hh_.y; } } while (0)
#define AT_PV(src, P, j) do { u32x4 pw_; pw_.x = cvtpk(P[8 * (j)], P[8 * (j) + 1]); pw_.y = cvtpk(P[8 * (j) + 2], P[8 * (j) + 3]); pw_.z = cvtpk(P[8 * (j) + 4], P[8 * (j) + 5]); pw_.w = cvtpk(P[8 * (j) + 6], P[8 * (j) + 7]); \
            const bf16x8 pa_ = __builtin_bit_cast(bf16x8, pw_); _Pragma("unroll") for (int d_ = 0; d_ < 4; ++d_) o[d_] = MFMA32(pa_, __builtin_bit_cast(bf16x8, src[d_]), o[d_]); } while (0)
        AT_VLOAD(vfA, 0, 0);
        __builtin_amdgcn_sched_barrier(0);
        float mx = fmaxf(s0[0], s1[0]);
#pragma unroll
        for (int r = 1; r < 16; ++r) mx = fmaxf(mx, fmaxf(s0[r], s1[r]));
        { auto rr = __builtin_amdgcn_permlane32_swap(__float_as_uint(mx), __float_as_uint(mx), false, false); mx = fmaxf(__uint_as_float(rr[0]), __uint_as_float(rr[1])); }
        const float mnew = fmaxf(m, mx); const float alpha = fast_exp2(m - mnew);
        if (__any(mnew > m)) {
#pragma unroll
            for (int r = 0; r < 16; ++r) { const float ar = __shfl(alpha, crow(r, hi));
#pragma unroll
                for (int d = 0; d < 4; ++d) o[d][r] *= ar; }
        }
        m = mnew; float ps = 0.f;
#pragma unroll
        for (int r = 0; r < 16; ++r) { s0[r] = fast_exp2(s0[r] - m); s1[r] = fast_exp2(s1[r] - m); ps += s0[r] + s1[r]; }
        l = l * alpha + ps;
        __builtin_amdgcn_sched_barrier(0);
        if constexpr (NS <= 4) {
        AT_VLOAD(vfB, 0, 1); __builtin_amdgcn_sched_barrier(0); AT_PV(vfA, s0, 0); __builtin_amdgcn_sched_barrier(0);
        AT_VLOAD(vfA, 1, 0); __builtin_amdgcn_sched_barrier(0); AT_PV(vfB, s0, 1); __builtin_amdgcn_sched_barrier(0);
        AT_VLOAD(vfB, 1, 1); __builtin_amdgcn_sched_barrier(0); AT_PV(vfA, s1, 0); __builtin_amdgcn_sched_barrier(0);
        AT_PV(vfB, s1, 1);
        } else {
        AT_PV(vfA, s0, 0); __builtin_amdgcn_sched_barrier(0); AT_VLOAD(vfA, 0, 1); __builtin_amdgcn_sched_barrier(0);
        AT_PV(vfA, s0, 1); __builtin_amdgcn_sched_barrier(0); AT_VLOAD(vfA, 1, 0); __builtin_amdgcn_sched_barrier(0);
        AT_PV(vfA, s1, 0); __builtin_amdgcn_sched_barrier(0); AT_VLOAD(vfA, 1, 1); __builtin_amdgcn_sched_barrier(0);
        AT_PV(vfA, s1, 1);
        }
#undef AT_VLOAD
#undef AT_PV
        if (PIPE) { if (tile + 1 < NT) AT_STORE((tile + 1) & 1); __syncthreads(); }
    }
    if (!PIPE) __syncthreads();
#undef AT_LOAD
#undef AT_STORE
    l += __shfl_xor(l, 32);
    LAS float* ex = (LAS float*)lds; LAS float* lsum = (LAS float*)(lds + 128 * 256 * 4);
#pragma unroll
    for (int d = 0; d < 4; ++d)
#pragma unroll
        for (int r = 0; r < 16; ++r) ex[(qg * 32 + crow(r, hi)) * 256 + t * 128 + 32 * d + l31] = o[d][r];
    if (hi == 0) lsum[t * 128 + qg * 32 + l31] = l;
    __syncthreads();
    for (int rr = 0; rr < 16; ++rr) {
        const int q = wid * 16 + rr;
        if (MODE == 0) {
            const float i1 = 1.0f / lsum[q], i2 = lam / lsum[128 + q];
            const f32x2 o1 = ((const LAS f32x2*)(ex + q * 256))[lane], o2 = ((const LAS f32x2*)(ex + q * 256 + 128))[lane];
            const float a = o1.x * i1 - o2.x * i2, bq = o1.y * i1 - o2.y * i2;
            const float ss = wave_sum(a * a + bq * bq); const float rn = (1.0f - LAMBDA_INIT) / sqrtf(ss * (1.0f / 128.0f) + EPS);
            *(GAS unsigned*)(outp + (size_t)q * opitch + 2 * lane) = cvtpk(a * rn * subg[2 * lane], bq * rn * subg[2 * lane + 1]);
        } else {
            const float inv = 1.0f / lsum[q]; const f32x4 v = ((const LAS f32x4*)(ex + q * 256))[lane];
            u32x2 w; w.x = cvtpk(v[0] * inv, v[1] * inv); w.y = cvtpk(v[2] * inv, v[3] * inv);
            *(GAS u32x2*)(outp + (size_t)q * opitch + 4 * lane) = w;
        }
    }
    __syncthreads();
}

#ifndef PHASE_MASK
#define PHASE_MASK 0xFFFF
#endif
#define PH_ON(k) ((PHASE_MASK >> (k)) & 1)
#define PH_IDS const int tid = opaque_tid(), lane = tid & 63, wave = __builtin_amdgcn_readfirstlane(tid >> 6), gw = bx * 8 + wave, gtid = bx * 512 + tid; (void)lane; (void)gw; (void)gtid; (void)wave
struct Args { const float* in[32]; float* out; unsigned char* ws; int ph_lo, ph_hi; };
constexpr int N_PHASES = 14;

__global__ void __launch_bounds__(512, 2) mega_fwd(Args a) {
    extern __shared__ __attribute__((aligned(16))) unsigned char lds_raw[];
    LAS uchar* lds = (LAS uchar*)lds_raw;
    const int G = (int)gridDim.x, bx = (int)blockIdx.x, NGW = G * 8, NTHR = G * 512;
    LAS unsigned long long* ptab = (LAS unsigned long long*)(lds + PTAB_OFF);
    if (threadIdx.x < 32) ptab[threadIdx.x] = (unsigned long long)a.in[threadIdx.x];
    __syncthreads();
#define INP(k) ((const GAS float*)(((unsigned long long)(unsigned)__builtin_amdgcn_readfirstlane((int)(ptab[k] >> 32)) << 32) | (unsigned long long)(unsigned)__builtin_amdgcn_readfirstlane((int)(ptab[k] & 0xffffffffull))))
    if (a.ph_lo == 0 && PH_ON(0)) {
        GAS float* rope_cs = (GAS float*)((GAS unsigned char*)a.ws + WS_ROPE);
        for (int i = bx * 512 + (int)threadIdx.x; i < SEQ * 8; i += NTHR) rope_entry(i, rope_cs, rope_cs + SEQ * 8);
    }
#ifdef REP_PH
    bool rep_done = false;
#endif
    for (int ph = a.ph_lo; ph < a.ph_hi; ++ph) {
        GAS unsigned char* ws = (GAS unsigned char*)a.ws; asm volatile("" : "+s"(ws));
        GAS float* lamp = (GAS float*)(ws + WS_CTL);
        GAS float* rope_cs = (GAS float*)(ws + WS_ROPE); GAS float* rope_sn = rope_cs + SEQ * 8;
        GAS float* SS0 = (GAS float*)(ws + WS_SS0); GAS float* SS1 = (GAS float*)(ws + WS_SS1); GAS float* SS2 = (GAS float*)(ws + WS_SS2); GAS float* SS3 = (GAS float*)(ws + WS_SS3); GAS float* SS4 = (GAS float*)(ws + WS_SS4); GAS float* SSM = (GAS float*)(ws + WS_SSM);
        GAS float* DTB = (GAS float*)(ws + WS_DT);
        GAS bf16_t* WGU1 = (GAS bf16_t*)(ws + WS_WGU1); GAS bf16_t* WD1 = (GAS bf16_t*)(ws + WS_WD1); GAS bf16_t* WIN = (GAS bf16_t*)(ws + WS_WIN); GAS bf16_t* WOUT = (GAS bf16_t*)(ws + WS_WOUT);
        GAS bf16_t* WQ = (GAS bf16_t*)(ws + WS_WQ); GAS bf16_t* WKV = (GAS bf16_t*)(ws + WS_WKV); GAS bf16_t* WO = (GAS bf16_t*)(ws + WS_WO); GAS bf16_t* WGU2 = (GAS bf16_t*)(ws + WS_WGU2); GAS bf16_t* WD2 = (GAS bf16_t*)(ws + WS_WD2);
        GAS bf16_t* MEMB = (GAS bf16_t*)(ws + WS_MEMB); GAS bf16_t* KVX = (GAS bf16_t*)(ws + WS_KVX); GAS bf16_t* VTX = (GAS bf16_t*)(ws + WS_VTX); GAS bf16_t* VT = (GAS bf16_t*)(ws + WS_VT);
        GAS float* out = (GAS float*)a.out;
        GAS bf16_t* XB = (GAS bf16_t*)(ws + WS_XB);
        GAS bf16_t* XC = (GAS bf16_t*)out; GAS bf16_t* XT = XC + (size_t)T * 1024; GAS bf16_t* BTR = XT + (size_t)T * 512;
        GAS bf16_t* YMIX = (GAS bf16_t*)(ws + WS_YMIX); GAS bf16_t* OX = YMIX;
        GAS bf16_t* YF = (GAS bf16_t*)(ws + WS_YFB); GAS bf16_t* YB = YF + (size_t)T * 512; GAS bf16_t* QX = YF;
        GAS bf16_t* BIG = (GAS bf16_t*)(ws + WS_BIG); GAS bf16_t* U = BIG; GAS bf16_t* PROJ = BIG;

        if (ph == 0 && PH_ON(0)) {
            PH_IDS;
            LAS float* scr = (LAS float*)(lds + wave * 16384);
            constexpr int I_G = 16 * 88, I_D = 44 * 32, I_IN = 16 * 97, I_SQ = 16 * 32, I_KV = 16 * 64;
            constexpr int NITEMS = 6 * I_G + I_IN + 3 * I_SQ + I_KV;
            static_assert(I_G == I_D, "item counts");
            for (int it = gw; it < NITEMS; it += NGW) {
                int r = it; const GAS float* W; const GAS float* gq = nullptr; GAS bf16_t* WT; int K = DM, N = DM, kind = 0;
                if (r < 3 * I_G) { const int w = r / I_G; r -= w * I_G; if (w == 2) { W = INP(5); K = FF; WT = WD1; } else { W = INP(3 + w); N = FF; WT = WGU1; kind = 1 + w; gq = INP(2); } }
                else if (r < 6 * I_G) { r -= 3 * I_G; const int w = r / I_G; r -= w * I_G; if (w == 2) { W = INP(30); K = FF; WT = WD2; } else { W = INP(28 + w); N = FF; WT = WGU2; kind = 1 + w; gq = INP(27); } }
                else if (r < 6 * I_G + I_IN) { r -= 6 * I_G; W = INP(7); N = 3088; WT = WIN; kind = 3; gq = INP(6); }
                else { r -= 6 * I_G + I_IN;
                    if (r < I_SQ) { W = INP(21); WT = WOUT; }
                    else if (r < 2 * I_SQ) { r -= I_SQ; W = INP(24); WT = WQ; gq = INP(22); }
                    else if (r < 3 * I_SQ) { r -= 2 * I_SQ; W = INP(26); WT = WO; }
                    else { r -= 3 * I_SQ; W = INP(25); N = 2 * DM; WT = WKV; gq = INP(23); } }
                p0_transpose_item(W, K, N, WT, kind, gq, scr, r, lane);
            }
            { const GAS float* xin = INP(0); for (int mrow = gw * 4; mrow < T; mrow += NGW * 4) rows4_to_bf16_ss(xin, XB, SS0, mrow, lane); }
            { const GAS float* min_ = INP(1); for (int mrow = gw * 4; mrow < TM; mrow += NGW * 4) rows4_to_bf16_ss(min_, MEMB, SSM, mrow, lane); }
            for (int i = gtid; i < (NPROJ - 3088) * DM / 8; i += NTHR) ((GAS u32x4*)(WIN + (size_t)3088 * DM))[i] = (u32x4){0u, 0u, 0u, 0u};
            if (bx == 0 && wave == 0) {
                const float s1 = wave_sum(INP(16)[lane] * INP(17)[lane]), s2 = wave_sum(INP(18)[lane] * INP(19)[lane]);
                if (lane == 0) lamp[0] = __expf(s1) - __expf(s2) + LAMBDA_INIT;
            }
        } else if (PH_ON(1) && (ph == 1 || ph == 2 || ph == 3 || ph == 7 || ph == 8 || ph == 10 || ph == 11 || ph == 12)) {
            for (int sub = 0; sub < 2; ++sub) {
                if (sub == 1 && ph != 1) break;
                GJob j; j.E = EpiAny{0, ws, 1.0f, 0u, 0u, 0u, 0};
                if (ph == 1 && sub == 0) { j.A = XB; j.Bt = WGU1; j.M = T; j.N = 2 * FF; j.K = DM; j.E.kind = 1; j.E.part_off = (unsigned)WS_SS0; j.E.o_off = (unsigned)WS_BIG; }
                else if (ph == 1)        { j.A = MEMB; j.Bt = WKV; j.M = TM; j.N = 2 * DM; j.K = DM; j.E.kind = 0; j.E.part_off = (unsigned)WS_SSM; j.E.o_off = (unsigned)WS_KVX; j.E.ldc = 2 * DM; }
                else if (ph == 2)        { j.A = U; j.Bt = WD1; j.M = T; j.N = DM; j.K = FF; j.E.kind = 2; j.E.scale = 0.5f; j.E.opart_off = (unsigned)WS_SS1; }
                else if (ph == 3)        { j.A = XB; j.Bt = WIN; j.M = T; j.N = NPROJ; j.K = DM; j.E.kind = 3; j.E.part_off = (unsigned)WS_SS1; j.E.o_off = (unsigned)WS_BIG; }
                else if (ph == 7)        { j.A = YMIX; j.Bt = WOUT; j.M = T; j.N = DM; j.K = DM; j.E.kind = 2; j.E.opart_off = (unsigned)WS_SS2; }
                else if (ph == 8)        { j.A = XB; j.Bt = WQ; j.M = T; j.N = DM; j.K = DM; j.E.kind = 0; j.E.part_off = (unsigned)WS_SS2; j.E.scale = 0.0625f * LOG2E; j.E.o_off = (unsigned)WS_YFB; j.E.ldc = DM; }
                else if (ph == 10)       { j.A = OX; j.Bt = WO; j.M = T; j.N = DM; j.K = DM; j.E.kind = 2; j.E.opart_off = (unsigned)WS_SS3; }
                else if (ph == 11)       { j.A = XB; j.Bt = WGU2; j.M = T; j.N = 2 * FF; j.K = DM; j.E.kind = 1; j.E.part_off = (unsigned)WS_SS3; j.E.o_off = (unsigned)WS_BIG; }
                else                     { j.A = U; j.Bt = WD2; j.M = T; j.N = DM; j.K = FF; j.E.kind = 2; j.E.scale = 0.5f; j.E.opart_off = (unsigned)WS_SS4; }
                run_gemm(lds, j.A, j.Bt, j.M, j.N, j.K, j.E);
            }
        } else if (ph == 4 && PH_ON(4)) {
            PH_IDS;
            LAS uchar* scr = lds + wave * 8448;
            { const GAS float* cwp = INP(8); const GAS float* cbp = INP(9); for (int it = gw; it < (T / 64) * 16; it += NGW) conv_item(PROJ, cwp, cbp, XC, XT, BTR, scr, it, lane); }
            for (int it = gw; it < NB * 4 * 2 * 64; it += NGW) { const int st = it & 63, dt = (it >> 6) & 1, bh = it >> 7, b = bh >> 2, h = bh & 3;
                transpose64(PROJ + (size_t)(b * SEQ + st * 64) * PLD + PC_V + h * 128 + dt * 64, PLD, VT + (size_t)(bh * 128 + dt * 64) * SEQ + st * 64, SEQ, scr, lane); }
            for (int it = gw; it < NB * 4 * 4 * 4; it += NGW) { const int mt = it & 3, dt = (it >> 2) & 3, bh = it >> 4, b = bh >> 2, h = bh & 3;
                transpose64(KVX + (size_t)(b * MEML + mt * 64) * (2 * DM) + DM + h * 256 + dt * 64, 2 * DM, VTX + (size_t)(bh * 256 + dt * 64) * MEML + mt * 64, MEML, scr, lane); }
        } else if (ph == 5 && PH_ON(5)) {
            PH_IDS;
#ifndef REP_SSD
#define REP_SSD 1
#endif
#ifndef REP_ATT
#define REP_ATT 1
#endif
            for (int rep = 0; rep < REP_SSD; ++rep)
            for (int it = bx; it < NB * 8 * 2; it += G) { const int dir = it & 1, h = (it >> 1) & 7, b = it >> 4;
                const float Aneg = -__expf(dir ? INP(13)[h] : INP(12)[h]);
#ifdef SSD_VALU
                ssd_item(lds, b, h, dir, XC, DTB, Aneg, dir ? YB : YF); }
#else
                ssd_item2(lds, b, h, dir, XC, BTR, XT, DTB, Aneg, dir ? YB : YF); }
#endif
            for (int rep = 0; rep < REP_ATT; ++rep)
            for (int i = 0;; ++i) {
                int bh, qb;
                if (G == 256) { if (i >= 8) break; bh = i * 8 + (bx & 7); qb = bx >> 3; }
                else { const int L = i * G + bx; if (L >= 2048) break; bh = L >> 5; qb = L & 31; }
                const int b = bh >> 2, h = bh & 3; const size_t row0 = (size_t)b * SEQ + qb * 128;
                const int t = wave & 1;
                attn_item<64, 128, 128, 64, 0, true>(lds, PROJ + row0 * PLD + PC_Q + h * 128 + t * 64, PLD, PROJ + (size_t)b * SEQ * PLD + PC_K + h * 128, PLD, t * 64,
                                               VT + (size_t)bh * 128 * SEQ, SEQ, 0, YMIX + row0 * DM + 512 + h * 128, DM, lamp[0], INP(20));
            }
        } else if (ph == 6 && PH_ON(6)) {
            PH_IDS;
            { const GAS float* Dp = INP(14); const GAS float* gp = INP(15);
              for (int it0 = gw * 4; it0 < T * 2; it0 += NGW * 4) {
                u32x2 yf[4], yb[4], xv[4], zv[4];
#pragma unroll
                for (int q = 0; q < 4; ++q) { const int it = it0 + q, tok = it >> 1, c = (it & 1) * 256 + 4 * lane;
                    yf[q] = *(const GAS u32x2*)(YF + (size_t)tok * 512 + c); yb[q] = *(const GAS u32x2*)(YB + (size_t)tok * 512 + c); xv[q] = *(const GAS u32x2*)(XC + (size_t)tok * 1024 + c); zv[q] = *(const GAS u32x2*)(PROJ + (size_t)tok * PLD + PC_Z + c); }
                float y[4][4], ss[4];
#pragma unroll
                for (int q = 0; q < 4; ++q) { const int c = ((it0 + q) & 1) * 256 + 4 * lane; const float D = Dp[c >> 6];
                    y[q][0] = (bflo(yf[q].x) + bflo(yb[q].x) + D * bflo(xv[q].x)) * silu_f(bflo(zv[q].x)); y[q][1] = (bfhi(yf[q].x) + bfhi(yb[q].x) + D * bfhi(xv[q].x)) * silu_f(bfhi(zv[q].x));
                    y[q][2] = (bflo(yf[q].y) + bflo(yb[q].y) + D * bflo(xv[q].y)) * silu_f(bflo(zv[q].y)); y[q][3] = (bfhi(yf[q].y) + bfhi(yb[q].y) + D * bfhi(xv[q].y)) * silu_f(bfhi(zv[q].y));
                    ss[q] = (y[q][0] * y[q][0] + y[q][1] * y[q][1]) + (y[q][2] * y[q][2] + y[q][3] * y[q][3]); }
#pragma unroll
                for (int o = 1; o < 64; o <<= 1) {
#pragma unroll
                    for (int q = 0; q < 4; ++q) ss[q] += __shfl_xor(ss[q], o); }
#pragma unroll
                for (int q = 0; q < 4; ++q) { const int it = it0 + q, tok = it >> 1, c = (it & 1) * 256 + 4 * lane; const float rn = 1.0f / sqrtf(ss[q] * (1.0f / 256.0f) + EPS); const f32x4 gv = *(const GAS f32x4*)(gp + c);
                    u32x2 w; w.x = cvtpk(y[q][0] * rn * gv[0], y[q][1] * rn * gv[1]); w.y = cvtpk(y[q][2] * rn * gv[2], y[q][3] * rn * gv[3]);
                    *(GAS u32x2*)(YMIX + (size_t)tok * DM + c) = w; }
              } }
        } else if (ph == 9 && PH_ON(9)) {
            PH_IDS;
            for (int i = 0;; ++i) {
                int bh, qb;
                if (G == 256) { if (i >= 8) break; bh = i * 8 + (bx & 7); qb = bx >> 3; }
                else { const int L = i * G + bx; if (L >= 2048) break; bh = L >> 5; qb = L & 31; }
                const int b = bh >> 2, h = bh & 3; const size_t row0 = (size_t)b * SEQ + qb * 128;
                const int t = wave & 1;
                attn_item<256, 256, 256, 4, 1, false>(lds, QX + row0 * DM + h * 256, DM, KVX + (size_t)b * MEML * (2 * DM) + h * 256, 2 * DM, 0,
                                               VTX + (size_t)bh * 256 * MEML, MEML, t * 128, OX + row0 * DM + h * 256, DM, 0.f, nullptr);
            }
        } else if (ph == 13 && PH_ON(13)) {
            PH_IDS;
            { f32x4 gv[4];
#pragma unroll
              for (int j = 0; j < 4; ++j) gv[j] = ((const GAS f32x4*)INP(31))[lane + 64 * j];
              for (int row0 = gw * 4; row0 < T; row0 += NGW * 4) {
                float sp[4]; u32x2 xv[4][4];
#pragma unroll
                for (int r = 0; r < 4; ++r) { sp[r] = SS4[(size_t)(row0 + r) * 16 + (lane & 15)];
#pragma unroll
                    for (int j = 0; j < 4; ++j) xv[r][j] = ((const GAS u32x2*)(XB + (size_t)(row0 + r) * DM))[lane + 64 * j]; }
#pragma unroll
                for (int o = 1; o < 16; o <<= 1) {
#pragma unroll
                    for (int r = 0; r < 4; ++r) sp[r] += __shfl_xor(sp[r], o); }
#pragma unroll
                for (int r = 0; r < 4; ++r) { const float rs = 1.0f / sqrtf(sp[r] * (1.0f / 1024.0f) + EPS); GAS f32x4* xr = (GAS f32x4*)(out + (size_t)(row0 + r) * DM);
#pragma unroll
                    for (int j = 0; j < 4; ++j) { f32x4 v; v[0] = bflo(xv[r][j].x); v[1] = bfhi(xv[r][j].x); v[2] = bflo(xv[r][j].y); v[3] = bfhi(xv[r][j].y); xr[lane + 64 * j] = v * rs * gv[j]; } }
              } }
        }
#ifdef REP_PH
        if (ph == REP_PH && !rep_done) { rep_done = true; cg::this_grid().sync(); --ph; continue; }
#endif
        if (ph + 1 < a.ph_hi) cg::this_grid().sync();
    }
}

extern "C" void kernel_launch(void* const* d_in, const int* in_sizes, int n_in, void* d_out, int out_size, void* d_ws, size_t ws_size, hipStream_t stream) {
    static int grid = 0;
    if (grid == 0) {
        if (n_in != 32 || in_sizes[0] != T * DM || out_size != T * DM || ws_size < WS_END) {
            fprintf(stderr, "kernel_launch: unexpected shapes (n_in %d, in0 %d, out %d, ws %zu < %zu); nothing launched\n", n_in, n_in > 0 ? in_sizes[0] : -1, out_size, ws_size, (size_t)WS_END); grid = -1; return; }
        int dev = 0, cus = 0, per_cu = 0;
        hipGetDevice(&dev); hipDeviceGetAttribute(&cus, hipDeviceAttributeMultiprocessorCount, dev);
        if (hipFuncSetAttribute((const void*)mega_fwd, hipFuncAttributeMaxDynamicSharedMemorySize, LDS_BYTES) != hipSuccess) { fprintf(stderr, "kernel_launch: hipFuncSetAttribute failed\n"); grid = -1; return; }
        if (hipOccupancyMaxActiveBlocksPerMultiprocessor(&per_cu, (const void*)mega_fwd, 512, LDS_BYTES) != hipSuccess || per_cu < 1) { fprintf(stderr, "kernel_launch: occupancy query says %d\n", per_cu); per_cu = 1; }
        (void)hipGetLastError();
        grid = cus * per_cu;
        if (grid <= 0) grid = 256;
    }
    if (grid < 0) return;
    Args a{};
    for (int i = 0; i < 32; ++i) a.in[i] = (const float*)d_in[i];
    a.out = (float*)d_out; a.ws = (unsigned char*)d_ws;
#if MK_COOP
    a.ph_lo = 0; a.ph_hi = N_PHASES;
    void* kargs[] = {&a};
    hipError_t e = hipLaunchCooperativeKernel((const void*)mega_fwd, dim3(grid), dim3(512), kargs, LDS_BYTES, stream);
    if (e != hipSuccess) fprintf(stderr, "kernel_launch: cooperative launch failed: %s (grid %d)\n", hipGetErrorString(e), grid);
#else
    for (int ph = 0; ph < N_PHASES; ++ph) { a.ph_lo = ph; a.ph_hi = ph + 1; hipLaunchKernelGGL(mega_fwd, dim3(grid), dim3(512), LDS_BYTES, stream, a); }
#endif
}
```

```cpp
#include <hip/hip_runtime.h>
#include <hip/hip_cooperative_groups.h>
#include <cstdio>
#include <cstdint>
namespace cg = cooperative_groups;
#ifndef MK_COOP
#define MK_COOP 1
#endif
namespace pg8 {
#define PG8_LAS __attribute__((address_space(3)))
typedef unsigned short bf16_t;
typedef short bf16x8 __attribute__((ext_vector_type(8)));
typedef float f32x4 __attribute__((ext_vector_type(4)));
typedef unsigned u32x4 __attribute__((ext_vector_type(4)));
constexpr int BM = 256, BK = 64, HALF = 128, HTB = HALF * BK * 2  , STAGE_BYTES = 8 * HTB, NXCD = 8, WGM = 8;

__host__ __device__ __forceinline__ int lds_byte(int r, int c) { const int st = (r >> 4) * 2 + (c >> 5), rr = r & 15, cc = c & 31, ob = rr * 64 + cc * 2; return st * 1024 + (ob ^ (((ob >> 9) & 1) << 5)); }
__host__ __device__ __forceinline__ void stage_rc(int b, int& R, int& C) { const int st = b / 1024, sb = b % 1024, swz = sb ^ (((sb >> 9) & 1) << 5); R = (st >> 1) * 16 + swz / 64; C = (st & 1) * 32 + (swz % 64) / 2; }
__host__ __device__ __forceinline__ int perm32(int rho) { const int n = rho >> 4, i = rho & 15; return 8 * (i >> 2) + 4 * n + (i & 3); }

struct Unit { int pm, pn; };
struct Gemm { const bf16_t* A; const bf16_t* Bt; int M, N, K; };

struct StaticOrder {
    int nM, nN, nwg, G, c;
    __host__ __device__ void init(int M, int N, int G_, int c_) { nM = M / BM; nN = N / BM; nwg = nM * nN; G = G_; c = c_; }
    __host__ __device__ bool next(int i, Unit& u) const {
        const long L = (long)i * G + c; if (L >= nwg) return false;
        int wgid = (int)L; { const int q = nwg / NXCD, r = nwg % NXCD, xcd = wgid % NXCD, off = wgid / NXCD; wgid = (xcd < r ? xcd * (q + 1) : r * (q + 1) + (xcd - r) * q) + off; }
        const int nig = WGM * nN, gid = wgid / nig, fm = gid * WGM, gsz = (nM - fm) < WGM ? (nM - fm) : WGM;
        u.pm = fm + ((wgid % nig) % gsz); u.pn = (wgid % nig) / gsz; return true;
    }
    __device__ __forceinline__ void a_ready(const Unit&) const {}
    __device__ __forceinline__ void done(const Unit&) const {}
};
__device__ __forceinline__ unsigned cvt_pk_bf16(float lo, float hi) { unsigned r; asm volatile("v_cvt_pk_bf16_f32 %0, %1, %2" : "=v"(r) : "v"(lo), "v"(hi)); return r; }
template <class Epi, class Sched, bool ALIGN_EPI = false, bool SP2 = false>
__device__ __forceinline__ void gemm_phase(PG8_LAS unsigned char* lds, const Gemm g, const Sched& S, const Epi& E) {
    int tid = threadIdx.x; asm volatile("" : "+v"(tid)); const int wid = __builtin_amdgcn_readfirstlane(tid >> 6), lane = tid & 63, wr = wid >> 2, wc = wid & 3, fr = lane & 15, fq = lane >> 4;
    const int K = g.K, nt = K / BK;
    unsigned voffA[2], voffB[2];
#pragma unroll
    for (int i = 0; i < 2; ++i) { int R, C; stage_rc(tid * 16 + i * 8192, R, C); const int Rb = Epi::PERM ? ((R & ~31) + perm32(R & 31)) : R;
        voffA[i] = (unsigned)(R * K + C) * 2u; voffB[i] = (unsigned)(Rb * K + C) * 2u; }
    const size_t kstep = (size_t)(BK * 2);
    const size_t hstep = (size_t)HALF * K * 2;
    const size_t tstep = 2 * hstep;
    const unsigned ldsw = (unsigned)wid * 1024u;
    const int aoff = lds_byte(wr * 64 + fr, fq * 8), boff = lds_byte(wc * 32 + fr, fq * 8);
#define PG8_SA(b, h) (((b) * 2 + (h)) * HTB)
#define PG8_SB(b, h) ((4 + (b) * 2 + (h)) * HTB)
#define PG8_STAGE(bufoff, gbase, voff) do { _Pragma("unroll") for (int _i = 0; _i < 2; ++_i) \
        __builtin_amdgcn_global_load_lds((const unsigned*)((const char*)(gbase) + (voff)[_i]), (PG8_LAS unsigned*)(lds + (bufoff) + ldsw + _i * 8192), 16, 0, 0); } while (0)
#define PG8_LDA(dst, b, h) do { _Pragma("unroll") for (int m = 0; m < 4; ++m) _Pragma("unroll") for (int k = 0; k < 2; ++k) dst[m][k] = *(const PG8_LAS bf16x8*)(lds + PG8_SA(b, h) + aoff + m * 2048 + k * 1024); } while (0)
#define PG8_LDB(dst, b, h) do { _Pragma("unroll") for (int n = 0; n < 2; ++n) _Pragma("unroll") for (int k = 0; k < 2; ++k) dst[n][k] = *(const PG8_LAS bf16x8*)(lds + PG8_SB(b, h) + boff + n * 2048 + k * 1024); } while (0)
#define PG8_MMA(ai, bj, At, Bt) do { __builtin_amdgcn_s_setprio(1); _Pragma("unroll") for (int m = 0; m < 4; ++m) _Pragma("unroll") for (int n = 0; n < 2; ++n) _Pragma("unroll") for (int k = 0; k < 2; ++k) \
        acc[ai][bj][m][n] = __builtin_amdgcn_mfma_f32_16x16x32_bf16(Bt[n][k], At[m][k], acc[ai][bj][m][n], 0, 0, 0); __builtin_amdgcn_s_setprio(0); } while (0)
#define PG8_WAIT_V(n) asm volatile("s_waitcnt vmcnt(" #n ")" ::: "memory")
#define PG8_WAIT_L(n) asm volatile("s_waitcnt lgkmcnt(" #n ")" ::: "memory")
#define PG8_BAR __builtin_amdgcn_s_barrier()
#define PG8_SCHED __builtin_amdgcn_sched_barrier(0)
    Unit cur, nxt; int ui = 0;
    if (!S.next(0, cur)) return;
    f32x4 acc[2][2][4][2];
#pragma unroll
    for (int a = 0; a < 2; ++a)
#pragma unroll
        for (int b = 0; b < 2; ++b)
#pragma unroll
            for (int m = 0; m < 4; ++m)
#pragma unroll
                for (int n = 0; n < 2; ++n) acc[a][b][m][n] = (f32x4){0.f, 0.f, 0.f, 0.f};
    bf16x8 At[4][2], B0[2][2], B1[2][2];
    const char* cA = (const char*)g.A + (size_t)cur.pm * tstep; const char* cB = (const char*)g.Bt + (size_t)cur.pn * tstep;
    S.a_ready(cur);
    if constexpr (SP2) {
        PG8_STAGE(PG8_SB(0, 0), cB, voffB); PG8_STAGE(PG8_SB(0, 1), cB + hstep, voffB); PG8_STAGE(PG8_SA(0, 0), cA, voffA); PG8_STAGE(PG8_SA(0, 1), cA + hstep, voffA);
        if (wr == 1) PG8_BAR;
        PG8_WAIT_V(2); PG8_BAR;
        PG8_STAGE(PG8_SB(1, 0), cB + kstep, voffB); PG8_STAGE(PG8_SA(1, 0), cA + kstep, voffA); PG8_STAGE(PG8_SB(1, 1), cB + hstep + kstep, voffB);
        PG8_WAIT_V(6); PG8_BAR;
    } else {
        PG8_STAGE(PG8_SB(0, 0), cB, voffB); PG8_STAGE(PG8_SA(0, 0), cA, voffA); PG8_STAGE(PG8_SB(0, 1), cB + hstep, voffB); PG8_STAGE(PG8_SA(0, 1), cA + hstep, voffA);
        if (wr == 1) PG8_BAR;
        PG8_WAIT_V(4); PG8_BAR;
        PG8_STAGE(PG8_SB(1, 0), cB + kstep, voffB); PG8_STAGE(PG8_SA(1, 0), cA + kstep, voffA); PG8_STAGE(PG8_SB(1, 1), cB + hstep + kstep, voffB);
        PG8_WAIT_V(6); PG8_BAR;
    }
    for (;;) {
        const bool has_next = S.next(ui + 1, nxt);
        const char* nA = has_next ? (const char*)g.A + (size_t)nxt.pm * tstep : cA; const char* nB = has_next ? (const char*)g.Bt + (size_t)nxt.pn * tstep : cB;
        for (int t = 0; t < nt; t += 2) {
            const bool last = (t == nt - 2);
            const char* a1 = cA + (size_t)(t + 1) * kstep;
            const char* a2 = last ? nA : cA + (size_t)(t + 2) * kstep; const char* b2 = last ? nB : cB + (size_t)(t + 2) * kstep;
            const char* a3 = a2 + kstep; const char* b3 = b2 + kstep;
            if (last && has_next) S.a_ready(nxt);
            if constexpr (SP2) {
            PG8_LDB(B0, 0, 0); PG8_LDB(B1, 0, 1); PG8_SCHED; PG8_LDA(At, 0, 0); PG8_STAGE(PG8_SA(1, 1), a1 + hstep, voffA);
            PG8_WAIT_V(8); PG8_WAIT_L(0); PG8_BAR; PG8_MMA(0, 0, At, B0); PG8_MMA(0, 1, At, B1); PG8_BAR; PG8_SCHED;
            PG8_LDA(At, 0, 1); PG8_STAGE(PG8_SB(0, 0), b2, voffB); PG8_STAGE(PG8_SB(0, 1), b2 + hstep, voffB); PG8_STAGE(PG8_SA(0, 0), a2, voffA);
            PG8_WAIT_V(8); PG8_WAIT_L(0); PG8_BAR; PG8_MMA(1, 0, At, B0); PG8_MMA(1, 1, At, B1); PG8_BAR; PG8_SCHED;
            PG8_LDB(B0, 1, 0); PG8_LDB(B1, 1, 1); PG8_SCHED; PG8_LDA(At, 1, 0); PG8_STAGE(PG8_SA(0, 1), a2 + hstep, voffA);
            PG8_WAIT_V(8); PG8_WAIT_L(0); PG8_BAR; PG8_MMA(0, 0, At, B0); PG8_MMA(0, 1, At, B1); PG8_BAR; PG8_SCHED;
            PG8_LDA(At, 1, 1); PG8_STAGE(PG8_SB(1, 0), b3, voffB); PG8_STAGE(PG8_SB(1, 1), b3 + hstep, voffB); PG8_STAGE(PG8_SA(1, 0), a3, voffA);
            PG8_WAIT_V(8); PG8_WAIT_L(0); PG8_BAR; PG8_MMA(1, 0, At, B0); PG8_MMA(1, 1, At, B1); PG8_BAR; PG8_SCHED;
            } else {
            PG8_LDB(B0, 0, 0); PG8_SCHED; PG8_LDA(At, 0, 0); PG8_STAGE(PG8_SA(1, 1), a1 + hstep, voffA);
            PG8_WAIT_L(8); PG8_BAR; PG8_WAIT_L(0); PG8_MMA(0, 0, At, B0); PG8_BAR; PG8_SCHED;
            PG8_LDB(B1, 0, 1); PG8_STAGE(PG8_SB(0, 0), b2, voffB);
            PG8_BAR; PG8_WAIT_L(0); PG8_MMA(0, 1, At, B1); PG8_BAR;
            PG8_LDA(At, 0, 1); PG8_STAGE(PG8_SA(0, 0), a2, voffA);
            PG8_BAR; PG8_WAIT_L(0); PG8_MMA(1, 0, At, B0); PG8_BAR; PG8_SCHED;
            PG8_STAGE(PG8_SB(0, 1), b2 + hstep, voffB);
            PG8_WAIT_V(6); PG8_BAR; PG8_MMA(1, 1, At, B1); PG8_BAR;
            PG8_LDB(B0, 1, 0); PG8_SCHED; PG8_LDA(At, 1, 0); PG8_STAGE(PG8_SA(0, 1), a2 + hstep, voffA);
            PG8_WAIT_L(8); PG8_BAR; PG8_WAIT_L(0); PG8_MMA(0, 0, At, B0); PG8_BAR; PG8_SCHED;
            PG8_LDB(B1, 1, 1); PG8_STAGE(PG8_SB(1, 0), b3, voffB);
            PG8_BAR; PG8_WAIT_L(0); PG8_MMA(0, 1, At, B1); PG8_BAR;
            PG8_LDA(At, 1, 1); PG8_STAGE(PG8_SA(1, 0), a3, voffA);
            PG8_BAR; PG8_WAIT_L(0); PG8_MMA(1, 0, At, B0); PG8_BAR; PG8_SCHED;
            PG8_STAGE(PG8_SB(1, 1), b3 + hstep, voffB);
            PG8_WAIT_V(6); PG8_BAR; PG8_MMA(1, 1, At, B1); PG8_BAR;
            }
        }
        if constexpr (ALIGN_EPI) { if (wr == 0) PG8_BAR; }
        if constexpr (!Epi::AFTER_DRAIN) { E(acc, cur, wr, wc, fr, fq); S.done(cur); }
        if (!has_next) break;
#pragma unroll
        for (int a = 0; a < 2; ++a)
#pragma unroll
            for (int b = 0; b < 2; ++b)
#pragma unroll
                for (int m = 0; m < 4; ++m)
#pragma unroll
                    for (int n = 0; n < 2; ++n) acc[a][b][m][n] = (f32x4){0.f, 0.f, 0.f, 0.f};
        cur = nxt; cA = nA; cB = nB; ++ui;
        if constexpr (ALIGN_EPI) { if (wr == 1) PG8_BAR; }
    }
    PG8_WAIT_V(0);
    if constexpr (!ALIGN_EPI) { if (wr == 0) PG8_BAR; }
    PG8_BAR;
    if constexpr (Epi::AFTER_DRAIN) { E.fused(acc, cur, wr, wc, fr, fq, lds, wid, lane); S.done(cur); }
#undef PG8_SA
#undef PG8_SB
#undef PG8_STAGE
#undef PG8_LDA
#undef PG8_LDB
#undef PG8_MMA
#undef PG8_WAIT_V
#undef PG8_WAIT_L
#undef PG8_BAR
#undef PG8_SCHED
}
}

#define LAS __attribute__((address_space(3)))
#define GAS __attribute__((address_space(1)))
typedef unsigned char uchar;
typedef pg8::bf16_t bf16_t;
typedef pg8::bf16x8 bf16x8;
typedef pg8::f32x4 f32x4;
typedef pg8::u32x4 u32x4;
typedef unsigned u32x2 __attribute__((ext_vector_type(2)));
typedef float f32x2 __attribute__((ext_vector_type(2)));
typedef float f32x16 __attribute__((ext_vector_type(16)));
typedef __bf16 bf16x2_t __attribute__((ext_vector_type(2)));

constexpr int NB = 16, SEQ = 4096, T = NB * SEQ, DM = 1024, FF = 2816, MEML = 256, TM = NB * MEML;
constexpr int NPROJ = 3328, PLD = 3072;
constexpr int PC_Z = 0, PC_X = 512, PC_B = 1024, PC_C = 1280, PC_Q = 1536, PC_K = 2048, PC_V = 2560;
constexpr float EPS = 1e-5f, LOG2E = 1.4426950408889634f;
constexpr float LAMBDA_INIT = 0.2f;

constexpr size_t MiB = 1u << 20;
constexpr size_t WS_CTL = 0, WS_ROPE = 1 * MiB, WS_SS0 = 2 * MiB, WS_SS1 = 6 * MiB, WS_SS2 = 10 * MiB, WS_SS3 = 14 * MiB, WS_SS4 = 18 * MiB, WS_SSM = 22 * MiB,
                 WS_DT = 23 * MiB, WS_WGU1 = 27 * MiB, WS_WD1 = 38 * MiB, WS_WIN = 44 * MiB, WS_WOUT = 51 * MiB, WS_WQ = 53 * MiB, WS_WKV = 55 * MiB, WS_WO = 59 * MiB,
                 WS_WGU2 = 61 * MiB, WS_WD2 = 72 * MiB, WS_MEMB = 78 * MiB, WS_KVX = 86 * MiB, WS_VTX = 102 * MiB, WS_VT = 110 * MiB, WS_XB = 174 * MiB,
                 WS_YMIX = 302 * MiB, WS_YFB = 430 * MiB, WS_BIG = 558 * MiB, WS_END = 942 * MiB;
constexpr int LDS_BYTES = 147456, PTAB_OFF = LDS_BYTES - 512, LDS_PTAB_ABS = PTAB_OFF;

__device__ __forceinline__ const GAS float* lds_inp(int k) {
    const LAS unsigned long long* ptab = (const LAS unsigned long long*)(uintptr_t)0; const unsigned long long v = *(const LAS unsigned long long*)((const LAS uchar*)ptab + LDS_PTAB_ABS + 8 * k);
    return (const GAS float*)(((unsigned long long)(unsigned)__builtin_amdgcn_readfirstlane((int)(v >> 32)) << 32) | (unsigned long long)(unsigned)__builtin_amdgcn_readfirstlane((int)(v & 0xffffffffull)));
}
__device__ __forceinline__ int opaque_tid() { int t = threadIdx.x; asm volatile("" : "+v"(t)); return t; }
__device__ __forceinline__ unsigned cvtpk(float lo, float hi) { f32x2 v = {lo, hi}; bf16x2_t b = __builtin_convertvector(v, bf16x2_t); return __builtin_bit_cast(unsigned, b); }
__device__ __forceinline__ float bflo(unsigned w) { return __uint_as_float(w << 16); }
__device__ __forceinline__ float bfhi(unsigned w) { return __uint_as_float(w & 0xffff0000u); }
__device__ __forceinline__ float wave_sum(float v) {
#pragma unroll
    for (int o = 1; o < 64; o <<= 1) v += __shfl_xor(v, o);
    return v;
}
__device__ __forceinline__ float fast_exp2(float x) { return __builtin_amdgcn_exp2f(x); }
__device__ __forceinline__ float silu_f(float g) { return g * __builtin_amdgcn_rcpf(1.0f + fast_exp2(-LOG2E * g)); }
__device__ __forceinline__ float row_rs(const GAS float* part, int row) {
    const GAS f32x4* p = (const GAS f32x4*)(part + (size_t)row * 16);
    const f32x4 a = p[0], b = p[1], c = p[2], d = p[3];
    const float s = (((a[0] + a[1]) + (a[2] + a[3])) + ((b[0] + b[1]) + (b[2] + b[3]))) + (((c[0] + c[1]) + (c[2] + c[3])) + ((d[0] + d[1]) + (d[2] + d[3])));
    return 1.0f / sqrtf(s * (1.0f / 1024.0f) + EPS);
}

constexpr int RS_OFF = 131072;
__device__ __forceinline__ void rows_rs8(int pm, int rloc0, float scale, float (&rs)[8]) {
    const LAS int* pid = (const LAS int*)((const LAS uchar*)(uintptr_t)0 + RS_OFF + 4096);
    const int slot = (pid[0] == pm) ? 0 : (pid[1] == pm) ? 1 : (pid[2] == pm) ? 2 : 3;
    const LAS float* t = (const LAS float*)((const LAS uchar*)(uintptr_t)0 + RS_OFF) + slot * 256 + rloc0;
#pragma unroll
    for (int i = 0; i < 8; ++i) rs[i] = t[(i >> 2) * 128 + (i & 3) * 16] * scale;
}
struct EpiBf16RS {
    static constexpr bool PERM = true, AFTER_DRAIN = false;
    const GAS float* part; float scale; GAS bf16_t* O; int ldc;
    __device__ __forceinline__ void operator()(const f32x4 (&acc)[2][2][4][2], const pg8::Unit& u, int wr, int wc, int fr, int fq) const {
        const int row0 = u.pm * 256 + wr * 64 + fr, col0 = u.pn * 256 + wc * 32 + 8 * fq;
        float rs8[8]; rows_rs8(u.pm, wr * 64 + fr, scale, rs8);
#pragma unroll
        for (int ai = 0; ai < 2; ++ai)
#pragma unroll
            for (int m = 0; m < 4; ++m) {
                const int row = row0 + ai * 128 + m * 16; const float rs = rs8[ai * 4 + m]; GAS bf16_t* rp = O + (size_t)row * ldc + col0;
#pragma unroll
                for (int bj = 0; bj < 2; ++bj) { const f32x4 v0 = acc[ai][bj][m][0] * rs, v1 = acc[ai][bj][m][1] * rs;
                    u32x4 w; w.x = cvtpk(v0[0], v0[1]); w.y = cvtpk(v0[2], v0[3]); w.z = cvtpk(v1[0], v1[1]); w.w = cvtpk(v1[2], v1[3]);
                    __builtin_nontemporal_store(w, (GAS u32x4*)(rp + bj * 128)); }
            }
    }
};
struct EpiSwiGLU {
    static constexpr bool PERM = true, AFTER_DRAIN = false;
    const GAS float* part; GAS bf16_t* U;
    __device__ __forceinline__ void operator()(const f32x4 (&acc)[2][2][4][2], const pg8::Unit& u, int wr, int wc, int fr, int fq) const {
        const int row0 = u.pm * 256 + wr * 64 + fr, col0 = u.pn * 128 + wc * 32 + 8 * fq;
        float rs8[8]; rows_rs8(u.pm, wr * 64 + fr, 1.0f, rs8);
#pragma unroll
        for (int ai = 0; ai < 2; ++ai)
#pragma unroll
            for (int m = 0; m < 4; ++m) {
                const int row = row0 + ai * 128 + m * 16; const float rs = rs8[ai * 4 + m];
                float h[8];
#pragma unroll
                for (int n = 0; n < 2; ++n)
#pragma unroll
                    for (int e = 0; e < 4; ++e) { const float g = acc[ai][0][m][n][e] * rs, up = acc[ai][1][m][n][e] * rs; h[4 * n + e] = silu_f(g) * up; }
                u32x4 w; w.x = cvtpk(h[0], h[1]); w.y = cvtpk(h[2], h[3]); w.z = cvtpk(h[4], h[5]); w.w = cvtpk(h[6], h[7]);
                __builtin_nontemporal_store(w, (GAS u32x4*)(U + (size_t)row * FF + col0));
            }
    }
};
struct EpiResidual {
    static constexpr bool PERM = true, AFTER_DRAIN = false;
    float alpha; GAS bf16_t* xb; GAS float* part;
    __device__ __forceinline__ void operator()(const f32x4 (&acc)[2][2][4][2], const pg8::Unit& u, int wr, int wc, int fr, int fq) const {
        const int row0 = u.pm * 256 + wr * 64 + fr, col0 = u.pn * 256 + wc * 32 + 8 * fq;
#pragma unroll
        for (int ai = 0; ai < 2; ++ai)
#pragma unroll
            for (int m = 0; m < 4; ++m) {
                const int row = row0 + ai * 128 + m * 16; float ss = 0.f;
#pragma unroll
                for (int bj = 0; bj < 2; ++bj) { const size_t off = (size_t)row * DM + col0 + bj * 128;
                    const u32x4 rv = *(const GAS u32x4*)(xb + off);
                    f32x4 v0, v1; v0[0] = bflo(rv.x); v0[1] = bfhi(rv.x); v0[2] = bflo(rv.y); v0[3] = bfhi(rv.y); v1[0] = bflo(rv.z); v1[1] = bfhi(rv.z); v1[2] = bflo(rv.w); v1[3] = bfhi(rv.w);
                    v0 = v0 + acc[ai][bj][m][0] * alpha; v1 = v1 + acc[ai][bj][m][1] * alpha;
                    u32x4 w; w.x = cvtpk(v0[0], v0[1]); w.y = cvtpk(v0[2], v0[3]); w.z = cvtpk(v1[0], v1[1]); w.w = cvtpk(v1[2], v1[3]); __builtin_nontemporal_store(w, (GAS u32x4*)(xb + off));
                    ss += ((v0[0] * v0[0] + v0[1] * v0[1]) + (v0[2] * v0[2] + v0[3] * v0[3])) + ((v1[0] * v1[0] + v1[1] * v1[1]) + (v1[2] * v1[2] + v1[3] * v1[3])); }
                ss += __shfl_xor(ss, 16); ss += __shfl_xor(ss, 32);
                if (fq == 0) part[(size_t)row * 16 + u.pn * 4 + wc] = ss;
            }
    }
};
struct EpiProj {
    static constexpr bool PERM = true, AFTER_DRAIN = false;
    const GAS float* part; GAS bf16_t* P; GAS float* DT; const GAS float* cs; const GAS float* sn; const GAS float* dtb_f; const GAS float* dtb_b;
    __device__ __forceinline__ void operator()(const f32x4 (&acc)[2][2][4][2], const pg8::Unit& u, int wr, int wc, int fr, int fq) const {
        const int pn = u.pn; const int row0 = u.pm * 256 + wr * 64 + fr;
        const bool isq = (pn == 6 || pn == 7), isk = (pn == 8 || pn == 9), rope = (isq || isk) && ((wc & 1) == 0);
        const float qs = isq ? 0.125f * LOG2E : 1.0f; const float sgn = (fq == 0) ? -1.f : 1.f;
        float rs8[8]; rows_rs8(u.pm, wr * 64 + fr, qs, rs8);
        if (pn == 12) {
            if (wc == 0 && fq < 2) {
                const GAS float* bias = (fq == 0) ? dtb_f : dtb_b;
#pragma unroll
                for (int ai = 0; ai < 2; ++ai)
#pragma unroll
                    for (int m = 0; m < 4; ++m) { const int row = row0 + ai * 128 + m * 16; const float rs = rs8[ai * 4 + m];
#pragma unroll
                        for (int n = 0; n < 2; ++n) { f32x4 o;
#pragma unroll
                            for (int e = 0; e < 4; ++e) { const float x = acc[ai][0][m][n][e] * rs + bias[4 * n + e]; o[e] = x > 20.f ? x : log1pf(__expf(x)); }
                            *(GAS f32x4*)(DT + (size_t)row * 16 + 8 * fq + 4 * n) = o; } }
            }
            return;
        }
        const int col0 = pn * 256 + wc * 32 + 8 * fq;
#pragma unroll
        for (int ai = 0; ai < 2; ++ai)
#pragma unroll
            for (int m = 0; m < 4; ++m) {
                const int row = row0 + ai * 128 + m * 16; const float rs = rs8[ai * 4 + m]; const int pos = row & (SEQ - 1);
                GAS bf16_t* rp = P + (size_t)row * PLD + col0;
#pragma unroll
                for (int bj = 0; bj < 2; ++bj) { f32x4 v0 = acc[ai][bj][m][0], v1 = acc[ai][bj][m][1];
                    if (rope) { f32x4 p0, p1;
#pragma unroll
                        for (int e = 0; e < 4; ++e) { p0[e] = __shfl_xor(v0[e], 16); p1[e] = __shfl_xor(v1[e], 16); }
                        if (fq < 2) { const f32x4 c0 = *(const GAS f32x4*)(cs + pos * 8), c1 = *(const GAS f32x4*)(cs + pos * 8 + 4), s0 = *(const GAS f32x4*)(sn + pos * 8), s1 = *(const GAS f32x4*)(sn + pos * 8 + 4);
                            v0 = v0 * c0 + p0 * s0 * sgn; v1 = v1 * c1 + p1 * s1 * sgn; } }
                    v0 = v0 * rs; v1 = v1 * rs;
                    u32x4 w; w.x = cvtpk(v0[0], v0[1]); w.y = cvtpk(v0[2], v0[3]); w.z = cvtpk(v1[0], v1[1]); w.w = cvtpk(v1[2], v1[3]);
                    __builtin_nontemporal_store(w, (GAS u32x4*)(rp + bj * 128)); }
            }
    }
};
struct EpiAny {
    static constexpr bool PERM = true, AFTER_DRAIN = false;
    int kind; GAS unsigned char* ws; float scale; unsigned part_off, o_off, opart_off; int ldc;
    __device__ __forceinline__ void operator()(const f32x4 (&acc)[2][2][4][2], const pg8::Unit& u, int wr, int wc, int fr, int fq) const {
        if (kind == 0) { EpiBf16RS e{(const GAS float*)(ws + part_off), scale, (GAS bf16_t*)(ws + o_off), ldc}; e(acc, u, wr, wc, fr, fq); }
        else if (kind == 1) { EpiSwiGLU e{(const GAS float*)(ws + part_off), (GAS bf16_t*)(ws + o_off)}; e(acc, u, wr, wc, fr, fq); }
        else if (kind == 2) { EpiResidual e{scale, (GAS bf16_t*)(ws + WS_XB), (GAS float*)(ws + opart_off)}; e(acc, u, wr, wc, fr, fq); }
        else { EpiProj e{(const GAS float*)(ws + part_off), (GAS bf16_t*)(ws + o_off), (GAS float*)(ws + WS_DT), (const GAS float*)(ws + WS_ROPE), (const GAS float*)(ws + WS_ROPE) + SEQ * 8, lds_inp(10), lds_inp(11)}; e(acc, u, wr, wc, fr, fq); }
    }
};
struct GJob { const GAS bf16_t* A; const GAS bf16_t* Bt; int M, N, K; EpiAny E; };
template <class Epi> __device__ __forceinline__ void run_gemm(LAS uchar* lds, const GAS bf16_t* A, const GAS bf16_t* Bt, int M, int N, int K, const Epi& E, const GAS float* part) {
    pg8::Gemm g{(const bf16_t*)A, (const bf16_t*)Bt, M, N, K}; pg8::StaticOrder S; S.init(M, N, (int)gridDim.x, (int)blockIdx.x);
    if (part) {
        int p0 = -1, p1 = -1, p2 = -1, p3 = -1; pg8::Unit u;
        for (int i = 0; S.next(i, u); ++i) { const int pm = u.pm; if (pm == p0 || pm == p1 || pm == p2 || pm == p3) continue; if (p0 < 0) p0 = pm; else if (p1 < 0) p1 = pm; else if (p2 < 0) p2 = pm; else p3 = pm; }
        const int tid = opaque_tid(), r = tid >> 1, hf = tid & 1;
        LAS float* rsT = (LAS float*)(lds + RS_OFF); LAS int* pid = (LAS int*)(lds + RS_OFF + 4096);
        f32x4 v[4][2];
#pragma unroll
        for (int sl = 0; sl < 4; ++sl) { const int pm = sl == 0 ? p0 : sl == 1 ? p1 : sl == 2 ? p2 : p3; const int pmc = pm < 0 ? 0 : pm;
            const GAS f32x4* src = (const GAS f32x4*)(part + ((size_t)pmc * 256 + r) * 16 + 8 * hf); v[sl][0] = src[0]; v[sl][1] = src[1]; }
#pragma unroll
        for (int sl = 0; sl < 4; ++sl) { float sm = ((v[sl][0][0] + v[sl][0][1]) + (v[sl][0][2] + v[sl][0][3])) + ((v[sl][1][0] + v[sl][1][1]) + (v[sl][1][2] + v[sl][1][3]));
            sm += __shfl_xor(sm, 1); if (hf == 0) rsT[sl * 256 + r] = 1.0f / sqrtf(sm * (1.0f / 1024.0f) + EPS); }
        if (tid == 0) { pid[0] = p0; pid[1] = p1; pid[2] = p2; pid[3] = p3; }
        __syncthreads();
    }
    pg8::gemm_phase<Epi, pg8::StaticOrder, true, true>(lds, g, S, E);
    __syncthreads();
}

__device__ __forceinline__ int map_row(int kind, int n) {
    if (kind == 1) return (n >> 7) * 256 + (n & 127);
    if (kind == 2) return (n >> 7) * 256 + 128 + (n & 127);
    if (kind == 3) return n < 1536 ? n : (n < 1552 ? 3072 + (n - 1536) : n - 16);
    return n;
}
__device__ __forceinline__ void p0_transpose_item(const GAS float* W, int K, int N, GAS bf16_t* WT, int kind, const GAS float* g, LAS float* scr, int item, int lane) {
    const int nblk = (N + 31) >> 5, kb = item / nblk, nb = item - kb * nblk, k0 = 64 * kb, n0 = 32 * nb;
    const int ncol = n0 + (lane & 31); const bool valid = ncol < N;
    float wv[32];
#pragma unroll
    for (int i = 0; i < 32; ++i) { const int kk = 2 * i + (lane >> 5); wv[i] = valid ? W[(size_t)(k0 + kk) * N + ncol] : 0.f; }
    if (g) {
        float gv[32];
#pragma unroll
        for (int i = 0; i < 32; ++i) gv[i] = g[k0 + 2 * i + (lane >> 5)];
#pragma unroll
        for (int i = 0; i < 32; ++i) wv[i] *= gv[i];
    }
#pragma unroll
    for (int i = 0; i < 32; ++i) { const int kk = 2 * i + (lane >> 5); scr[kk * 33 + (lane & 31)] = wv[i]; }
    asm volatile("s_waitcnt lgkmcnt(0)" ::: "memory");
    const int c = lane & 7;
#pragma unroll
    for (int j = 0; j < 4; ++j) { const int n = (lane >> 3) + 8 * j; const LAS float* s = scr + (8 * c) * 33 + n;
        if (n0 + n < N) { u32x4 o; o.x = cvtpk(s[0 * 33], s[1 * 33]); o.y = cvtpk(s[2 * 33], s[3 * 33]); o.z = cvtpk(s[4 * 33], s[5 * 33]); o.w = cvtpk(s[6 * 33], s[7 * 33]);
            *(GAS u32x4*)(WT + (size_t)map_row(kind, n0 + n) * K + k0 + 8 * c) = o; } }
    asm volatile("s_waitcnt lgkmcnt(0)" ::: "memory");
}
__device__ __forceinline__ void rows4_to_bf16_ss(const GAS float* x, GAS bf16_t* o, GAS float* part, int row, int lane) {
    f32x4 v[4][4]; float sm[4];
#pragma unroll
    for (int r = 0; r < 4; ++r)
#pragma unroll
        for (int j = 0; j < 4; ++j) v[r][j] = ((const GAS f32x4*)(x + (size_t)(row + r) * DM))[lane + 64 * j];
#pragma unroll
    for (int r = 0; r < 4; ++r) { float a = 0.f;
#pragma unroll
        for (int j = 0; j < 4; ++j) a += (v[r][j][0] * v[r][j][0] + v[r][j][1] * v[r][j][1]) + (v[r][j][2] * v[r][j][2] + v[r][j][3] * v[r][j][3]);
        sm[r] = wave_sum(a); }
#pragma unroll
    for (int r = 0; r < 4; ++r) {
#pragma unroll
        for (int j = 0; j < 4; ++j) { u32x2 w; w.x = cvtpk(v[r][j][0], v[r][j][1]); w.y = cvtpk(v[r][j][2], v[r][j][3]); ((GAS u32x2*)(o + (size_t)(row + r) * DM))[lane + 64 * j] = w; }
        if (lane < 16) part[(size_t)(row + r) * 16 + lane] = (lane == 0) ? sm[r] : 0.f; }
}
__device__ __forceinline__ void rope_entry(int idx, GAS float* cs, GAS float* sn) {
    const int pos = idx >> 3, i = idx & 7;
    const float invf = (i == 0) ? 1.0f : (i == 1) ? 0.193922758102417f : (i == 2) ? 0.03760603070259094f : (i == 3) ? 0.00729266507551074f : (i == 4) ? 0.001414213445968926f
                     : (i == 5) ? 0.00027424818836152554f : (i == 6) ? 5.318296462064609e-05f : 1.0313385246263351e-05f;
    const float angf = (float)pos * invf;
    const double x = (double)angf; const double kq = rint(x * 0.6366197723675814);
    double r = fma(-kq, 1.5707963267948966, x); r = fma(-kq, 6.123233995736766e-17, r);
    const int q = ((int)kq) & 3; const double r2 = r * r;
    const double s = r * (1.0 + r2 * (-1.0 / 6 + r2 * (1.0 / 120 + r2 * (-1.0 / 5040 + r2 * (1.0 / 362880 + r2 * (-1.0 / 39916800 + r2 * (1.0 / 6227020800.0)))))));
    const double c = 1.0 + r2 * (-0.5 + r2 * (1.0 / 24 + r2 * (-1.0 / 720 + r2 * (1.0 / 40320 + r2 * (-1.0 / 3628800 + r2 * (1.0 / 479001600.0 + r2 * (-1.0 / 87178291200.0)))))));
    const double co = (q == 0) ? c : (q == 1) ? -s : (q == 2) ? -c : s;
    const double si = (q == 0) ? s : (q == 1) ? c : (q == 2) ? -s : -c;
    cs[idx] = (float)co; sn[idx] = (float)si;
}

__device__ __forceinline__ void transpose64(const GAS bf16_t* src, int sp, GAS bf16_t* dst, int dp, LAS uchar* scr, int lane) {
#pragma unroll
    for (int i = 0; i < 8; ++i) { const int r = i * 8 + (lane >> 3), c8 = lane & 7; const u32x4 v = *(const GAS u32x4*)(src + (size_t)r * sp + c8 * 8);
        LAS unsigned* w = (LAS unsigned*)(scr + r * 132 + c8 * 16); w[0] = v.x; w[1] = v.y; w[2] = v.z; w[3] = v.w; }
    asm volatile("s_waitcnt lgkmcnt(0)" ::: "memory");
#pragma unroll
    for (int i = 0; i < 8; ++i) { const int c = i * 8 + (lane >> 3), r8 = lane & 7; unsigned e[8];
#pragma unroll
        for (int j = 0; j < 8; ++j) e[j] = *(const LAS unsigned short*)(scr + (r8 * 8 + j) * 132 + c * 2);
        u32x4 o; o.x = e[0] | (e[1] << 16); o.y = e[2] | (e[3] << 16); o.z = e[4] | (e[5] << 16); o.w = e[6] | (e[7] << 16);
        __builtin_nontemporal_store(o, (GAS u32x4*)(dst + (size_t)c * dp + r8 * 8)); }
    asm volatile("s_waitcnt lgkmcnt(0)" ::: "memory");
}
__device__ __forceinline__ void conv_item(const GAS bf16_t* P, const GAS float* cw, const GAS float* cb, GAS bf16_t* XC, GAS bf16_t* XT, GAS bf16_t* BT, LAS uchar* scr, int item, int lane) {
    unsigned oz = 0u; asm volatile("" : "+v"(oz));
    const int cb16 = item & 15, tt = item >> 4, tok0 = tt * 64, s0 = tok0 & (SEQ - 1), b = tok0 >> 12, ci = s0 >> 7, l0 = s0 & 127;
    const int c8 = lane & 7, tb = lane >> 3, ch = cb16 * 64 + c8 * 8;
    float w[5][8], bias[8];
#pragma unroll
    for (int k = 0; k < 5; ++k) { const f32x4 a = *(const GAS f32x4*)(cw + k * 1024 + ch), bq = *(const GAS f32x4*)(cw + k * 1024 + ch + 4);
#pragma unroll
        for (int e = 0; e < 4; ++e) { w[k][e] = a[e]; w[k][4 + e] = bq[e]; } }
    { const f32x4 a = *(const GAS f32x4*)(cb + ch), bq = *(const GAS f32x4*)(cb + ch + 4);
#pragma unroll
      for (int e = 0; e < 4; ++e) { bias[e] = a[e]; bias[4 + e] = bq[e]; } }
    const int sb = s0 + tb * 8;
    const GAS bf16_t* src = P + (size_t)(tok0 + tb * 8) * PLD + PC_X + ch;
    float win[5][8];
#pragma unroll
    for (int j = 0; j < 4; ++j) { const int sq = sb + j - 2; u32x4 v = {oz, oz, oz, oz}; if (sq >= 0 && sq < SEQ) v = *(const GAS u32x4*)(src + (ptrdiff_t)(j - 2) * PLD);
        win[j][0] = bflo(v.x); win[j][1] = bfhi(v.x); win[j][2] = bflo(v.y); win[j][3] = bfhi(v.y); win[j][4] = bflo(v.z); win[j][5] = bfhi(v.z); win[j][6] = bflo(v.w); win[j][7] = bfhi(v.w); }
#pragma unroll
    for (int i = 0; i < 8; ++i) {
        { const int sq = sb + i + 2; u32x4 v = {oz, oz, oz, oz}; if (sq < SEQ) v = *(const GAS u32x4*)(src + (ptrdiff_t)(i + 2) * PLD);
          float* d = win[(i + 4) % 5];
          d[0] = bflo(v.x); d[1] = bfhi(v.x); d[2] = bflo(v.y); d[3] = bfhi(v.y); d[4] = bflo(v.z); d[5] = bfhi(v.z); d[6] = bflo(v.w); d[7] = bfhi(v.w); }
        float o[8];
#pragma unroll
        for (int e = 0; e < 8; ++e) { float acc = bias[e];
#pragma unroll
            for (int k = 0; k < 5; ++k) acc += w[k][e] * win[(i + k) % 5][e];
            o[e] = silu_f(acc); }
        u32x4 ov; ov.x = cvtpk(o[0], o[1]); ov.y = cvtpk(o[2], o[3]); ov.z = cvtpk(o[4], o[5]); ov.w = cvtpk(o[6], o[7]);
        __builtin_nontemporal_store(ov, (GAS u32x4*)(XC + (size_t)(tok0 + tb * 8 + i) * 1024 + ch));
        LAS unsigned* wq = (LAS unsigned*)(scr + (tb * 8 + i) * 132 + c8 * 16); wq[0] = ov.x; wq[1] = ov.y; wq[2] = ov.z; wq[3] = ov.w;
    }
    asm volatile("s_waitcnt lgkmcnt(0)" ::: "memory");
    if (cb16 < 12) {
        GAS bf16_t* dst = (cb16 < 8) ? XT + ((size_t)((b * 32 + ci) * 8 + cb16) * 64) * 128 + l0
                                 : BT + ((size_t)((b * 32 + ci) * 2 + ((cb16 - 8) >> 1)) * 128 + ((cb16 - 8) & 1) * 64) * 128 + l0;
#pragma unroll
        for (int i = 0; i < 8; ++i) { const int c = i * 8 + (lane >> 3), r8 = lane & 7; unsigned e[8];
#pragma unroll
            for (int j = 0; j < 8; ++j) e[j] = *(const LAS unsigned short*)(scr + (r8 * 8 + j) * 132 + c * 2);
            u32x4 ov; ov.x = e[0] | (e[1] << 16); ov.y = e[2] | (e[3] << 16); ov.z = e[4] | (e[5] << 16); ov.w = e[6] | (e[7] << 16);
            __builtin_nontemporal_store(ov, (GAS u32x4*)(dst + (size_t)c * 128 + r8 * 8)); }
    }
    asm volatile("s_waitcnt lgkmcnt(0)" ::: "memory");
}

__device__ __forceinline__ float dpp_sum8(float v) {
    v += __builtin_bit_cast(float, __builtin_amdgcn_update_dpp(0, __builtin_bit_cast(int, v), 0xB1, 0xF, 0xF, true));
    v += __builtin_bit_cast(float, __builtin_amdgcn_update_dpp(0, __builtin_bit_cast(int, v), 0x4E, 0xF, 0xF, true));
    v += __builtin_bit_cast(float, __builtin_amdgcn_update_dpp(0, __builtin_bit_cast(int, v), 0x141, 0xF, 0xF, true));
    return v;
}
__device__ __forceinline__ void ssd_item(LAS uchar* lds, int b, int h, int dir, const GAS bf16_t* XC, const GAS float* DT, float Aneg, GAS bf16_t* Y) {
    const int tid = opaque_tid(), p = tid >> 3, nq = tid & 7, g = h >> 2;
    LAS float* sB = (LAS float*)lds;
    LAS float* sC = sB + 64 * 128;
    LAS float* sX = sC + 64 * 128;
    LAS float* sY = sX + 64 * 64;
    LAS float* sDt = sY + 64 * 64;
    LAS float* sE = sDt + 64;
    float st[16];
#pragma unroll
    for (int k = 0; k < 16; ++k) st[k] = 0.f;
    u32x4 rb[2], rc[2], rx; float rdt = 0.f;
    const size_t tokb = (size_t)b * SEQ;
#define SSD_LOAD(blk) do { const int t0_ = dir ? (SEQ - 64 - (blk) * 64) : (blk) * 64; \
        _Pragma("unroll") for (int i_ = 0; i_ < 2; ++i_) { const int id_ = tid + 512 * i_, r_ = id_ >> 4, c_ = id_ & 15; const GAS bf16_t* s_ = XC + (tokb + t0_ + r_) * 1024 + 512 + g * 128 + c_ * 8; \
            rb[i_] = *(const GAS u32x4*)s_; rc[i_] = *(const GAS u32x4*)(s_ + 256); } \
        { const int r_ = tid >> 3, c_ = tid & 7; rx = *(const GAS u32x4*)(XC + (tokb + t0_ + r_) * 1024 + h * 64 + c_ * 8); } \
        if (tid < 64) rdt = DT[(tokb + t0_ + tid) * 16 + dir * 8 + h]; } while (0)
#define SSD_ST8(dst, v) do { f32x4 a_, b_; a_[0] = bflo((v).x); a_[1] = bfhi((v).x); a_[2] = bflo((v).y); a_[3] = bfhi((v).y); b_[0] = bflo((v).z); b_[1] = bfhi((v).z); b_[2] = bflo((v).w); b_[3] = bfhi((v).w); \
        *(LAS f32x4*)(dst) = a_; *(LAS f32x4*)((dst) + 4) = b_; } while (0)
#define SSD_STORE() do { \
        _Pragma("unroll") for (int i_ = 0; i_ < 2; ++i_) { const int id_ = tid + 512 * i_, r_ = id_ >> 4, c_ = id_ & 15; SSD_ST8(sB + r_ * 128 + c_ * 8, rb[i_]); SSD_ST8(sC + r_ * 128 + c_ * 8, rc[i_]); } \
        { const int r_ = tid >> 3, c_ = tid & 7; SSD_ST8(sX + r_ * 64 + c_ * 8, rx); } \
        if (tid < 64) { sDt[tid] = rdt; sE[tid] = __expf(rdt * Aneg); } } while (0)
    SSD_LOAD(0); SSD_STORE();
    __syncthreads();
    for (int blk = 0; blk < SEQ / 64; ++blk) {
        if (blk + 1 < SEQ / 64) SSD_LOAD(blk + 1);
        for (int j = 0; j < 64; ++j) {
            const int i = dir ? 63 - j : j;
            const float e = sE[i], xdt = sX[i * 64 + p] * sDt[i];
            const LAS f32x4* bp = (const LAS f32x4*)(sB + i * 128 + nq * 16); const LAS f32x4* cp = (const LAS f32x4*)(sC + i * 128 + nq * 16);
            float acc = 0.f;
#pragma unroll
            for (int q = 0; q < 4; ++q) { const f32x4 bv = bp[q], cv = cp[q];
#pragma unroll
                for (int k = 0; k < 4; ++k) { st[4 * q + k] = st[4 * q + k] * e + xdt * bv[k]; acc += cv[k] * st[4 * q + k]; } }
            acc = dpp_sum8(acc);
            if (nq == 0) sY[i * 64 + p] = acc;
        }
        __syncthreads();
        { const int t0 = dir ? (SEQ - 64 - blk * 64) : blk * 64; const int r = tid >> 3, c = tid & 7; const LAS f32x4* yp = (const LAS f32x4*)(sY + r * 64 + c * 8); const f32x4 a = yp[0], bq = yp[1];
          u32x4 w; w.x = cvtpk(a[0], a[1]); w.y = cvtpk(a[2], a[3]); w.z = cvtpk(bq[0], bq[1]); w.w = cvtpk(bq[2], bq[3]);
          *(GAS u32x4*)(Y + (tokb + t0 + r) * 512 + h * 64 + c * 8) = w; }
        if (blk + 1 < SEQ / 64) SSD_STORE();
        __syncthreads();
    }
#undef SSD_LOAD
#undef SSD_ST8
#undef SSD_STORE
}

__device__ __forceinline__ float max3f(float a, float b, float c) { float r; asm("v_max3_f32 %0, %1, %2, %3" : "=v"(r) : "v"(a), "v"(b), "v"(c)); return r; }
__device__ __forceinline__ int crow(int r, int hi) { return (r & 3) + 8 * (r >> 2) + 4 * hi; }
#define MFMA32(a, b, c) __builtin_amdgcn_mfma_f32_32x32x16_bf16((a), (b), (c), 0, 0, 0)
constexpr int SS_ROW = 272, SS_B = 0, SS_BT = 34816, SS_C = 69632, SS_XT = 104448, SS_S = 121856, SS_SC = 139264, SS_SCB = 2064;
static_assert(SS_SC + 2 * SS_SCB <= PTAB_OFF, "SSD LDS map");
__device__ __forceinline__ void ssd_item2(LAS uchar* lds, int b, int h, int dir, const GAS bf16_t* XC, const GAS bf16_t* BT, const GAS bf16_t* XT, const GAS float* DT, float Aneg, GAS bf16_t* Y) {
    const int tid = opaque_tid(), lane = tid & 63, wid = __builtin_amdgcn_readfirstlane(tid >> 6), l31 = lane & 31, hi = lane >> 5, g = h >> 2;
    const int lt = wid < 4 ? wid : 7 - wid, pt = wid >> 2;
    f32x16 S;
#pragma unroll
    for (int r = 0; r < 16; ++r) S[r] = 0.f;
    u32x4 rB[4], rC[4], rT[4], rX[2]; float dt0 = 0.f, dt1 = 0.f;
#define S2_CI(cp) (dir ? 31 - (cp) : (cp))
#define S2_LOAD(cp) do { const int ci_ = S2_CI(cp); const size_t tok0_ = (size_t)b * SEQ + ci_ * 128; \
        _Pragma("unroll") for (int i_ = 0; i_ < 4; ++i_) { const int id_ = tid + 512 * i_, r_ = id_ >> 4, c_ = id_ & 15; const GAS bf16_t* s_ = XC + (tok0_ + r_) * 1024 + 512 + g * 128 + c_ * 8; \
            rB[i_] = *(const GAS u32x4*)s_; rC[i_] = *(const GAS u32x4*)(s_ + 256); \
            rT[i_] = *(const GAS u32x4*)(BT + ((size_t)((b * 32 + ci_) * 2 + g) * 128 + r_) * 128 + c_ * 8); } \
        _Pragma("unroll") for (int i_ = 0; i_ < 2; ++i_) { const int id_ = tid + 512 * i_, r_ = id_ >> 4, c_ = id_ & 15; rX[i_] = *(const GAS u32x4*)(XT + ((size_t)((b * 32 + ci_) * 8 + h) * 64 + r_) * 128 + c_ * 8); } } while (0)
#define S2_STORE() do { \
        _Pragma("unroll") for (int i_ = 0; i_ < 4; ++i_) { const int id_ = tid + 512 * i_, r_ = id_ >> 4, c_ = id_ & 15; \
            *(LAS u32x4*)(lds + SS_B + r_ * SS_ROW + c_ * 16) = rB[i_]; *(LAS u32x4*)(lds + SS_C + r_ * SS_ROW + c_ * 16) = rC[i_]; *(LAS u32x4*)(lds + SS_BT + r_ * SS_ROW + c_ * 16) = rT[i_]; } \
        _Pragma("unroll") for (int i_ = 0; i_ < 2; ++i_) { const int id_ = tid + 512 * i_, r_ = id_ >> 4, c_ = id_ & 15; *(LAS u32x4*)(lds + SS_XT + r_ * SS_ROW + c_ * 16) = rX[i_]; } } while (0)
#define S2_LOADDT(cp) do { const int ci_ = S2_CI(cp); const size_t tok0_ = (size_t)b * SEQ + ci_ * 128; const int la_ = dir ? 127 - 2 * lane : 2 * lane, lb_ = dir ? 126 - 2 * lane : 2 * lane + 1; \
        dt0 = DT[(tok0_ + la_) * 16 + dir * 8 + h]; dt1 = DT[(tok0_ + lb_) * 16 + dir * 8 + h]; } while (0)
#define S2_SCAN(buf) do { LAS float* sc_ = (LAS float*)(lds + SS_SC + (buf) * SS_SCB); const float a0_ = dt0 * Aneg, a1_ = dt1 * Aneg; float s_ = a0_ + a1_; \
        _Pragma("unroll") for (int o_ = 1; o_ < 64; o_ <<= 1) { const float t_ = __shfl_up(s_, o_); if (lane >= o_) s_ += t_; } \
        const float c1_ = s_, c0_ = s_ - a1_, tot_ = __shfl(s_, 63); const int la_ = dir ? 127 - 2 * lane : 2 * lane, lb_ = dir ? 126 - 2 * lane : 2 * lane + 1; \
        sc_[la_] = c0_; sc_[lb_] = c1_; sc_[128 + la_] = dt0; sc_[128 + lb_] = dt1; sc_[256 + la_] = __expf(tot_ - c0_) * dt0; sc_[256 + lb_] = __expf(tot_ - c1_) * dt1; \
        sc_[384 + la_] = __expf(c0_); sc_[384 + lb_] = __expf(c1_); if (lane == 0) sc_[512] = __expf(tot_); } while (0)
    S2_LOAD(0); S2_LOADDT(0);
    if (wid == 0) S2_SCAN(0);
    S2_LOADDT(1);
    S2_STORE();
    for (int i = tid; i < 64 * SS_ROW / 4; i += 512) ((LAS unsigned*)(lds + SS_S))[i] = 0u;
    __syncthreads();
    for (int cp = 0; cp < 32; ++cp) {
        if (wid == 0 && cp + 1 < 32) S2_SCAN((cp + 1) & 1);
        if (cp + 2 < 32) S2_LOADDT(cp + 2);
        if (cp + 1 < 32) S2_LOAD(cp + 1);
        const LAS float* sc = (const LAS float*)(lds + SS_SC + (cp & 1) * SS_SCB);
        const LAS float* sCum = sc; const LAS float* sDt = sc + 128; const LAS float* sW = sc + 256; const LAS float* sEin = sc + 384;
        bf16x8 cf[8];
#pragma unroll
        for (int k = 0; k < 8; ++k) cf[k] = *(const LAS bf16x8*)(lds + SS_C + (32 * lt + l31) * SS_ROW + (16 * k + 8 * hi) * 2);
        f32x16 Yd;
#pragma unroll
        for (int r = 0; r < 16; ++r) Yd[r] = 0.f;
        const float cum_l = sCum[32 * lt + l31];
        const int st_lo = dir ? lt : 0, st_hi = dir ? 3 : lt;
        for (int st = st_lo; st <= st_hi; ++st) {
            f32x16 G;
#pragma unroll
            for (int r = 0; r < 16; ++r) G[r] = 0.f;
            bf16x8 bfr[4]; f32x4 cs4[2], dt4[2]; u32x4 xw[2];
#pragma unroll
            for (int k = 0; k < 4; ++k) bfr[k] = *(const LAS bf16x8*)(lds + SS_B + (32 * st + l31) * SS_ROW + (16 * k + 8 * hi) * 2);
            cs4[0] = *(const LAS f32x4*)(sCum + 32 * st + 4 * hi); dt4[0] = *(const LAS f32x4*)(sDt + 32 * st + 4 * hi);
#pragma unroll
            for (int j = 0; j < 2; ++j) { const LAS uchar* xa = lds + SS_XT + (32 * pt + l31) * SS_ROW + (32 * st + 16 * j + 4 * hi) * 2;
                const u32x2 lo = *(const LAS u32x2*)xa, hh = *(const LAS u32x2*)(xa + 16); xw[j].x = lo.x; xw[j].y = lo.y; xw[j].z = hh.x; xw[j].w = hh.y; }
            __builtin_amdgcn_sched_barrier(0);
#pragma unroll
            for (int k = 0; k < 4; ++k) G = MFMA32(bfr[k], cf[k], G);
            __builtin_amdgcn_sched_barrier(0);
#pragma unroll
            for (int k = 0; k < 4; ++k) bfr[k] = *(const LAS bf16x8*)(lds + SS_B + (32 * st + l31) * SS_ROW + (16 * (k + 4) + 8 * hi) * 2);
            __builtin_amdgcn_sched_barrier(0);
#pragma unroll
            for (int k = 0; k < 4; ++k) G = MFMA32(bfr[k], cf[k + 4], G);
            const bool diag = (st == lt);
#pragma unroll
            for (int r4 = 0; r4 < 4; ++r4) {
                if (r4 < 3) { cs4[(r4 + 1) & 1] = *(const LAS f32x4*)(sCum + 32 * st + 8 * (r4 + 1) + 4 * hi); dt4[(r4 + 1) & 1] = *(const LAS f32x4*)(sDt + 32 * st + 8 * (r4 + 1) + 4 * hi); }
#pragma unroll
                for (int e = 0; e < 4; ++e) { const int srel = 8 * r4 + 4 * hi + e; float v = G[4 * r4 + e] * __expf(cum_l - cs4[r4 & 1][e]) * dt4[r4 & 1][e];
                    if (diag) { const bool ok = dir ? (srel >= l31) : (srel <= l31); v = ok ? v : 0.f; }
                    G[4 * r4 + e] = v; } }
#pragma unroll
            for (int j = 0; j < 2; ++j) { u32x4 pw; pw.x = cvtpk(G[8 * j], G[8 * j + 1]); pw.y = cvtpk(G[8 * j + 2], G[8 * j + 3]); pw.z = cvtpk(G[8 * j + 4], G[8 * j + 5]); pw.w = cvtpk(G[8 * j + 6], G[8 * j + 7]);
                Yd = MFMA32(__builtin_bit_cast(bf16x8, pw), __builtin_bit_cast(bf16x8, xw[j]), Yd); }
            __builtin_amdgcn_sched_barrier(0);
        }
        f32x16 Yo;
#pragma unroll
        for (int r = 0; r < 16; ++r) Yo[r] = 0.f;
#pragma unroll
        for (int kh = 0; kh < 2; ++kh) { bf16x8 sfr[4];
#pragma unroll
          for (int k = 0; k < 4; ++k) sfr[k] = *(const LAS bf16x8*)(lds + SS_S + (32 * pt + l31) * SS_ROW + (16 * (4 * kh + k) + 8 * hi) * 2);
          __builtin_amdgcn_sched_barrier(0);
#pragma unroll
          for (int k = 0; k < 4; ++k) Yo = MFMA32(cf[4 * kh + k], sfr[k], Yo);
          __builtin_amdgcn_sched_barrier(0); }
        { const size_t tok0 = (size_t)b * SEQ + S2_CI(cp) * 128;
#pragma unroll
          for (int r4 = 0; r4 < 4; ++r4) { const f32x4 e4 = *(const LAS f32x4*)(sEin + 32 * lt + 8 * r4 + 4 * hi);
#pragma unroll
              for (int e = 0; e < 4; ++e) { const float yv = Yd[4 * r4 + e] + e4[e] * Yo[4 * r4 + e];
                  Y[(tok0 + 32 * lt + 8 * r4 + 4 * hi + e) * 512 + h * 64 + 32 * pt + l31] = (bf16_t)(cvtpk(yv, 0.f) & 0xffffu); } } }
        { const float etot = sc[512];
#pragma unroll
          for (int r = 0; r < 16; ++r) S[r] *= etot;
#pragma unroll
          for (int kh = 0; kh < 4; ++kh) { u32x4 xr[2]; f32x4 w0[2], w1[2]; bf16x8 btf[2];
#pragma unroll
              for (int q = 0; q < 2; ++q) { const int k = 2 * kh + q; xr[q] = *(const LAS u32x4*)(lds + SS_XT + (32 * pt + l31) * SS_ROW + (16 * k + 8 * hi) * 2);
                  w0[q] = *(const LAS f32x4*)(sW + 16 * k + 8 * hi); w1[q] = *(const LAS f32x4*)(sW + 16 * k + 8 * hi + 4);
                  btf[q] = *(const LAS bf16x8*)(lds + SS_BT + (32 * lt + l31) * SS_ROW + (16 * k + 8 * hi) * 2); }
              __builtin_amdgcn_sched_barrier(0);
#pragma unroll
              for (int q = 0; q < 2; ++q) { u32x4 xs; xs.x = cvtpk(bflo(xr[q].x) * w0[q][0], bfhi(xr[q].x) * w0[q][1]); xs.y = cvtpk(bflo(xr[q].y) * w0[q][2], bfhi(xr[q].y) * w0[q][3]);
                  xs.z = cvtpk(bflo(xr[q].z) * w1[q][0], bfhi(xr[q].z) * w1[q][1]); xs.w = cvtpk(bflo(xr[q].w) * w1[q][2], bfhi(xr[q].w) * w1[q][3]);
                  S = MFMA32(__builtin_bit_cast(bf16x8, xs), btf[q], S); }
              __builtin_amdgcn_sched_barrier(0); } }
        __syncthreads();
        if (cp + 1 < 32) S2_STORE();
#pragma unroll
        for (int r = 0; r < 16; ++r) *(LAS unsigned short*)(lds + SS_S + (32 * pt + crow(r, hi)) * SS_ROW + (32 * lt + l31) * 2) = (unsigned short)(cvtpk(S[r], 0.f) & 0xffffu);
        __syncthreads();
    }
#undef S2_CI
#undef S2_LOAD
#undef S2_STORE
#undef S2_LOADDT
#undef S2_SCAN
}

template <int DQK, int KW, int DVT, int NT, int MODE, bool PIPE>
__device__ __forceinline__ void attn_item(LAS uchar* lds, const GAS bf16_t* qptr, int qpitch, const GAS bf16_t* kptr, int kpitch, int kwcol, const GAS bf16_t* vtptr, int vtpitch, int vrow,
                                          GAS bf16_t* outp, int opitch, float lam, const GAS float* subg, unsigned& tacc) {
#ifdef TSEG
#define TS_BEGIN(k) do { if (TSEG == (k)) { __builtin_amdgcn_sched_barrier(0); tacc -= (unsigned)__builtin_amdgcn_s_memrealtime(); __builtin_amdgcn_sched_barrier(0); } } while (0)
#else
#define TS_BEGIN(k) do {} while (0)
#endif
    constexpr int KROW = KW * 2 + 16, KBUF = 64 * KROW, VROW = 136, VBUF = DVT * VROW, NKP = 64 * (KW / 8) / 512, NVP = DVT * 8 / 512, NS = DQK / 16;
    static_assert(2 * KBUF + 2 * VBUF <= PTAB_OFF && 128 * 256 * 4 + 1024 <= PTAB_OFF, "attention LDS");
    const int tid = opaque_tid(), lane = tid & 63, wid = __builtin_amdgcn_readfirstlane(tid >> 6), qg = wid >> 1, t = wid & 1, l31 = lane & 31, hi = lane >> 5;
    bf16x8 qf[NS];
    { const GAS bf16_t* qr = qptr + (size_t)(qg * 32 + l31) * qpitch + 8 * hi;
#pragma unroll
      for (int s = 0; s < NS; ++s) qf[s] = *(const GAS bf16x8*)(qr + 16 * s); }
    f32x16 o[4];
#pragma unroll
    for (int d = 0; d < 4; ++d)
#pragma unroll
        for (int r = 0; r < 16; ++r) o[d][r] = 0.f;
    float m = -1e30f, l = 0.f;
    u32x4 kst[NKP], vst[NVP];
#define AT_LOAD(tile) do { \
        _Pragma("unroll") for (int i_ = 0; i_ < NKP; ++i_) { const int id_ = tid + 512 * i_, r_ = id_ / (KW / 8), c_ = id_ % (KW / 8); kst[i_] = *(const GAS u32x4*)(kptr + (size_t)((tile) * 64 + r_) * kpitch + c_ * 8); } \
        _Pragma("unroll") for (int i_ = 0; i_ < NVP; ++i_) { const int id_ = tid + 512 * i_, r_ = id_ >> 3, c_ = id_ & 7; vst[i_] = *(const GAS u32x4*)(vtptr + (size_t)r_ * vtpitch + (tile) * 64 + c_ * 8); } } while (0)
#define AT_STORE(buf) do { \
        _Pragma("unroll") for (int i_ = 0; i_ < NKP; ++i_) { const int id_ = tid + 512 * i_, r_ = id_ / (KW / 8), c_ = id_ % (KW / 8); *(LAS u32x4*)(lds + (buf) * KBUF + r_ * KROW + c_ * 16) = kst[i_]; } \
        _Pragma("unroll") for (int i_ = 0; i_ < NVP; ++i_) { const int id_ = tid + 512 * i_, r_ = id_ >> 3, c_ = id_ & 7; LAS u32x2* d_ = (LAS u32x2*)(lds + 2 * KBUF + (buf) * VBUF + r_ * VROW + c_ * 16); \
            d_[0] = (u32x2){vst[i_].x, vst[i_].y}; d_[1] = (u32x2){vst[i_].z, vst[i_].w}; } } while (0)
    if (PIPE) { AT_LOAD(0); AT_STORE(0); __syncthreads(); }
#pragma unroll
    for (int s = 0; s < NS; ++s) asm volatile("" :: "v"(qf[s]));
    for (int tile = 0; tile < NT; ++tile) {
        if (PIPE) { if (tile + 1 < NT) AT_LOAD(tile + 1); }
        else { AT_LOAD(tile); AT_STORE(tile & 1); __syncthreads(); }
        TS_BEGIN(1);
        const LAS uchar* kb = lds + (tile & 1) * KBUF; const LAS uchar* vb = lds + 2 * KBUF + (tile & 1) * VBUF;
        f32x16 s0, s1;
#pragma unroll
        for (int r = 0; r < 16; ++r) { s0[r] = 0.f; s1[r] = 0.f; }
        { const LAS uchar* ka = kb + l31 * KROW + (kwcol + 8 * hi) * 2;
          constexpr int GS = (NS > 4) ? 2 : 4;
#pragma unroll
          for (int g4 = 0; g4 < NS / GS; ++g4) { bf16x8 kf[2 * GS];
#pragma unroll
              for (int s = 0; s < GS; ++s) { kf[2 * s] = *(const LAS bf16x8*)(ka + 32 * (GS * g4 + s)); kf[2 * s + 1] = *(const LAS bf16x8*)(ka + 32 * KROW + 32 * (GS * g4 + s)); }
              __builtin_amdgcn_sched_barrier(0);
#pragma unroll
              for (int s = 0; s < GS; ++s) { s0 = MFMA32(kf[2 * s], qf[GS * g4 + s], s0); s1 = MFMA32(kf[2 * s + 1], qf[GS * g4 + s], s1); }
              __builtin_amdgcn_sched_barrier(0); } }
        u32x4 vfA[4], vfB[4];
#define AT_VLOAD(dst, kt, j) do { _Pragma("unroll") for (int d_ = 0; d_ < 4; ++d_) { const LAS uchar* va_ = vb + (vrow + 32 * d_ + l31) * VROW + (32 * (kt) + 16 * (j) + 4 * hi) * 2; \
            const u32x2 lo_ = *(const LAS u32x2*)va_, hh_ = *(const LAS u32x2*)(va_ + 16); dst[d_].x = lo_.x; dst[d_].y = lo_.y; dst[d_].z = hh_.x; dst[d_].w = hh_.y; } } while (0)
#define AT_PV(src, P, j) do { u32x4 pw_; pw_.x = cvtpk(P[8 * (j)], P[8 * (j) + 1]); pw_.y = cvtpk(P[8 * (j) + 2], P[8 * (j) + 3]); pw_.z = cvtpk(P[8 * (j) + 4], P[8 * (j) + 5]); pw_.w = cvtpk(P[8 * (j) + 6], P[8 * (j) + 7]); \
            const bf16x8 pa_ = __builtin_bit_cast(bf16x8, pw_); _Pragma("unroll") for (int d_ = 0; d_ < 4; ++d_) o[d_] = MFMA32(pa_, __builtin_bit_cast(bf16x8, src[d_]), o[d_]); } while (0)
        AT_VLOAD(vfA, 0, 0);
        __builtin_amdgcn_sched_barrier(0);
#ifdef TSEG
        if (TSEG == 1) { asm volatile("s_nop 0" :: "v"(s0[15]), "v"(s1[15])); tacc += (unsigned)__builtin_amdgcn_s_memrealtime(); }
#endif
        TS_BEGIN(2);
        asm volatile("s_nop 15\n\ts_nop 7" : "+v"(s0), "+v"(s1));
        float mxa = max3f(s0[0], s0[1], s0[2]), mxb = max3f(s0[3], s0[4], s0[5]), mxc = max3f(s1[0], s1[1], s1[2]), mxd = max3f(s1[3], s1[4], s1[5]);
        mxa = max3f(mxa, s0[6], s0[7]); mxb = max3f(mxb, s0[8], s0[9]); mxc = max3f(mxc, s1[6], s1[7]); mxd = max3f(mxd, s1[8], s1[9]);
        mxa = max3f(mxa, s0[10], s0[11]); mxb = max3f(mxb, s0[12], s0[13]); mxc = max3f(mxc, s1[10], s1[11]); mxd = max3f(mxd, s1[12], s1[13]);
        mxa = max3f(mxa, s0[14], s0[15]); mxc = max3f(mxc, s1[14], s1[15]);
        float mx = max3f(max3f(mxa, mxb, mxc), mxd, mxd);
        { auto rr = __builtin_amdgcn_permlane32_swap(__float_as_uint(mx), __float_as_uint(mx), false, false); mx = max3f(__uint_as_float(rr[0]), __uint_as_float(rr[1]), __uint_as_float(rr[1])); }
        if (__any(mx > m + 8.0f)) {
            const float mnew = fmaxf(m, mx); const float alpha = fast_exp2(m - mnew);
#pragma unroll
            for (int r = 0; r < 16; ++r) { const float ar = __shfl(alpha, crow(r, hi));
#pragma unroll
                for (int d = 0; d < 4; ++d) o[d][r] *= ar; }
            l *= alpha; m = mnew;
        }
        float psa = 0.f, psb = 0.f, psc = 0.f, psd = 0.f;
#pragma unroll
        for (int r = 0; r < 16; r += 2) { s0[r] = fast_exp2(s0[r] - m); s1[r] = fast_exp2(s1[r] - m); s0[r + 1] = fast_exp2(s0[r + 1] - m); s1[r + 1] = fast_exp2(s1[r + 1] - m);
            psa += s0[r]; psb += s1[r]; psc += s0[r + 1]; psd += s1[r + 1]; }
        l += (psa + psb) + (psc + psd);
        __builtin_amdgcn_sched_barrier(0);
#ifdef TSEG
        if (TSEG == 2) { asm volatile("s_nop 0" :: "v"(s0[15]), "v"(s1[15]), "v"(s0[0]), "v"(l)); tacc += (unsigned)__builtin_amdgcn_s_memrealtime(); }
#endif
        TS_BEGIN(3);
        if constexpr (NS <= 4) {
        AT_VLOAD(vfB, 0, 1); __builtin_amdgcn_sched_barrier(0); AT_PV(vfA, s0, 0); __builtin_amdgcn_sched_barrier(0);
        AT_VLOAD(vfA, 1, 0); __builtin_amdgcn_sched_barrier(0); AT_PV(vfB, s0, 1); __builtin_amdgcn_sched_barrier(0);
        AT_VLOAD(vfB, 1, 1); __builtin_amdgcn_sched_barrier(0); AT_PV(vfA, s1, 0); __builtin_amdgcn_sched_barrier(0);
        AT_PV(vfB, s1, 1);
        } else {
        AT_PV(vfA, s0, 0); __builtin_amdgcn_sched_barrier(0); AT_VLOAD(vfA, 0, 1); __builtin_amdgcn_sched_barrier(0);
        AT_PV(vfA, s0, 1); __builtin_amdgcn_sched_barrier(0); AT_VLOAD(vfA, 1, 0); __builtin_amdgcn_sched_barrier(0);
        AT_PV(vfA, s1, 0); __builtin_amdgcn_sched_barrier(0); AT_VLOAD(vfA, 1, 1); __builtin_amdgcn_sched_barrier(0);
        AT_PV(vfA, s1, 1);
        }
#undef AT_VLOAD
#undef AT_PV
#ifdef TSEG
        if (TSEG == 3) { __builtin_amdgcn_sched_barrier(0); asm volatile("s_nop 0" :: "v"(o[0][15]), "v"(o[1][15]), "v"(o[2][15]), "v"(o[3][15])); tacc += (unsigned)__builtin_amdgcn_s_memrealtime(); }
#endif
        TS_BEGIN(4);
        if (PIPE) { if (tile + 1 < NT) AT_STORE((tile + 1) & 1); __syncthreads(); }
#ifdef TSEG
        if (TSEG == 4) tacc += (unsigned)__builtin_amdgcn_s_memrealtime();
#endif
    }
    if (!PIPE) __syncthreads();
#undef AT_LOAD
#undef AT_STORE
    l += __shfl_xor(l, 32);
    LAS float* ex = (LAS float*)lds; LAS float* lsum = (LAS float*)(lds + 128 * 256 * 4);
#pragma unroll
    for (int d = 0; d < 4; ++d)
#pragma unroll
        for (int r = 0; r < 16; ++r) ex[(qg * 32 + crow(r, hi)) * 256 + t * 128 + 32 * d + l31] = o[d][r];
    if (hi == 0) lsum[t * 128 + qg * 32 + l31] = l;
    __syncthreads();
    if (MODE == 0) {
        float av[16], bv[16], ss[16];
#pragma unroll
        for (int rr = 0; rr < 16; ++rr) { const int q = wid * 16 + rr; const float i1 = 1.0f / lsum[q], i2 = lam / lsum[128 + q];
            const f32x2 o1 = ((const LAS f32x2*)(ex + q * 256))[lane], o2 = ((const LAS f32x2*)(ex + q * 256 + 128))[lane];
            av[rr] = o1.x * i1 - o2.x * i2; bv[rr] = o1.y * i1 - o2.y * i2; ss[rr] = av[rr] * av[rr] + bv[rr] * bv[rr]; }
#pragma unroll
        for (int o_ = 1; o_ < 64; o_ <<= 1) {
#pragma unroll
            for (int rr = 0; rr < 16; ++rr) ss[rr] += __shfl_xor(ss[rr], o_); }
        const float g0 = subg[2 * lane], g1 = subg[2 * lane + 1];
#pragma unroll
        for (int rr = 0; rr < 16; ++rr) { const int q = wid * 16 + rr; const float rn = (1.0f - LAMBDA_INIT) / sqrtf(ss[rr] * (1.0f / 128.0f) + EPS);
            *(GAS unsigned*)(outp + (size_t)q * opitch + 2 * lane) = cvtpk(av[rr] * rn * g0, bv[rr] * rn * g1); }
    } else {
#pragma unroll 4
        for (int rr = 0; rr < 16; ++rr) { const int q = wid * 16 + rr;
            const float inv = 1.0f / lsum[q]; const f32x4 v = ((const LAS f32x4*)(ex + q * 256))[lane];
            u32x2 w; w.x = cvtpk(v[0] * inv, v[1] * inv); w.y = cvtpk(v[2] * inv, v[3] * inv);
            *(GAS u32x2*)(outp + (size_t)q * opitch + 4 * lane) = w; }
    }
    __syncthreads();
}

constexpr int XA_KROW = 528, XA_VROW = 136, XA_K = 0, XA_V = 64 * XA_KROW, XA_Q = XA_V + 256 * XA_VROW, XA_END = XA_Q + 128 * XA_KROW;
static_assert(XA_END <= PTAB_OFF, "cross attention LDS");
__device__ __forceinline__ void xattn_item(LAS uchar* lds, const GAS bf16_t* qptr, int qpitch, const GAS bf16_t* kptr, int kpitch, const GAS bf16_t* vtptr, int vtpitch, GAS bf16_t* outp, int opitch) {
    const int tid = opaque_tid(), lane = tid & 63, wid = __builtin_amdgcn_readfirstlane(tid >> 6), qg = wid >> 1, t = wid & 1, l31 = lane & 31, hi = lane >> 5;
    const int vrow = t * 128;
    u32x4 kst[4], vst[4];
#define XA_LOAD(tile) do { \
        _Pragma("unroll") for (int i_ = 0; i_ < 4; ++i_) { const int id_ = tid + 512 * i_, r_ = id_ >> 5, c_ = id_ & 31; kst[i_] = *(const GAS u32x4*)(kptr + (size_t)((tile) * 64 + r_) * kpitch + c_ * 8); } \
        _Pragma("unroll") for (int i_ = 0; i_ < 4; ++i_) { const int id_ = tid + 512 * i_, r_ = id_ >> 3, c_ = id_ & 7; vst[i_] = *(const GAS u32x4*)(vtptr + (size_t)r_ * vtpitch + (tile) * 64 + c_ * 8); } } while (0)
#define XA_STORE() do { \
        _Pragma("unroll") for (int i_ = 0; i_ < 4; ++i_) { const int id_ = tid + 512 * i_, r_ = id_ >> 5, c_ = id_ & 31; *(LAS u32x4*)(lds + XA_K + r_ * XA_KROW + c_ * 16) = kst[i_]; } \
        _Pragma("unroll") for (int i_ = 0; i_ < 4; ++i_) { const int id_ = tid + 512 * i_, r_ = id_ >> 3, c_ = id_ & 7; LAS u32x2* d_ = (LAS u32x2*)(lds + XA_V + r_ * XA_VROW + c_ * 16); \
            d_[0] = (u32x2){vst[i_].x, vst[i_].y}; d_[1] = (u32x2){vst[i_].z, vst[i_].w}; } } while (0)
    XA_LOAD(0);
    { u32x4 qs[8];
#pragma unroll
      for (int i = 0; i < 8; ++i) { const int id = tid + 512 * i, r = id >> 5, c = id & 31; qs[i] = *(const GAS u32x4*)(qptr + (size_t)r * qpitch + c * 8); }
#pragma unroll
      for (int i = 0; i < 8; ++i) { const int id = tid + 512 * i, r = id >> 5, c = id & 31; *(LAS u32x4*)(lds + XA_Q + r * XA_KROW + c * 16) = qs[i]; } }
    f32x16 o[4];
#pragma unroll
    for (int d = 0; d < 4; ++d)
#pragma unroll
        for (int r = 0; r < 16; ++r) o[d][r] = 0.f;
    float m = -1e30f, l = 0.f;
    for (int tile = 0; tile < 4; ++tile) {
        XA_STORE();
        __syncthreads();
        if (tile + 1 < 4) XA_LOAD(tile + 1);
        f32x16 s0, s1;
#pragma unroll
        for (int r = 0; r < 16; ++r) { s0[r] = 0.f; s1[r] = 0.f; }
        { const LAS uchar* ka = lds + XA_K + l31 * XA_KROW + (8 * hi) * 2; const LAS uchar* qa = lds + XA_Q + (qg * 32 + l31) * XA_KROW + (8 * hi) * 2;
#pragma unroll
          for (int g2 = 0; g2 < 8; ++g2) { bf16x8 kf[4], qb[2];
#pragma unroll
              for (int s = 0; s < 2; ++s) { kf[2 * s] = *(const LAS bf16x8*)(ka + 32 * (2 * g2 + s)); kf[2 * s + 1] = *(const LAS bf16x8*)(ka + 32 * XA_KROW + 32 * (2 * g2 + s)); qb[s] = *(const LAS bf16x8*)(qa + 32 * (2 * g2 + s)); }
              __builtin_amdgcn_sched_barrier(0);
#pragma unroll
              for (int s = 0; s < 2; ++s) { s0 = MFMA32(kf[2 * s], qb[s], s0); s1 = MFMA32(kf[2 * s + 1], qb[s], s1); }
              __builtin_amdgcn_sched_barrier(0); } }
        asm volatile("s_nop 15\n\ts_nop 7" : "+v"(s0), "+v"(s1));
        float mxa = max3f(s0[0], s0[1], s0[2]), mxb = max3f(s0[3], s0[4], s0[5]), mxc = max3f(s1[0], s1[1], s1[2]), mxd = max3f(s1[3], s1[4], s1[5]);
        mxa = max3f(mxa, s0[6], s0[7]); mxb = max3f(mxb, s0[8], s0[9]); mxc = max3f(mxc, s1[6], s1[7]); mxd = max3f(mxd, s1[8], s1[9]);
        mxa = max3f(mxa, s0[10], s0[11]); mxb = max3f(mxb, s0[12], s0[13]); mxc = max3f(mxc, s1[10], s1[11]); mxd = max3f(mxd, s1[12], s1[13]);
        mxa = max3f(mxa, s0[14], s0[15]); mxc = max3f(mxc, s1[14], s1[15]);
        float mx = max3f(max3f(mxa, mxb, mxc), mxd, mxd);
        { auto rr = __builtin_amdgcn_permlane32_swap(__float_as_uint(mx), __float_as_uint(mx), false, false); mx = max3f(__uint_as_float(rr[0]), __uint_as_float(rr[1]), __uint_as_float(rr[1])); }
        if (__any(mx > m + 8.0f)) {
            const float mnew = fmaxf(m, mx); const float alpha = fast_exp2(m - mnew);
#pragma unroll
            for (int r = 0; r < 16; ++r) { const float ar = __shfl(alpha, crow(r, hi));
#pragma unroll
                for (int d = 0; d < 4; ++d) o[d][r] *= ar; }
            l *= alpha; m = mnew;
        }
        float psa = 0.f, psb = 0.f, psc = 0.f, psd = 0.f;
#pragma unroll
        for (int r = 0; r < 16; r += 2) { s0[r] = fast_exp2(s0[r] - m); s1[r] = fast_exp2(s1[r] - m); s0[r + 1] = fast_exp2(s0[r + 1] - m); s1[r + 1] = fast_exp2(s1[r + 1] - m);
            psa += s0[r]; psb += s1[r]; psc += s0[r + 1]; psd += s1[r + 1]; }
        l += (psa + psb) + (psc + psd);
        __builtin_amdgcn_sched_barrier(0);
#pragma unroll
        for (int s4 = 0; s4 < 4; ++s4) {
            u32x4 vf[4];
#pragma unroll
            for (int d = 0; d < 4; ++d) { const LAS uchar* va = lds + XA_V + (vrow + 32 * d + l31) * XA_VROW + (16 * s4 + 4 * hi) * 2; const u32x2 lo = *(const LAS u32x2*)va, hh = *(const LAS u32x2*)(va + 16);
                vf[d].x = lo.x; vf[d].y = lo.y; vf[d].z = hh.x; vf[d].w = hh.y; }
            u32x4 pw;
            if (s4 == 0)      { pw.x = cvtpk(s0[0], s0[1]); pw.y = cvtpk(s0[2], s0[3]); pw.z = cvtpk(s0[4], s0[5]); pw.w = cvtpk(s0[6], s0[7]); }
            else if (s4 == 1) { pw.x = cvtpk(s0[8], s0[9]); pw.y = cvtpk(s0[10], s0[11]); pw.z = cvtpk(s0[12], s0[13]); pw.w = cvtpk(s0[14], s0[15]); }
            else if (s4 == 2) { pw.x = cvtpk(s1[0], s1[1]); pw.y = cvtpk(s1[2], s1[3]); pw.z = cvtpk(s1[4], s1[5]); pw.w = cvtpk(s1[6], s1[7]); }
            else              { pw.x = cvtpk(s1[8], s1[9]); pw.y = cvtpk(s1[10], s1[11]); pw.z = cvtpk(s1[12], s1[13]); pw.w = cvtpk(s1[14], s1[15]); }
            __builtin_amdgcn_sched_barrier(0);
            const bf16x8 pa = __builtin_bit_cast(bf16x8, pw);
#pragma unroll
            for (int d = 0; d < 4; ++d) o[d] = MFMA32(pa, __builtin_bit_cast(bf16x8, vf[d]), o[d]);
            __builtin_amdgcn_sched_barrier(0);
        }
        __syncthreads();
    }
#undef XA_LOAD
#undef XA_STORE
    l += __shfl_xor(l, 32);
    LAS float* ex = (LAS float*)lds; LAS float* lsum = (LAS float*)(lds + 128 * 256 * 4);
#pragma unroll
    for (int d = 0; d < 4; ++d)
#pragma unroll
        for (int r = 0; r < 16; ++r) ex[(qg * 32 + crow(r, hi)) * 256 + t * 128 + 32 * d + l31] = o[d][r];
    if (hi == 0) lsum[t * 128 + qg * 32 + l31] = l;
    __syncthreads();
#pragma unroll 4
    for (int rr = 0; rr < 16; ++rr) { const int q = wid * 16 + rr;
        const float inv = 1.0f / lsum[q]; const f32x4 v = ((const LAS f32x4*)(ex + q * 256))[lane];
        u32x2 w; w.x = cvtpk(v[0] * inv, v[1] * inv); w.y = cvtpk(v[2] * inv, v[3] * inv);
        *(GAS u32x2*)(outp + (size_t)q * opitch + 4 * lane) = w; }
    __syncthreads();
}

#define XB_TMO      128
#define XB_XCNT(j)  (256  + 64 * (j))
#define XB_XSUB(j)  (1280 + 64 * (j))
#define XB_XGEN(j)  (2304 + 64 * (j))
#define XB_TOP      3328
#define XB_TOPGEN   3392
#define XCD_BAR_WORDS 3456
#define XB_SPIN_CAP (1u << 18)

__device__ __forceinline__ unsigned xb_ld(unsigned* p)              { return __hip_atomic_load(p, __ATOMIC_RELAXED, __HIP_MEMORY_SCOPE_AGENT); }
__device__ __forceinline__ unsigned xb_add(unsigned* p, unsigned v) { return __hip_atomic_fetch_add(p, v, __ATOMIC_RELAXED, __HIP_MEMORY_SCOPE_AGENT); }
__device__ __forceinline__ unsigned xb_xcc_id() { return (unsigned)__builtin_amdgcn_s_getreg((3 << 11) | 20) & 0xFu; }
#define XB_SPIN(cond, bar) do { unsigned _sp = 0; while (cond) { __builtin_amdgcn_s_sleep(1); \
    if ((++_sp & 255u) == 0u) { if (xb_ld(&(bar)[XB_TMO])) break; if (_sp > XB_SPIN_CAP) { atomicAdd(&(bar)[XB_TMO], 1u); break; } } } } while (0)

struct XcdBarrier {
    unsigned* bar; unsigned x;
    volatile LAS unsigned* st;
};

__device__ __forceinline__ XcdBarrier xcd_barrier_post(unsigned* bar, volatile LAS unsigned* st) {
    XcdBarrier b; b.bar = bar; b.x = xb_xcc_id(); b.st = st;
    if (threadIdx.x == 0) (void)xb_add(&bar[XB_XCNT(b.x)], 1u);
    return b;
}
__device__ __forceinline__ void xcd_barrier_complete(unsigned* bar, unsigned x, unsigned& nloc, unsigned& nx) {
    const unsigned G = gridDim.x * gridDim.y * gridDim.z;
    unsigned sum, cnt, mine, sp = 0u;
    for (;;) {
        sum = 0u; cnt = 0u; mine = 0u;
#pragma unroll
        for (unsigned j = 0; j < 16; ++j) { const unsigned c = xb_ld(&bar[XB_XCNT(j)]); sum += c; cnt += (c > 0u) ? 1u : 0u; mine = (j == x) ? c : mine; }
        if (sum == G) break;
        __builtin_amdgcn_s_sleep(1);
        if ((++sp & 255u) == 0u) { if (xb_ld(&bar[XB_TMO])) break; if (sp > XB_SPIN_CAP) { atomicAdd(&bar[XB_TMO], 1u); break; } }
    }
    nloc = mine > 0u ? mine : 1u; nx = cnt > 0u ? cnt : 1u;
}

__device__ __forceinline__ void xcd_barrier(const XcdBarrier& b) {
    asm volatile("s_waitcnt vmcnt(0)" ::: "memory");
    __syncthreads();
    if (threadIdx.x == 0) {
        unsigned* bar = b.bar;
        __builtin_amdgcn_s_waitcnt(0);
        unsigned nloc = b.st[0], nx = b.st[1];
        if (nloc == 0u) { xcd_barrier_complete(bar, b.x, nloc, nx); b.st[0] = nloc; b.st[1] = nx; }
        const unsigned old = xb_add(&bar[XB_XSUB(b.x)], 1u);
        const unsigned gen = old / nloc;
        if (old + 1u == (gen + 1u) * nloc) {
            __builtin_amdgcn_fence(__ATOMIC_RELEASE, "agent");
            asm volatile("s_waitcnt vmcnt(0)" ::: "memory");
            const unsigned og = xb_add(&bar[XB_TOP], 1u);
            const unsigned tg = og / nx;
            if (og + 1u == (tg + 1u) * nx) xb_add(&bar[XB_TOPGEN], 1u);
            else XB_SPIN(xb_ld(&bar[XB_TOPGEN]) == tg, bar);
            __builtin_amdgcn_fence(__ATOMIC_ACQUIRE, "agent");
            xb_add(&bar[XB_XGEN(b.x)], 1u);
            asm volatile("s_waitcnt vmcnt(0)" ::: "memory");
        } else {
            XB_SPIN(xb_ld(&bar[XB_XGEN(b.x)]) == gen, bar);
            __builtin_amdgcn_fence(__ATOMIC_ACQUIRE, "agent");
            asm volatile("s_waitcnt vmcnt(0)" ::: "memory");
        }
    }
    __syncthreads();
}

#ifndef PHASE_MASK
#define PHASE_MASK 0xFFFF
#endif
#define PH_ON(k) ((PHASE_MASK >> (k)) & 1)
#define PH_IDS const int tid = opaque_tid(), lane = tid & 63, wave = __builtin_amdgcn_readfirstlane(tid >> 6), gw = bx * 8 + wave, gtid = bx * 512 + tid; (void)lane; (void)gw; (void)gtid; (void)wave
struct Args { const float* in[32]; float* out; unsigned char* ws; int ph_lo, ph_hi; };
#ifdef TSEG
constexpr int N_PHASES = 15;
#else
constexpr int N_PHASES = 14;
#endif

__global__ void __launch_bounds__(512, 2) mega_fwd(Args a) {
    extern __shared__ __attribute__((aligned(16))) unsigned char lds_raw[];
    LAS uchar* lds = (LAS uchar*)lds_raw;
    const int G = (int)gridDim.x, bx = (int)blockIdx.x, NGW = G * 8, NTHR = G * 512;
    LAS unsigned long long* ptab = (LAS unsigned long long*)(lds + PTAB_OFF);
    if (threadIdx.x < 32) ptab[threadIdx.x] = (unsigned long long)a.in[threadIdx.x];
    if (threadIdx.x < 2) ((volatile LAS unsigned*)(lds + PTAB_OFF + 384))[threadIdx.x] = 0u;
    __syncthreads();
    XcdBarrier xbar = xcd_barrier_post((unsigned*)(a.ws + WS_CTL + 4096), (volatile LAS unsigned*)(lds + PTAB_OFF + 384));
#define INP(k) ((const GAS float*)(((unsigned long long)(unsigned)__builtin_amdgcn_readfirstlane((int)(ptab[k] >> 32)) << 32) | (unsigned long long)(unsigned)__builtin_amdgcn_readfirstlane((int)(ptab[k] & 0xffffffffull))))
    if (a.ph_lo == 0 && PH_ON(0)) {
        GAS float* rope_cs = (GAS float*)((GAS unsigned char*)a.ws + WS_ROPE);
        for (int i = bx * 512 + (int)threadIdx.x; i < SEQ * 8; i += NTHR) rope_entry(i, rope_cs, rope_cs + SEQ * 8);
    }
#ifdef REP_PH
    bool rep_done = false;
#endif
    for (int ph = a.ph_lo; ph < a.ph_hi; ++ph) {
        GAS unsigned char* ws = (GAS unsigned char*)a.ws; asm volatile("" : "+s"(ws));
        GAS float* lamp = (GAS float*)(ws + WS_CTL);
        GAS float* rope_cs = (GAS float*)(ws + WS_ROPE); GAS float* rope_sn = rope_cs + SEQ * 8;
        GAS float* SS0 = (GAS float*)(ws + WS_SS0); GAS float* SS1 = (GAS float*)(ws + WS_SS1); GAS float* SS2 = (GAS float*)(ws + WS_SS2); GAS float* SS3 = (GAS float*)(ws + WS_SS3); GAS float* SS4 = (GAS float*)(ws + WS_SS4); GAS float* SSM = (GAS float*)(ws + WS_SSM);
        GAS float* DTB = (GAS float*)(ws + WS_DT);
        GAS bf16_t* WGU1 = (GAS bf16_t*)(ws + WS_WGU1); GAS bf16_t* WD1 = (GAS bf16_t*)(ws + WS_WD1); GAS bf16_t* WIN = (GAS bf16_t*)(ws + WS_WIN); GAS bf16_t* WOUT = (GAS bf16_t*)(ws + WS_WOUT);
        GAS bf16_t* WQ = (GAS bf16_t*)(ws + WS_WQ); GAS bf16_t* WKV = (GAS bf16_t*)(ws + WS_WKV); GAS bf16_t* WO = (GAS bf16_t*)(ws + WS_WO); GAS bf16_t* WGU2 = (GAS bf16_t*)(ws + WS_WGU2); GAS bf16_t* WD2 = (GAS bf16_t*)(ws + WS_WD2);
        GAS bf16_t* MEMB = (GAS bf16_t*)(ws + WS_MEMB); GAS bf16_t* KVX = (GAS bf16_t*)(ws + WS_KVX); GAS bf16_t* VTX = (GAS bf16_t*)(ws + WS_VTX); GAS bf16_t* VT = (GAS bf16_t*)(ws + WS_VT);
        GAS float* out = (GAS float*)a.out;
        GAS bf16_t* XB = (GAS bf16_t*)(ws + WS_XB);
        GAS bf16_t* XC = (GAS bf16_t*)out; GAS bf16_t* XT = XC + (size_t)T * 1024; GAS bf16_t* BTR = XT + (size_t)T * 512;
        GAS bf16_t* YMIX = (GAS bf16_t*)(ws + WS_YMIX); GAS bf16_t* OX = YMIX;
        GAS bf16_t* YF = (GAS bf16_t*)(ws + WS_YFB); GAS bf16_t* YB = YF + (size_t)T * 512; GAS bf16_t* QX = YF;
        GAS bf16_t* BIG = (GAS bf16_t*)(ws + WS_BIG); GAS bf16_t* U = BIG; GAS bf16_t* PROJ = BIG;

        if (ph == 0 && PH_ON(0)) {
            PH_IDS;
            LAS float* scr = (LAS float*)(lds + wave * 16384);
            constexpr int I_G = 16 * 88, I_D = 44 * 32, I_IN = 16 * 97, I_SQ = 16 * 32, I_KV = 16 * 64;
            constexpr int NITEMS = 6 * I_G + I_IN + 3 * I_SQ + I_KV;
            static_assert(I_G == I_D, "item counts");
            for (int it = gw; it < NITEMS; it += NGW) {
                int r = it; const GAS float* W; const GAS float* gq = nullptr; GAS bf16_t* WT; int K = DM, N = DM, kind = 0;
                if (r < 3 * I_G) { const int w = r / I_G; r -= w * I_G; if (w == 2) { W = INP(5); K = FF; WT = WD1; } else { W = INP(3 + w); N = FF; WT = WGU1; kind = 1 + w; gq = INP(2); } }
                else if (r < 6 * I_G) { r -= 3 * I_G; const int w = r / I_G; r -= w * I_G; if (w == 2) { W = INP(30); K = FF; WT = WD2; } else { W = INP(28 + w); N = FF; WT = WGU2; kind = 1 + w; gq = INP(27); } }
                else if (r < 6 * I_G + I_IN) { r -= 6 * I_G; W = INP(7); N = 3088; WT = WIN; kind = 3; gq = INP(6); }
                else { r -= 6 * I_G + I_IN;
                    if (r < I_SQ) { W = INP(21); WT = WOUT; }
                    else if (r < 2 * I_SQ) { r -= I_SQ; W = INP(24); WT = WQ; gq = INP(22); }
                    else if (r < 3 * I_SQ) { r -= 2 * I_SQ; W = INP(26); WT = WO; }
                    else { r -= 3 * I_SQ; W = INP(25); N = 2 * DM; WT = WKV; gq = INP(23); } }
                p0_transpose_item(W, K, N, WT, kind, gq, scr, r, lane);
            }
            { const GAS float* xin = INP(0); for (int mrow = gw * 4; mrow < T; mrow += NGW * 4) rows4_to_bf16_ss(xin, XB, SS0, mrow, lane); }
            { const GAS float* min_ = INP(1); for (int mrow = gw * 4; mrow < TM; mrow += NGW * 4) rows4_to_bf16_ss(min_, MEMB, SSM, mrow, lane); }
            for (int i = gtid; i < (NPROJ - 3088) * DM / 8; i += NTHR) { unsigned oz = 0u; asm volatile("" : "+v"(oz)); ((GAS u32x4*)(WIN + (size_t)3088 * DM))[i] = (u32x4){oz, oz, oz, oz}; }
            if (bx == 0 && wave == 0) {
                const float s1 = wave_sum(INP(16)[lane] * INP(17)[lane]), s2 = wave_sum(INP(18)[lane] * INP(19)[lane]);
                if (lane == 0) lamp[0] = __expf(s1) - __expf(s2) + LAMBDA_INIT;
            }
        } else if (PH_ON(1) && (ph == 1 || ph == 2 || ph == 3 || ph == 7 || ph == 8 || ph == 10 || ph == 11 || ph == 12)) {
            for (int sub = 0; sub < 2; ++sub) {
                if (sub == 1 && ph != 1) break;
                GJob j; j.E = EpiAny{0, ws, 1.0f, 0u, 0u, 0u, 0};
                if (ph == 1 && sub == 0) { j.A = XB; j.Bt = WGU1; j.M = T; j.N = 2 * FF; j.K = DM; j.E.kind = 1; j.E.part_off = (unsigned)WS_SS0; j.E.o_off = (unsigned)WS_BIG; }
                else if (ph == 1)        { j.A = MEMB; j.Bt = WKV; j.M = TM; j.N = 2 * DM; j.K = DM; j.E.kind = 0; j.E.part_off = (unsigned)WS_SSM; j.E.o_off = (unsigned)WS_KVX; j.E.ldc = 2 * DM; }
                else if (ph == 2)        { j.A = U; j.Bt = WD1; j.M = T; j.N = DM; j.K = FF; j.E.kind = 2; j.E.scale = 0.5f; j.E.opart_off = (unsigned)WS_SS1; }
                else if (ph == 3)        { j.A = XB; j.Bt = WIN; j.M = T; j.N = NPROJ; j.K = DM; j.E.kind = 3; j.E.part_off = (unsigned)WS_SS1; j.E.o_off = (unsigned)WS_BIG; }
                else if (ph == 7)        { j.A = YMIX; j.Bt = WOUT; j.M = T; j.N = DM; j.K = DM; j.E.kind = 2; j.E.opart_off = (unsigned)WS_SS2; }
                else if (ph == 8)        { j.A = XB; j.Bt = WQ; j.M = T; j.N = DM; j.K = DM; j.E.kind = 0; j.E.part_off = (unsigned)WS_SS2; j.E.scale = 0.0625f * LOG2E; j.E.o_off = (unsigned)WS_YFB; j.E.ldc = DM; }
                else if (ph == 10)       { j.A = OX; j.Bt = WO; j.M = T; j.N = DM; j.K = DM; j.E.kind = 2; j.E.opart_off = (unsigned)WS_SS3; }
                else if (ph == 11)       { j.A = XB; j.Bt = WGU2; j.M = T; j.N = 2 * FF; j.K = DM; j.E.kind = 1; j.E.part_off = (unsigned)WS_SS3; j.E.o_off = (unsigned)WS_BIG; }
                else                     { j.A = U; j.Bt = WD2; j.M = T; j.N = DM; j.K = FF; j.E.kind = 2; j.E.scale = 0.5f; j.E.opart_off = (unsigned)WS_SS4; }
                run_gemm(lds, j.A, j.Bt, j.M, j.N, j.K, j.E, j.E.kind == 2 ? (const GAS float*)nullptr : (const GAS float*)(ws + j.E.part_off));
            }
        } else if (ph == 4 && PH_ON(4)) {
            PH_IDS;
            LAS uchar* scr = lds + wave * 8448;
            { const GAS float* cwp = INP(8); const GAS float* cbp = INP(9); for (int it = gw; it < (T / 64) * 16; it += NGW) conv_item(PROJ, cwp, cbp, XC, XT, BTR, scr, it, lane); }
            for (int it = gw; it < NB * 4 * 2 * 64; it += NGW) { const int st = it & 63, dt = (it >> 6) & 1, bh = it >> 7, b = bh >> 2, h = bh & 3;
                transpose64(PROJ + (size_t)(b * SEQ + st * 64) * PLD + PC_V + h * 128 + dt * 64, PLD, VT + (size_t)(bh * 128 + dt * 64) * SEQ + st * 64, SEQ, scr, lane); }
            for (int it = gw; it < NB * 4 * 4 * 4; it += NGW) { const int mt = it & 3, dt = (it >> 2) & 3, bh = it >> 4, b = bh >> 2, h = bh & 3;
                transpose64(KVX + (size_t)(b * MEML + mt * 64) * (2 * DM) + DM + h * 256 + dt * 64, 2 * DM, VTX + (size_t)(bh * 256 + dt * 64) * MEML + mt * 64, MEML, scr, lane); }
        } else if (ph == 5 && PH_ON(5)) {
            PH_IDS;
#ifndef REP_SSD
#define REP_SSD 1
#endif
#ifndef REP_ATT
#define REP_ATT 1
#endif
            for (int rep = 0; rep < REP_SSD; ++rep)
            for (int it = bx; it < NB * 8 * 2; it += G) { const int dir = it & 1, h = (it >> 1) & 7, b = it >> 4;
                const float Aneg = -__expf(dir ? INP(13)[h] : INP(12)[h]);
#ifdef SSD_VALU
                ssd_item(lds, b, h, dir, XC, DTB, Aneg, dir ? YB : YF); }
#else
                ssd_item2(lds, b, h, dir, XC, BTR, XT, DTB, Aneg, dir ? YB : YF); }
#endif
            unsigned tacc = 0u;
            for (int rep = 0; rep < REP_ATT; ++rep)
            for (int i = 0;; ++i) {
                int bh, qb;
                if (G == 256) { if (i >= 8) break; bh = i * 8 + (bx & 7); qb = bx >> 3; }
                else { const int L = i * G + bx; if (L >= 2048) break; bh = L >> 5; qb = L & 31; }
                const int b = bh >> 2, h = bh & 3; const size_t row0 = (size_t)b * SEQ + qb * 128;
                const int t = wave & 1;
                attn_item<64, 128, 128, 64, 0, true>(lds, PROJ + row0 * PLD + PC_Q + h * 128 + t * 64, PLD, PROJ + (size_t)b * SEQ * PLD + PC_K + h * 128, PLD, t * 64,
                                               VT + (size_t)bh * 128 * SEQ, SEQ, 0, YMIX + row0 * DM + 512 + h * 128, DM, lamp[0], INP(20), tacc);
            }
#ifdef TSEG
            if (bx == 0 && tid == 0) *(GAS unsigned*)(ws + WS_CTL + 64) = (TSEG == 0) ? 250000u : tacc;
#endif
        } else if (ph == 6 && PH_ON(6)) {
            PH_IDS;
            { const GAS float* Dp = INP(14); const GAS float* gp = INP(15);
              for (int it0 = gw * 4; it0 < T * 2; it0 += NGW * 4) {
                u32x2 yf[4], yb[4], xv[4], zv[4];
#pragma unroll
                for (int q = 0; q < 4; ++q) { const int it = it0 + q, tok = it >> 1, c = (it & 1) * 256 + 4 * lane;
                    yf[q] = *(const GAS u32x2*)(YF + (size_t)tok * 512 + c); yb[q] = *(const GAS u32x2*)(YB + (size_t)tok * 512 + c); xv[q] = *(const GAS u32x2*)(XC + (size_t)tok * 1024 + c); zv[q] = *(const GAS u32x2*)(PROJ + (size_t)tok * PLD + PC_Z + c); }
                float y[4][4], ss[4];
#pragma unroll
                for (int q = 0; q < 4; ++q) { const int c = ((it0 + q) & 1) * 256 + 4 * lane; const float D = Dp[c >> 6];
                    y[q][0] = (bflo(yf[q].x) + bflo(yb[q].x) + D * bflo(xv[q].x)) * silu_f(bflo(zv[q].x)); y[q][1] = (bfhi(yf[q].x) + bfhi(yb[q].x) + D * bfhi(xv[q].x)) * silu_f(bfhi(zv[q].x));
                    y[q][2] = (bflo(yf[q].y) + bflo(yb[q].y) + D * bflo(xv[q].y)) * silu_f(bflo(zv[q].y)); y[q][3] = (bfhi(yf[q].y) + bfhi(yb[q].y) + D * bfhi(xv[q].y)) * silu_f(bfhi(zv[q].y));
                    ss[q] = (y[q][0] * y[q][0] + y[q][1] * y[q][1]) + (y[q][2] * y[q][2] + y[q][3] * y[q][3]); }
#pragma unroll
                for (int o = 1; o < 64; o <<= 1) {
#pragma unroll
                    for (int q = 0; q < 4; ++q) ss[q] += __shfl_xor(ss[q], o); }
#pragma unroll
                for (int q = 0; q < 4; ++q) { const int it = it0 + q, tok = it >> 1, c = (it & 1) * 256 + 4 * lane; const float rn = 1.0f / sqrtf(ss[q] * (1.0f / 256.0f) + EPS); const f32x4 gv = *(const GAS f32x4*)(gp + c);
                    u32x2 w; w.x = cvtpk(y[q][0] * rn * gv[0], y[q][1] * rn * gv[1]); w.y = cvtpk(y[q][2] * rn * gv[2], y[q][3] * rn * gv[3]);
                    *(GAS u32x2*)(YMIX + (size_t)tok * DM + c) = w; }
              } }
        } else if (ph == 9 && PH_ON(9)) {
            PH_IDS;
            unsigned tdummy = 0u;
            for (int i = 0;; ++i) {
                int bh, qb;
                if (G == 256) { if (i >= 8) break; bh = i * 8 + (bx & 7); qb = bx >> 3; }
                else { const int L = i * G + bx; if (L >= 2048) break; bh = L >> 5; qb = L & 31; }
                const int b = bh >> 2, h = bh & 3; const size_t row0 = (size_t)b * SEQ + qb * 128;
                const int t = wave & 1;
xattn_item(lds, QX + row0 * DM + h * 256, DM, KVX + (size_t)b * MEML * (2 * DM) + h * 256, 2 * DM, VTX + (size_t)bh * 256 * MEML, MEML, OX + row0 * DM + h * 256, DM);
            }
        } else if (ph == 13 && PH_ON(13)) {
            PH_IDS;
            { f32x4 gv[4];
#pragma unroll
              for (int j = 0; j < 4; ++j) gv[j] = ((const GAS f32x4*)INP(31))[lane + 64 * j];
              for (int row0 = gw * 8; row0 < T; row0 += NGW * 8) {
                float sp[8]; u32x2 xv[8][4];
#pragma unroll
                for (int r = 0; r < 8; ++r) { sp[r] = SS4[(size_t)(row0 + r) * 16 + (lane & 15)];
#pragma unroll
                    for (int j = 0; j < 4; ++j) xv[r][j] = ((const GAS u32x2*)(XB + (size_t)(row0 + r) * DM))[lane + 64 * j]; }
#pragma unroll
                for (int o = 1; o < 16; o <<= 1) {
#pragma unroll
                    for (int r = 0; r < 8; ++r) sp[r] += __shfl_xor(sp[r], o); }
#pragma unroll
                for (int r = 0; r < 8; ++r) { const float rs = 1.0f / sqrtf(sp[r] * (1.0f / 1024.0f) + EPS); GAS f32x4* xr = (GAS f32x4*)(out + (size_t)(row0 + r) * DM);
#pragma unroll
                    for (int j = 0; j < 4; ++j) { f32x4 v; v[0] = bflo(xv[r][j].x); v[1] = bfhi(xv[r][j].x); v[2] = bflo(xv[r][j].y); v[3] = bfhi(xv[r][j].y); xr[lane + 64 * j] = v * rs * gv[j]; } }
              } }
        }
#ifdef TSEG
        else if (ph == 14) {
            const unsigned tk = *(GAS unsigned*)(ws + WS_CTL + 64); unsigned K = ((tk + 1024u) & ~2047u) * 4u; if (K > 8000000u) K = 8000000u;
            for (unsigned i = (unsigned)bx * 512u + (unsigned)opaque_tid(); i < K; i += (unsigned)NTHR) out[i * 8u] += (i & 1u) ? 0.1f : -0.1f;
        }
#endif
#ifdef REP_PH
        if (ph == REP_PH && !rep_done) { rep_done = true; cg::this_grid().sync(); --ph; continue; }
#endif
        if (ph + 1 < a.ph_hi) { if (a.ph_lo < 0) cg::this_grid().sync(); else xcd_barrier(xbar); }
#ifdef EXTRA_SYNCS
        if (ph == 6) for (int e = 0; e < EXTRA_SYNCS; ++e) cg::this_grid().sync();
#endif
    }
}

extern "C" void kernel_launch(void* const* d_in, const int* in_sizes, int n_in, void* d_out, int out_size, void* d_ws, size_t ws_size, hipStream_t stream) {
    static int grid = 0;
    if (grid == 0) {
        if (n_in != 32 || in_sizes[0] != T * DM || out_size != T * DM || ws_size < WS_END) {
            fprintf(stderr, "kernel_launch: unexpected shapes (n_in %d, in0 %d, out %d, ws %zu < %zu); nothing launched\n", n_in, n_in > 0 ? in_sizes[0] : -1, out_size, ws_size, (size_t)WS_END); grid = -1; return; }
        int dev = 0, cus = 0, per_cu = 0;
        hipGetDevice(&dev); hipDeviceGetAttribute(&cus, hipDeviceAttributeMultiprocessorCount, dev);
        if (hipFuncSetAttribute((const void*)mega_fwd, hipFuncAttributeMaxDynamicSharedMemorySize, LDS_BYTES) != hipSuccess) { fprintf(stderr, "kernel_launch: hipFuncSetAttribute failed\n"); grid = -1; return; }
        if (hipOccupancyMaxActiveBlocksPerMultiprocessor(&per_cu, (const void*)mega_fwd, 512, LDS_BYTES) != hipSuccess || per_cu < 1) { fprintf(stderr, "kernel_launch: occupancy query says %d\n", per_cu); per_cu = 1; }
        (void)hipGetLastError();
        grid = cus * per_cu;
        if (grid <= 0 || grid > 256) grid = 256;
        if (grid != 256) fprintf(stderr, "kernel_launch: grid %d != 256: built for a 256-CU device\n", grid);
    }
    if (grid < 0) return;
    Args a{};
    for (int i = 0; i < 32; ++i) a.in[i] = (const float*)d_in[i];
    a.out = (float*)d_out; a.ws = (unsigned char*)d_ws;
#if MK_COOP
    if (hipMemsetAsync((char*)d_ws + WS_CTL + 4096, 0, XCD_BAR_WORDS * 4, stream) != hipSuccess) { fprintf(stderr, "kernel_launch: memset of the barrier words failed\n"); return; }
    a.ph_lo = 0; a.ph_hi = N_PHASES;
    void* kargs[] = {&a};
    hipError_t e = hipLaunchCooperativeKernel((const void*)mega_fwd, dim3(grid), dim3(512), kargs, LDS_BYTES, stream);
    if (e != hipSuccess) fprintf(stderr, "kernel_launch: cooperative launch failed: %s (grid %d)\n", hipGetErrorString(e), grid);
#else
    for (int ph = 0; ph < N_PHASES; ++ph) { a.ph_lo = ph; a.ph_hi = ph + 1; hipLaunchKernelGGL(mega_fwd, dim3(grid), dim3(512), LDS_BYTES, stream, a); }
#endif
}
```

```cpp
#include <hip/hip_runtime.h>
#include <hip/hip_cooperative_groups.h>
#include <cstdio>
#include <cstdint>
namespace cg = cooperative_groups;
#ifndef MK_COOP
#define MK_COOP 1
#endif
namespace pg8 {
#define PG8_LAS __attribute__((address_space(3)))
typedef unsigned short bf16_t;
typedef short bf16x8 __attribute__((ext_vector_type(8)));
typedef float f32x4 __attribute__((ext_vector_type(4)));
typedef unsigned u32x4 __attribute__((ext_vector_type(4)));
constexpr int BM = 256, BK = 64, HALF = 128, HTB = HALF * BK * 2  , STAGE_BYTES = 8 * HTB, NXCD = 8, WGM = 8;

__host__ __device__ __forceinline__ int lds_byte(int r, int c) { const int st = (r >> 4) * 2 + (c >> 5), rr = r & 15, cc = c & 31, ob = rr * 64 + cc * 2; return st * 1024 + (ob ^ (((ob >> 9) & 1) << 5)); }
__host__ __device__ __forceinline__ void stage_rc(int b, int& R, int& C) { const int st = b / 1024, sb = b % 1024, swz = sb ^ (((sb >> 9) & 1) << 5); R = (st >> 1) * 16 + swz / 64; C = (st & 1) * 32 + (swz % 64) / 2; }
__host__ __device__ __forceinline__ int perm32(int rho) { const int n = rho >> 4, i = rho & 15; return 8 * (i >> 2) + 4 * n + (i & 3); }

struct Unit { int pm, pn; };
struct Gemm { const bf16_t* A; const bf16_t* Bt; int M, N, K; };

struct StaticOrder {
    int nM, nN, nwg, G, c;
    __host__ __device__ void init(int M, int N, int G_, int c_) { nM = M / BM; nN = N / BM; nwg = nM * nN; G = G_; c = c_; }
    __host__ __device__ bool next(int i, Unit& u) const {
        const long L = (long)i * G + c; if (L >= nwg) return false;
        int wgid = (int)L; { const int q = nwg / NXCD, r = nwg % NXCD, xcd = wgid % NXCD, off = wgid / NXCD; wgid = (xcd < r ? xcd * (q + 1) : r * (q + 1) + (xcd - r) * q) + off; }
        const int nig = WGM * nN, gid = wgid / nig, fm = gid * WGM, gsz = (nM - fm) < WGM ? (nM - fm) : WGM;
        u.pm = fm + ((wgid % nig) % gsz); u.pn = (wgid % nig) / gsz; return true;
    }
    __device__ __forceinline__ void a_ready(const Unit&) const {}
    __device__ __forceinline__ void done(const Unit&) const {}
};
__device__ __forceinline__ unsigned cvt_pk_bf16(float lo, float hi) { unsigned r; asm volatile("v_cvt_pk_bf16_f32 %0, %1, %2" : "=v"(r) : "v"(lo), "v"(hi)); return r; }
template <class Epi, class Sched, bool ALIGN_EPI = false, bool SP2 = false>
__device__ __forceinline__ void gemm_phase(PG8_LAS unsigned char* lds, const Gemm g, const Sched& S, const Epi& E) {
    int tid = threadIdx.x; asm volatile("" : "+v"(tid)); const int wid = __builtin_amdgcn_readfirstlane(tid >> 6), lane = tid & 63, wr = wid >> 2, wc = wid & 3, fr = lane & 15, fq = lane >> 4;
    const int K = g.K, nt = K / BK;
    unsigned voffA[2], voffB[2];
#pragma unroll
    for (int i = 0; i < 2; ++i) { int R, C; stage_rc(tid * 16 + i * 8192, R, C); const int Rb = Epi::PERM ? ((R & ~31) + perm32(R & 31)) : R;
        voffA[i] = (unsigned)(R * K + C) * 2u; voffB[i] = (unsigned)(Rb * K + C) * 2u; }
    const size_t kstep = (size_t)(BK * 2);
    const size_t hstep = (size_t)HALF * K * 2;
    const size_t tstep = 2 * hstep;
    const unsigned ldsw = (unsigned)wid * 1024u;
    const int aoff = lds_byte(wr * 64 + fr, fq * 8), boff = lds_byte(wc * 32 + fr, fq * 8);
#define PG8_SA(b, h) (((b) * 2 + (h)) * HTB)
#define PG8_SB(b, h) ((4 + (b) * 2 + (h)) * HTB)
#define PG8_STAGE(bufoff, gbase, voff) do { _Pragma("unroll") for (int _i = 0; _i < 2; ++_i) \
        __builtin_amdgcn_global_load_lds((const unsigned*)((const char*)(gbase) + (voff)[_i]), (PG8_LAS unsigned*)(lds + (bufoff) + ldsw + _i * 8192), 16, 0, 0); } while (0)
#define PG8_LDA(dst, b, h) do { _Pragma("unroll") for (int m = 0; m < 4; ++m) _Pragma("unroll") for (int k = 0; k < 2; ++k) dst[m][k] = *(const PG8_LAS bf16x8*)(lds + PG8_SA(b, h) + aoff + m * 2048 + k * 1024); } while (0)
#define PG8_LDB(dst, b, h) do { _Pragma("unroll") for (int n = 0; n < 2; ++n) _Pragma("unroll") for (int k = 0; k < 2; ++k) dst[n][k] = *(const PG8_LAS bf16x8*)(lds + PG8_SB(b, h) + boff + n * 2048 + k * 1024); } while (0)
#define PG8_MMA(ai, bj, At, Bt) do { __builtin_amdgcn_s_setprio(1); _Pragma("unroll") for (int m = 0; m < 4; ++m) _Pragma("unroll") for (int n = 0; n < 2; ++n) _Pragma("unroll") for (int k = 0; k < 2; ++k) \
        acc[ai][bj][m][n] = __builtin_amdgcn_mfma_f32_16x16x32_bf16(Bt[n][k], At[m][k], acc[ai][bj][m][n], 0, 0, 0); __builtin_amdgcn_s_setprio(0); } while (0)
#define PG8_WAIT_V(n) asm volatile("s_waitcnt vmcnt(" #n ")" ::: "memory")
#define PG8_WAIT_L(n) asm volatile("s_waitcnt lgkmcnt(" #n ")" ::: "memory")
#define PG8_BAR __builtin_amdgcn_s_barrier()
#define PG8_SCHED __builtin_amdgcn_sched_barrier(0)
    Unit cur, nxt; int ui = 0;
    if (!S.next(0, cur)) return;
    f32x4 acc[2][2][4][2];
#pragma unroll
    for (int a = 0; a < 2; ++a)
#pragma unroll
        for (int b = 0; b < 2; ++b)
#pragma unroll
            for (int m = 0; m < 4; ++m)
#pragma unroll
                for (int n = 0; n < 2; ++n) acc[a][b][m][n] = (f32x4){0.f, 0.f, 0.f, 0.f};
    bf16x8 At[4][2], B0[2][2], B1[2][2];
    const char* cA = (const char*)g.A + (size_t)cur.pm * tstep; const char* cB = (const char*)g.Bt + (size_t)cur.pn * tstep;
    S.a_ready(cur);
    if constexpr (SP2) {
        PG8_STAGE(PG8_SB(0, 0), cB, voffB); PG8_STAGE(PG8_SB(0, 1), cB + hstep, voffB); PG8_STAGE(PG8_SA(0, 0), cA, voffA); PG8_STAGE(PG8_SA(0, 1), cA + hstep, voffA);
        if (wr == 1) PG8_BAR;
        PG8_WAIT_V(2); PG8_BAR;
        PG8_STAGE(PG8_SB(1, 0), cB + kstep, voffB); PG8_STAGE(PG8_SA(1, 0), cA + kstep, voffA); PG8_STAGE(PG8_SB(1, 1), cB + hstep + kstep, voffB);
        PG8_WAIT_V(6); PG8_BAR;
    } else {
        PG8_STAGE(PG8_SB(0, 0), cB, voffB); PG8_STAGE(PG8_SA(0, 0), cA, voffA); PG8_STAGE(PG8_SB(0, 1), cB + hstep, voffB); PG8_STAGE(PG8_SA(0, 1), cA + hstep, voffA);
        if (wr == 1) PG8_BAR;
        PG8_WAIT_V(4); PG8_BAR;
        PG8_STAGE(PG8_SB(1, 0), cB + kstep, voffB); PG8_STAGE(PG8_SA(1, 0), cA + kstep, voffA); PG8_STAGE(PG8_SB(1, 1), cB + hstep + kstep, voffB);
        PG8_WAIT_V(6); PG8_BAR;
    }
    for (;;) {
        const bool has_next = S.next(ui + 1, nxt);
        const char* nA = has_next ? (const char*)g.A + (size_t)nxt.pm * tstep : cA; const char* nB = has_next ? (const char*)g.Bt + (size_t)nxt.pn * tstep : cB;
        for (int t = 0; t < nt; t += 2) {
            const bool last = (t == nt - 2);
            const char* a1 = cA + (size_t)(t + 1) * kstep;
            const char* a2 = last ? nA : cA + (size_t)(t + 2) * kstep; const char* b2 = last ? nB : cB + (size_t)(t + 2) * kstep;
            const char* a3 = a2 + kstep; const char* b3 = b2 + kstep;
            if (last && has_next) S.a_ready(nxt);
            if constexpr (SP2) {
            PG8_LDB(B0, 0, 0); PG8_LDB(B1, 0, 1); PG8_SCHED; PG8_LDA(At, 0, 0); PG8_STAGE(PG8_SA(1, 1), a1 + hstep, voffA);
            PG8_WAIT_V(8); PG8_WAIT_L(0); PG8_BAR; PG8_MMA(0, 0, At, B0); PG8_MMA(0, 1, At, B1); PG8_BAR; PG8_SCHED;
            PG8_LDA(At, 0, 1); PG8_STAGE(PG8_SB(0, 0), b2, voffB); PG8_STAGE(PG8_SB(0, 1), b2 + hstep, voffB); PG8_STAGE(PG8_SA(0, 0), a2, voffA);
            PG8_WAIT_V(8); PG8_WAIT_L(0); PG8_BAR; PG8_MMA(1, 0, At, B0); PG8_MMA(1, 1, At, B1); PG8_BAR; PG8_SCHED;
            PG8_LDB(B0, 1, 0); PG8_LDB(B1, 1, 1); PG8_SCHED; PG8_LDA(At, 1, 0); PG8_STAGE(PG8_SA(0, 1), a2 + hstep, voffA);
            PG8_WAIT_V(8); PG8_WAIT_L(0); PG8_BAR; PG8_MMA(0, 0, At, B0); PG8_MMA(0, 1, At, B1); PG8_BAR; PG8_SCHED;
            PG8_LDA(At, 1, 1); PG8_STAGE(PG8_SB(1, 0), b3, voffB); PG8_STAGE(PG8_SB(1, 1), b3 + hstep, voffB); PG8_STAGE(PG8_SA(1, 0), a3, voffA);
            PG8_WAIT_V(8); PG8_WAIT_L(0); PG8_BAR; PG8_MMA(1, 0, At, B0); PG8_MMA(1, 1, At, B1); PG8_BAR; PG8_SCHED;
            } else {
            PG8_LDB(B0, 0, 0); PG8_SCHED; PG8_LDA(At, 0, 0); PG8_STAGE(PG8_SA(1, 1), a1 + hstep, voffA);
            PG8_WAIT_L(8); PG8_BAR; PG8_WAIT_L(0); PG8_MMA(0, 0, At, B0); PG8_BAR; PG8_SCHED;
            PG8_LDB(B1, 0, 1); PG8_STAGE(PG8_SB(0, 0), b2, voffB);
            PG8_BAR; PG8_WAIT_L(0); PG8_MMA(0, 1, At, B1); PG8_BAR;
            PG8_LDA(At, 0, 1); PG8_STAGE(PG8_SA(0, 0), a2, voffA);
            PG8_BAR; PG8_WAIT_L(0); PG8_MMA(1, 0, At, B0); PG8_BAR; PG8_SCHED;
            PG8_STAGE(PG8_SB(0, 1), b2 + hstep, voffB);
            PG8_WAIT_V(6); PG8_BAR; PG8_MMA(1, 1, At, B1); PG8_BAR;
            PG8_LDB(B0, 1, 0); PG8_SCHED; PG8_LDA(At, 1, 0); PG8_STAGE(PG8_SA(0, 1), a2 + hstep, voffA);
            PG8_WAIT_L(8); PG8_BAR; PG8_WAIT_L(0); PG8_MMA(0, 0, At, B0); PG8_BAR; PG8_SCHED;
            PG8_LDB(B1, 1, 1); PG8_STAGE(PG8_SB(1, 0), b3, voffB);
            PG8_BAR; PG8_WAIT_L(0); PG8_MMA(0, 1, At, B1); PG8_BAR;
            PG8_LDA(At, 1, 1); PG8_STAGE(PG8_SA(1, 0), a3, voffA);
            PG8_BAR; PG8_WAIT_L(0); PG8_MMA(1, 0, At, B0); PG8_BAR; PG8_SCHED;
            PG8_STAGE(PG8_SB(1, 1), b3 + hstep, voffB);
            PG8_WAIT_V(6); PG8_BAR; PG8_MMA(1, 1, At, B1); PG8_BAR;
            }
        }
        if constexpr (ALIGN_EPI) { if (wr == 0) PG8_BAR; }
        if constexpr (!Epi::AFTER_DRAIN) { E(acc, cur, wr, wc, fr, fq); S.done(cur); }
        if (!has_next) break;
#pragma unroll
        for (int a = 0; a < 2; ++a)
#pragma unroll
            for (int b = 0; b < 2; ++b)
#pragma unroll
                for (int m = 0; m < 4; ++m)
#pragma unroll
                    for (int n = 0; n < 2; ++n) acc[a][b][m][n] = (f32x4){0.f, 0.f, 0.f, 0.f};
        cur = nxt; cA = nA; cB = nB; ++ui;
        if constexpr (ALIGN_EPI) { if (wr == 1) PG8_BAR; }
    }
    PG8_WAIT_V(0);
    if constexpr (!ALIGN_EPI) { if (wr == 0) PG8_BAR; }
    PG8_BAR;
    if constexpr (Epi::AFTER_DRAIN) { E.fused(acc, cur, wr, wc, fr, fq, lds, wid, lane); S.done(cur); }
#undef PG8_SA
#undef PG8_SB
#undef PG8_STAGE
#undef PG8_LDA
#undef PG8_LDB
#undef PG8_MMA
#undef PG8_WAIT_V
#undef PG8_WAIT_L
#undef PG8_BAR
#undef PG8_SCHED
}
}

#define LAS __attribute__((address_space(3)))
#define GAS __attribute__((address_space(1)))
typedef unsigned char uchar;
typedef pg8::bf16_t bf16_t;
typedef pg8::bf16x8 bf16x8;
typedef pg8::f32x4 f32x4;
typedef pg8::u32x4 u32x4;
typedef unsigned u32x2 __attribute__((ext_vector_type(2)));
typedef float f32x2 __attribute__((ext_vector_type(2)));
typedef float f32x16 __attribute__((ext_vector_type(16)));
typedef __bf16 bf16x2_t __attribute__((ext_vector_type(2)));

constexpr int NB = 16, SEQ = 4096, T = NB * SEQ, DM = 1024, FF = 2816, MEML = 256, TM = NB * MEML;
constexpr int NPROJ = 3328, PLD = 3072;
constexpr int PC_Z = 0, PC_X = 512, PC_B = 1024, PC_C = 1280, PC_Q = 1536, PC_K = 2048, PC_V = 2560;
constexpr float EPS = 1e-5f, LOG2E = 1.4426950408889634f;
constexpr float LAMBDA_INIT = 0.2f;

constexpr size_t MiB = 1u << 20;
constexpr size_t WS_CTL = 0, WS_ROPE = 1 * MiB, WS_SS0 = 2 * MiB, WS_SS1 = 6 * MiB, WS_SS2 = 10 * MiB, WS_SS3 = 14 * MiB, WS_SS4 = 18 * MiB, WS_SSM = 22 * MiB,
                 WS_DT = 23 * MiB, WS_WGU1 = 27 * MiB, WS_WD1 = 38 * MiB, WS_WIN = 44 * MiB, WS_WOUT = 51 * MiB, WS_WQ = 53 * MiB, WS_WKV = 55 * MiB, WS_WO = 59 * MiB,
                 WS_WGU2 = 61 * MiB, WS_WD2 = 72 * MiB, WS_MEMB = 78 * MiB, WS_KVX = 86 * MiB, WS_VTX = 102 * MiB, WS_VT = 110 * MiB, WS_XB = 174 * MiB,
                 WS_YMIX = 302 * MiB, WS_YFB = 430 * MiB, WS_BIG = 558 * MiB, WS_END = 942 * MiB;
constexpr int LDS_BYTES = 147456, PTAB_OFF = LDS_BYTES - 512, LDS_PTAB_ABS = PTAB_OFF;

__device__ __forceinline__ const GAS float* lds_inp(int k) {
    const LAS unsigned long long* ptab = (const LAS unsigned long long*)(uintptr_t)0; const unsigned long long v = *(const LAS unsigned long long*)((const LAS uchar*)ptab + LDS_PTAB_ABS + 8 * k);
    return (const GAS float*)(((unsigned long long)(unsigned)__builtin_amdgcn_readfirstlane((int)(v >> 32)) << 32) | (unsigned long long)(unsigned)__builtin_amdgcn_readfirstlane((int)(v & 0xffffffffull)));
}
__device__ __forceinline__ int opaque_tid() { int t = threadIdx.x; asm volatile("" : "+v"(t)); return t; }
__device__ __forceinline__ unsigned cvtpk(float lo, float hi) { f32x2 v = {lo, hi}; bf16x2_t b = __builtin_convertvector(v, bf16x2_t); return __builtin_bit_cast(unsigned, b); }
__device__ __forceinline__ float bflo(unsigned w) { return __uint_as_float(w << 16); }
__device__ __forceinline__ float bfhi(unsigned w) { return __uint_as_float(w & 0xffff0000u); }
__device__ __forceinline__ float wave_sum(float v) {
#pragma unroll
    for (int o = 1; o < 64; o <<= 1) v += __shfl_xor(v, o);
    return v;
}
__device__ __forceinline__ float fast_exp2(float x) { return __builtin_amdgcn_exp2f(x); }
__device__ __forceinline__ float silu_f(float g) { return g * __builtin_amdgcn_rcpf(1.0f + fast_exp2(-LOG2E * g)); }
__device__ __forceinline__ float row_rs(const GAS float* part, int row) {
    const GAS f32x4* p = (const GAS f32x4*)(part + (size_t)row * 16);
    const f32x4 a = p[0], b = p[1], c = p[2], d = p[3];
    const float s = (((a[0] + a[1]) + (a[2] + a[3])) + ((b[0] + b[1]) + (b[2] + b[3]))) + (((c[0] + c[1]) + (c[2] + c[3])) + ((d[0] + d[1]) + (d[2] + d[3])));
    return 1.0f / sqrtf(s * (1.0f / 1024.0f) + EPS);
}

constexpr int RS_OFF = 131072;
__device__ __forceinline__ void rows_rs8(int pm, int rloc0, float scale, float (&rs)[8]) {
    const LAS int* pid = (const LAS int*)((const LAS uchar*)(uintptr_t)0 + RS_OFF + 4096);
    const int slot = (pid[0] == pm) ? 0 : (pid[1] == pm) ? 1 : (pid[2] == pm) ? 2 : 3;
    const LAS float* t = (const LAS float*)((const LAS uchar*)(uintptr_t)0 + RS_OFF) + slot * 256 + rloc0;
#pragma unroll
    for (int i = 0; i < 8; ++i) rs[i] = t[(i >> 2) * 128 + (i & 3) * 16] * scale;
}
struct EpiBf16RS {
    static constexpr bool PERM = true, AFTER_DRAIN = false;
    const GAS float* part; float scale; GAS bf16_t* O; int ldc;
    __device__ __forceinline__ void operator()(const f32x4 (&acc)[2][2][4][2], const pg8::Unit& u, int wr, int wc, int fr, int fq) const {
        const int row0 = u.pm * 256 + wr * 64 + fr, col0 = u.pn * 256 + wc * 32 + 8 * fq;
        float rs8[8]; rows_rs8(u.pm, wr * 64 + fr, scale, rs8);
#pragma unroll
        for (int ai = 0; ai < 2; ++ai)
#pragma unroll
            for (int m = 0; m < 4; ++m) {
                const int row = row0 + ai * 128 + m * 16; const float rs = rs8[ai * 4 + m]; GAS bf16_t* rp = O + (size_t)row * ldc + col0;
#pragma unroll
                for (int bj = 0; bj < 2; ++bj) { const f32x4 v0 = acc[ai][bj][m][0] * rs, v1 = acc[ai][bj][m][1] * rs;
                    u32x4 w; w.x = cvtpk(v0[0], v0[1]); w.y = cvtpk(v0[2], v0[3]); w.z = cvtpk(v1[0], v1[1]); w.w = cvtpk(v1[2], v1[3]);
                    *(GAS u32x4*)(rp + bj * 128) = w; }
            }
    }
};
struct EpiSwiGLU {
    static constexpr bool PERM = true, AFTER_DRAIN = false;
    const GAS float* part; GAS bf16_t* U;
    __device__ __forceinline__ void operator()(const f32x4 (&acc)[2][2][4][2], const pg8::Unit& u, int wr, int wc, int fr, int fq) const {
        const int row0 = u.pm * 256 + wr * 64 + fr, col0 = u.pn * 128 + wc * 32 + 8 * fq;
        float rs8[8]; rows_rs8(u.pm, wr * 64 + fr, 1.0f, rs8);
#pragma unroll
        for (int ai = 0; ai < 2; ++ai)
#pragma unroll
            for (int m = 0; m < 4; ++m) {
                const int row = row0 + ai * 128 + m * 16; const float rs = rs8[ai * 4 + m];
                float h[8];
#pragma unroll
                for (int n = 0; n < 2; ++n)
#pragma unroll
                    for (int e = 0; e < 4; ++e) { const float g = acc[ai][0][m][n][e] * rs, up = acc[ai][1][m][n][e] * rs; h[4 * n + e] = silu_f(g) * up; }
                u32x4 w; w.x = cvtpk(h[0], h[1]); w.y = cvtpk(h[2], h[3]); w.z = cvtpk(h[4], h[5]); w.w = cvtpk(h[6], h[7]);
                __builtin_nontemporal_store(w, (GAS u32x4*)(U + (size_t)row * FF + col0));
            }
    }
};
struct EpiResidual {
    static constexpr bool PERM = true, AFTER_DRAIN = false;
    float alpha; GAS bf16_t* xb; GAS float* part;
    __device__ __forceinline__ void operator()(const f32x4 (&acc)[2][2][4][2], const pg8::Unit& u, int wr, int wc, int fr, int fq) const {
        const int row0 = u.pm * 256 + wr * 64 + fr, col0 = u.pn * 256 + wc * 32 + 8 * fq;
#pragma unroll
        for (int ai = 0; ai < 2; ++ai)
#pragma unroll
            for (int m = 0; m < 4; ++m) {
                const int row = row0 + ai * 128 + m * 16; float ss = 0.f;
#pragma unroll
                for (int bj = 0; bj < 2; ++bj) { const size_t off = (size_t)row * DM + col0 + bj * 128;
                    const u32x4 rv = *(const GAS u32x4*)(xb + off);
                    f32x4 v0, v1; v0[0] = bflo(rv.x); v0[1] = bfhi(rv.x); v0[2] = bflo(rv.y); v0[3] = bfhi(rv.y); v1[0] = bflo(rv.z); v1[1] = bfhi(rv.z); v1[2] = bflo(rv.w); v1[3] = bfhi(rv.w);
                    v0 = v0 + acc[ai][bj][m][0] * alpha; v1 = v1 + acc[ai][bj][m][1] * alpha;
                    u32x4 w; w.x = cvtpk(v0[0], v0[1]); w.y = cvtpk(v0[2], v0[3]); w.z = cvtpk(v1[0], v1[1]); w.w = cvtpk(v1[2], v1[3]); *(GAS u32x4*)(xb + off) = w;
                    ss += ((v0[0] * v0[0] + v0[1] * v0[1]) + (v0[2] * v0[2] + v0[3] * v0[3])) + ((v1[0] * v1[0] + v1[1] * v1[1]) + (v1[2] * v1[2] + v1[3] * v1[3])); }
                ss += __shfl_xor(ss, 16); ss += __shfl_xor(ss, 32);
                if (fq == 0) part[(size_t)row * 16 + u.pn * 4 + wc] = ss;
            }
    }
};
struct EpiProj {
    static constexpr bool PERM = true, AFTER_DRAIN = false;
    const GAS float* part; GAS bf16_t* P; GAS float* DT; const GAS float* cs; const GAS float* sn; const GAS float* dtb_f; const GAS float* dtb_b;
    __device__ __forceinline__ void operator()(const f32x4 (&acc)[2][2][4][2], const pg8::Unit& u, int wr, int wc, int fr, int fq) const {
        const int pn = u.pn; const int row0 = u.pm * 256 + wr * 64 + fr;
        const bool isq = (pn == 6 || pn == 7), isk = (pn == 8 || pn == 9), rope = (isq || isk) && ((wc & 1) == 0);
        const float qs = isq ? 0.125f * LOG2E : 1.0f; const float sgn = (fq == 0) ? -1.f : 1.f;
        float rs8[8]; rows_rs8(u.pm, wr * 64 + fr, qs, rs8);
        if (pn == 12) {
            if (wc == 0 && fq < 2) {
                const GAS float* bias = (fq == 0) ? dtb_f : dtb_b;
#pragma unroll
                for (int ai = 0; ai < 2; ++ai)
#pragma unroll
                    for (int m = 0; m < 4; ++m) { const int row = row0 + ai * 128 + m * 16; const float rs = rs8[ai * 4 + m];
#pragma unroll
                        for (int n = 0; n < 2; ++n) { f32x4 o;
#pragma unroll
                            for (int e = 0; e < 4; ++e) { const float x = acc[ai][0][m][n][e] * rs + bias[4 * n + e]; o[e] = x > 20.f ? x : log1pf(__expf(x)); }
                            *(GAS f32x4*)(DT + (size_t)row * 16 + 8 * fq + 4 * n) = o; } }
            }
            return;
        }
        const int col0 = pn * 256 + wc * 32 + 8 * fq;
#pragma unroll
        for (int ai = 0; ai < 2; ++ai)
#pragma unroll
            for (int m = 0; m < 4; ++m) {
                const int row = row0 + ai * 128 + m * 16; const float rs = rs8[ai * 4 + m]; const int pos = row & (SEQ - 1);
                GAS bf16_t* rp = P + (size_t)row * PLD + col0;
#pragma unroll
                for (int bj = 0; bj < 2; ++bj) { f32x4 v0 = acc[ai][bj][m][0], v1 = acc[ai][bj][m][1];
                    if (rope) { f32x4 p0, p1;
#pragma unroll
                        for (int e = 0; e < 4; ++e) { p0[e] = __shfl_xor(v0[e], 16); p1[e] = __shfl_xor(v1[e], 16); }
                        if (fq < 2) { const f32x4 c0 = *(const GAS f32x4*)(cs + pos * 8), c1 = *(const GAS f32x4*)(cs + pos * 8 + 4), s0 = *(const GAS f32x4*)(sn + pos * 8), s1 = *(const GAS f32x4*)(sn + pos * 8 + 4);
                            v0 = v0 * c0 + p0 * s0 * sgn; v1 = v1 * c1 + p1 * s1 * sgn; } }
                    v0 = v0 * rs; v1 = v1 * rs;
                    u32x4 w; w.x = cvtpk(v0[0], v0[1]); w.y = cvtpk(v0[2], v0[3]); w.z = cvtpk(v1[0], v1[1]); w.w = cvtpk(v1[2], v1[3]);
                    __builtin_nontemporal_store(w, (GAS u32x4*)(rp + bj * 128)); }
            }
    }
};
struct EpiAny {
    static constexpr bool PERM = true, AFTER_DRAIN = false;
    int kind; GAS unsigned char* ws; float scale; unsigned part_off, o_off, opart_off; int ldc;
    __device__ __forceinline__ void operator()(const f32x4 (&acc)[2][2][4][2], const pg8::Unit& u, int wr, int wc, int fr, int fq) const {
        if (kind == 0) { EpiBf16RS e{(const GAS float*)(ws + part_off), scale, (GAS bf16_t*)(ws + o_off), ldc}; e(acc, u, wr, wc, fr, fq); }
        else if (kind == 1) { EpiSwiGLU e{(const GAS float*)(ws + part_off), (GAS bf16_t*)(ws + o_off)}; e(acc, u, wr, wc, fr, fq); }
        else if (kind == 2) { EpiResidual e{scale, (GAS bf16_t*)(ws + WS_XB), (GAS float*)(ws + opart_off)}; e(acc, u, wr, wc, fr, fq); }
        else { EpiProj e{(const GAS float*)(ws + part_off), (GAS bf16_t*)(ws + o_off), (GAS float*)(ws + WS_DT), (const GAS float*)(ws + WS_ROPE), (const GAS float*)(ws + WS_ROPE) + SEQ * 8, lds_inp(10), lds_inp(11)}; e(acc, u, wr, wc, fr, fq); }
    }
};
struct GJob { const GAS bf16_t* A; const GAS bf16_t* Bt; int M, N, K; EpiAny E; };
template <class Epi> __device__ __forceinline__ void run_gemm(LAS uchar* lds, const GAS bf16_t* A, const GAS bf16_t* Bt, int M, int N, int K, const Epi& E, const GAS float* part) {
    pg8::Gemm g{(const bf16_t*)A, (const bf16_t*)Bt, M, N, K}; pg8::StaticOrder S; S.init(M, N, (int)gridDim.x, (int)blockIdx.x);
    if (part) {
        int p0 = -1, p1 = -1, p2 = -1, p3 = -1; pg8::Unit u;
        for (int i = 0; S.next(i, u); ++i) { const int pm = u.pm; if (pm == p0 || pm == p1 || pm == p2 || pm == p3) continue; if (p0 < 0) p0 = pm; else if (p1 < 0) p1 = pm; else if (p2 < 0) p2 = pm; else p3 = pm; }
        const int tid = opaque_tid(), r = tid >> 1, hf = tid & 1;
        LAS float* rsT = (LAS float*)(lds + RS_OFF); LAS int* pid = (LAS int*)(lds + RS_OFF + 4096);
        f32x4 v[4][2];
#pragma unroll
        for (int sl = 0; sl < 4; ++sl) { const int pm = sl == 0 ? p0 : sl == 1 ? p1 : sl == 2 ? p2 : p3; const int pmc = pm < 0 ? 0 : pm;
            const GAS f32x4* src = (const GAS f32x4*)(part + ((size_t)pmc * 256 + r) * 16 + 8 * hf); v[sl][0] = src[0]; v[sl][1] = src[1]; }
#pragma unroll
        for (int sl = 0; sl < 4; ++sl) { float sm = ((v[sl][0][0] + v[sl][0][1]) + (v[sl][0][2] + v[sl][0][3])) + ((v[sl][1][0] + v[sl][1][1]) + (v[sl][1][2] + v[sl][1][3]));
            sm += __shfl_xor(sm, 1); if (hf == 0) rsT[sl * 256 + r] = 1.0f / sqrtf(sm * (1.0f / 1024.0f) + EPS); }
        if (tid == 0) { pid[0] = p0; pid[1] = p1; pid[2] = p2; pid[3] = p3; }
        __syncthreads();
    }
    pg8::gemm_phase<Epi, pg8::StaticOrder, true, true>(lds, g, S, E);
    __syncthreads();
}

__device__ __forceinline__ int map_row(int kind, int n) {
    if (kind == 1) return (n >> 7) * 256 + (n & 127);
    if (kind == 2) return (n >> 7) * 256 + 128 + (n & 127);
    if (kind == 3) return n < 1536 ? n : (n < 1552 ? 3072 + (n - 1536) : n - 16);
    return n;
}
__device__ __forceinline__ void p0_transpose_item(const GAS float* W, int K, int N, GAS bf16_t* WT, int kind, const GAS float* g, LAS float* scr, int item, int lane) {
    const int nblk = (N + 31) >> 5, kb = item / nblk, nb = item - kb * nblk, k0 = 64 * kb, n0 = 32 * nb;
    const int ncol = n0 + (lane & 31); const bool valid = ncol < N;
    float wv[32];
#pragma unroll
    for (int i = 0; i < 32; ++i) { const int kk = 2 * i + (lane >> 5); wv[i] = valid ? W[(size_t)(k0 + kk) * N + ncol] : 0.f; }
    if (g) {
        float gv[32];
#pragma unroll
        for (int i = 0; i < 32; ++i) gv[i] = g[k0 + 2 * i + (lane >> 5)];
#pragma unroll
        for (int i = 0; i < 32; ++i) wv[i] *= gv[i];
    }
#pragma unroll
    for (int i = 0; i < 32; ++i) { const int kk = 2 * i + (lane >> 5); scr[kk * 33 + (lane & 31)] = wv[i]; }
    asm volatile("s_waitcnt lgkmcnt(0)" ::: "memory");
    const int c = lane & 7;
#pragma unroll
    for (int j = 0; j < 4; ++j) { const int n = (lane >> 3) + 8 * j; const LAS float* s = scr + (8 * c) * 33 + n;
        if (n0 + n < N) { u32x4 o; o.x = cvtpk(s[0 * 33], s[1 * 33]); o.y = cvtpk(s[2 * 33], s[3 * 33]); o.z = cvtpk(s[4 * 33], s[5 * 33]); o.w = cvtpk(s[6 * 33], s[7 * 33]);
            *(GAS u32x4*)(WT + (size_t)map_row(kind, n0 + n) * K + k0 + 8 * c) = o; } }
    asm volatile("s_waitcnt lgkmcnt(0)" ::: "memory");
}
__device__ __forceinline__ void rows4_to_bf16_ss(const GAS float* x, GAS bf16_t* o, GAS float* part, int row, int lane) {
    f32x4 v[4][4]; float sm[4];
#pragma unroll
    for (int r = 0; r < 4; ++r)
#pragma unroll
        for (int j = 0; j < 4; ++j) v[r][j] = ((const GAS f32x4*)(x + (size_t)(row + r) * DM))[lane + 64 * j];
#pragma unroll
    for (int r = 0; r < 4; ++r) { float a = 0.f;
#pragma unroll
        for (int j = 0; j < 4; ++j) a += (v[r][j][0] * v[r][j][0] + v[r][j][1] * v[r][j][1]) + (v[r][j][2] * v[r][j][2] + v[r][j][3] * v[r][j][3]);
        sm[r] = wave_sum(a); }
#pragma unroll
    for (int r = 0; r < 4; ++r) {
#pragma unroll
        for (int j = 0; j < 4; ++j) { u32x2 w; w.x = cvtpk(v[r][j][0], v[r][j][1]); w.y = cvtpk(v[r][j][2], v[r][j][3]); ((GAS u32x2*)(o + (size_t)(row + r) * DM))[lane + 64 * j] = w; }
        if (lane < 16) part[(size_t)(row + r) * 16 + lane] = (lane == 0) ? sm[r] : 0.f; }
}
__device__ __forceinline__ void rope_entry(int idx, GAS float* cs, GAS float* sn) {
    const int pos = idx >> 3, i = idx & 7;
    const float invf = (i == 0) ? 1.0f : (i == 1) ? 0.193922758102417f : (i == 2) ? 0.03760603070259094f : (i == 3) ? 0.00729266507551074f : (i == 4) ? 0.001414213445968926f
                     : (i == 5) ? 0.00027424818836152554f : (i == 6) ? 5.318296462064609e-05f : 1.0313385246263351e-05f;
    const float angf = (float)pos * invf;
    const double x = (double)angf; const double kq = rint(x * 0.6366197723675814);
    double r = fma(-kq, 1.5707963267948966, x); r = fma(-kq, 6.123233995736766e-17, r);
    const int q = ((int)kq) & 3; const double r2 = r * r;
    const double s = r * (1.0 + r2 * (-1.0 / 6 + r2 * (1.0 / 120 + r2 * (-1.0 / 5040 + r2 * (1.0 / 362880 + r2 * (-1.0 / 39916800 + r2 * (1.0 / 6227020800.0)))))));
    const double c = 1.0 + r2 * (-0.5 + r2 * (1.0 / 24 + r2 * (-1.0 / 720 + r2 * (1.0 / 40320 + r2 * (-1.0 / 3628800 + r2 * (1.0 / 479001600.0 + r2 * (-1.0 / 87178291200.0)))))));
    const double co = (q == 0) ? c : (q == 1) ? -s : (q == 2) ? -c : s;
    const double si = (q == 0) ? s : (q == 1) ? c : (q == 2) ? -s : -c;
    cs[idx] = (float)co; sn[idx] = (float)si;
}

__device__ __forceinline__ void transpose64(const GAS bf16_t* src, int sp, GAS bf16_t* dst, int dp, LAS uchar* scr, int lane) {
#pragma unroll
    for (int i = 0; i < 8; ++i) { const int r = i * 8 + (lane >> 3), c8 = lane & 7; const u32x4 v = *(const GAS u32x4*)(src + (size_t)r * sp + c8 * 8);
        LAS unsigned* w = (LAS unsigned*)(scr + r * 132 + c8 * 16); w[0] = v.x; w[1] = v.y; w[2] = v.z; w[3] = v.w; }
    asm volatile("s_waitcnt lgkmcnt(0)" ::: "memory");
#pragma unroll
    for (int i = 0; i < 8; ++i) { const int c = i * 8 + (lane >> 3), r8 = lane & 7; unsigned e[8];
#pragma unroll
        for (int j = 0; j < 8; ++j) e[j] = *(const LAS unsigned short*)(scr + (r8 * 8 + j) * 132 + c * 2);
        u32x4 o; o.x = e[0] | (e[1] << 16); o.y = e[2] | (e[3] << 16); o.z = e[4] | (e[5] << 16); o.w = e[6] | (e[7] << 16);
        *(GAS u32x4*)(dst + (size_t)c * dp + r8 * 8) = o; }
    asm volatile("s_waitcnt lgkmcnt(0)" ::: "memory");
}
__device__ __forceinline__ void conv_item(const GAS bf16_t* P, const GAS float* cw, const GAS float* cb, GAS bf16_t* XC, GAS bf16_t* XT, GAS bf16_t* BT, LAS uchar* scr, int item, int lane) {
    unsigned oz = 0u; asm volatile("" : "+v"(oz));
    const int cb16 = item & 15, tt = item >> 4, tok0 = tt * 64, s0 = tok0 & (SEQ - 1), b = tok0 >> 12, ci = s0 >> 7, l0 = s0 & 127;
    const int c8 = lane & 7, tb = lane >> 3, ch = cb16 * 64 + c8 * 8;
    float w[5][8], bias[8];
#pragma unroll
    for (int k = 0; k < 5; ++k) { const f32x4 a = *(const GAS f32x4*)(cw + k * 1024 + ch), bq = *(const GAS f32x4*)(cw + k * 1024 + ch + 4);
#pragma unroll
        for (int e = 0; e < 4; ++e) { w[k][e] = a[e]; w[k][4 + e] = bq[e]; } }
    { const f32x4 a = *(const GAS f32x4*)(cb + ch), bq = *(const GAS f32x4*)(cb + ch + 4);
#pragma unroll
      for (int e = 0; e < 4; ++e) { bias[e] = a[e]; bias[4 + e] = bq[e]; } }
    const int sb = s0 + tb * 8;
    const GAS bf16_t* src = P + (size_t)(tok0 + tb * 8) * PLD + PC_X + ch;
    float win[5][8];
#pragma unroll
    for (int j = 0; j < 4; ++j) { const int sq = sb + j - 2; u32x4 v = {oz, oz, oz, oz}; if (sq >= 0 && sq < SEQ) v = *(const GAS u32x4*)(src + (ptrdiff_t)(j - 2) * PLD);
        win[j][0] = bflo(v.x); win[j][1] = bfhi(v.x); win[j][2] = bflo(v.y); win[j][3] = bfhi(v.y); win[j][4] = bflo(v.z); win[j][5] = bfhi(v.z); win[j][6] = bflo(v.w); win[j][7] = bfhi(v.w); }
#pragma unroll
    for (int i = 0; i < 8; ++i) {
        { const int sq = sb + i + 2; u32x4 v = {oz, oz, oz, oz}; if (sq < SEQ) v = *(const GAS u32x4*)(src + (ptrdiff_t)(i + 2) * PLD);
          float* d = win[(i + 4) % 5];
          d[0] = bflo(v.x); d[1] = bfhi(v.x); d[2] = bflo(v.y); d[3] = bfhi(v.y); d[4] = bflo(v.z); d[5] = bfhi(v.z); d[6] = bflo(v.w); d[7] = bfhi(v.w); }
        float o[8];
#pragma unroll
        for (int e = 0; e < 8; ++e) { float acc = bias[e];
#pragma unroll
            for (int k = 0; k < 5; ++k) acc += w[k][e] * win[(i + k) % 5][e];
            o[e] = silu_f(acc); }
        u32x4 ov; ov.x = cvtpk(o[0], o[1]); ov.y = cvtpk(o[2], o[3]); ov.z = cvtpk(o[4], o[5]); ov.w = cvtpk(o[6], o[7]);
        *(GAS u32x4*)(XC + (size_t)(tok0 + tb * 8 + i) * 1024 + ch) = ov;
        LAS unsigned* wq = (LAS unsigned*)(scr + (tb * 8 + i) * 132 + c8 * 16); wq[0] = ov.x; wq[1] = ov.y; wq[2] = ov.z; wq[3] = ov.w;
    }
    asm volatile("s_waitcnt lgkmcnt(0)" ::: "memory");
    if (cb16 < 12) {
        GAS bf16_t* dst = (cb16 < 8) ? XT + ((size_t)((b * 32 + ci) * 8 + cb16) * 64) * 128 + l0
                                 : BT + ((size_t)((b * 32 + ci) * 2 + ((cb16 - 8) >> 1)) * 128 + ((cb16 - 8) & 1) * 64) * 128 + l0;
#pragma unroll
        for (int i = 0; i < 8; ++i) { const int c = i * 8 + (lane >> 3), r8 = lane & 7; unsigned e[8];
#pragma unroll
            for (int j = 0; j < 8; ++j) e[j] = *(const LAS unsigned short*)(scr + (r8 * 8 + j) * 132 + c * 2);
            u32x4 ov; ov.x = e[0] | (e[1] << 16); ov.y = e[2] | (e[3] << 16); ov.z = e[4] | (e[5] << 16); ov.w = e[6] | (e[7] << 16);
            *(GAS u32x4*)(dst + (size_t)c * 128 + r8 * 8) = ov; }
    }
    asm volatile("s_waitcnt lgkmcnt(0)" ::: "memory");
}

__device__ __forceinline__ float dpp_sum8(float v) {
    v += __builtin_bit_cast(float, __builtin_amdgcn_update_dpp(0, __builtin_bit_cast(int, v), 0xB1, 0xF, 0xF, true));
    v += __builtin_bit_cast(float, __builtin_amdgcn_update_dpp(0, __builtin_bit_cast(int, v), 0x4E, 0xF, 0xF, true));
    v += __builtin_bit_cast(float, __builtin_amdgcn_update_dpp(0, __builtin_bit_cast(int, v), 0x141, 0xF, 0xF, true));
    return v;
}
__device__ __forceinline__ void ssd_item(LAS uchar* lds, int b, int h, int dir, const GAS bf16_t* XC, const GAS float* DT, float Aneg, GAS bf16_t* Y) {
    const int tid = opaque_tid(), p = tid >> 3, nq = tid & 7, g = h >> 2;
    LAS float* sB = (LAS float*)lds;
    LAS float* sC = sB + 64 * 128;
    LAS float* sX = sC + 64 * 128;
    LAS float* sY = sX + 64 * 64;
    LAS float* sDt = sY + 64 * 64;
    LAS float* sE = sDt + 64;
    float st[16];
#pragma unroll
    for (int k = 0; k < 16; ++k) st[k] = 0.f;
    u32x4 rb[2], rc[2], rx; float rdt = 0.f;
    const size_t tokb = (size_t)b * SEQ;
#define SSD_LOAD(blk) do { const int t0_ = dir ? (SEQ - 64 - (blk) * 64) : (blk) * 64; \
        _Pragma("unroll") for (int i_ = 0; i_ < 2; ++i_) { const int id_ = tid + 512 * i_, r_ = id_ >> 4, c_ = id_ & 15; const GAS bf16_t* s_ = XC + (tokb + t0_ + r_) * 1024 + 512 + g * 128 + c_ * 8; \
            rb[i_] = *(const GAS u32x4*)s_; rc[i_] = *(const GAS u32x4*)(s_ + 256); } \
        { const int r_ = tid >> 3, c_ = tid & 7; rx = *(const GAS u32x4*)(XC + (tokb + t0_ + r_) * 1024 + h * 64 + c_ * 8); } \
        if (tid < 64) rdt = DT[(tokb + t0_ + tid) * 16 + dir * 8 + h]; } while (0)
#define SSD_ST8(dst, v) do { f32x4 a_, b_; a_[0] = bflo((v).x); a_[1] = bfhi((v).x); a_[2] = bflo((v).y); a_[3] = bfhi((v).y); b_[0] = bflo((v).z); b_[1] = bfhi((v).z); b_[2] = bflo((v).w); b_[3] = bfhi((v).w); \
        *(LAS f32x4*)(dst) = a_; *(LAS f32x4*)((dst) + 4) = b_; } while (0)
#define SSD_STORE() do { \
        _Pragma("unroll") for (int i_ = 0; i_ < 2; ++i_) { const int id_ = tid + 512 * i_, r_ = id_ >> 4, c_ = id_ & 15; SSD_ST8(sB + r_ * 128 + c_ * 8, rb[i_]); SSD_ST8(sC + r_ * 128 + c_ * 8, rc[i_]); } \
        { const int r_ = tid >> 3, c_ = tid & 7; SSD_ST8(sX + r_ * 64 + c_ * 8, rx); } \
        if (tid < 64) { sDt[tid] = rdt; sE[tid] = __expf(rdt * Aneg); } } while (0)
    SSD_LOAD(0); SSD_STORE();
    __syncthreads();
    for (int blk = 0; blk < SEQ / 64; ++blk) {
        if (blk + 1 < SEQ / 64) SSD_LOAD(blk + 1);
        for (int j = 0; j < 64; ++j) {
            const int i = dir ? 63 - j : j;
            const float e = sE[i], xdt = sX[i * 64 + p] * sDt[i];
            const LAS f32x4* bp = (const LAS f32x4*)(sB + i * 128 + nq * 16); const LAS f32x4* cp = (const LAS f32x4*)(sC + i * 128 + nq * 16);
            float acc = 0.f;
#pragma unroll
            for (int q = 0; q < 4; ++q) { const f32x4 bv = bp[q], cv = cp[q];
#pragma unroll
                for (int k = 0; k < 4; ++k) { st[4 * q + k] = st[4 * q + k] * e + xdt * bv[k]; acc += cv[k] * st[4 * q + k]; } }
            acc = dpp_sum8(acc);
            if (nq == 0) sY[i * 64 + p] = acc;
        }
        __syncthreads();
        { const int t0 = dir ? (SEQ - 64 - blk * 64) : blk * 64; const int r = tid >> 3, c = tid & 7; const LAS f32x4* yp = (const LAS f32x4*)(sY + r * 64 + c * 8); const f32x4 a = yp[0], bq = yp[1];
          u32x4 w; w.x = cvtpk(a[0], a[1]); w.y = cvtpk(a[2], a[3]); w.z = cvtpk(bq[0], bq[1]); w.w = cvtpk(bq[2], bq[3]);
          *(GAS u32x4*)(Y + (tokb + t0 + r) * 512 + h * 64 + c * 8) = w; }
        if (blk + 1 < SEQ / 64) SSD_STORE();
        __syncthreads();
    }
#undef SSD_LOAD
#undef SSD_ST8
#undef SSD_STORE
}

__device__ __forceinline__ float max3f(float a, float b, float c) { float r; asm("v_max3_f32 %0, %1, %2, %3" : "=v"(r) : "v"(a), "v"(b), "v"(c)); return r; }
__device__ __forceinline__ int crow(int r, int hi) { return (r & 3) + 8 * (r >> 2) + 4 * hi; }
#define MFMA32(a, b, c) __builtin_amdgcn_mfma_f32_32x32x16_bf16((a), (b), (c), 0, 0, 0)
constexpr int SS_ROW = 272, SS_B = 0, SS_BT = 34816, SS_C = 69632, SS_XT = 104448, SS_S = 121856, SS_SC = 139264, SS_SCB = 2064;
static_assert(SS_SC + 2 * SS_SCB <= PTAB_OFF, "SSD LDS map");
__device__ __forceinline__ void ssd_item2(LAS uchar* lds, int b, int h, int dir, const GAS bf16_t* XC, const GAS bf16_t* BT, const GAS bf16_t* XT, const GAS float* DT, float Aneg, GAS bf16_t* Y) {
    const int tid = opaque_tid(), lane = tid & 63, wid = __builtin_amdgcn_readfirstlane(tid >> 6), l31 = lane & 31, hi = lane >> 5, g = h >> 2;
    const int lt = wid < 4 ? wid : 7 - wid, pt = wid >> 2;
    f32x16 S;
#pragma unroll
    for (int r = 0; r < 16; ++r) S[r] = 0.f;
    u32x4 rB[4], rC[4], rT[4], rX[2]; float dt0 = 0.f, dt1 = 0.f;
#define S2_CI(cp) (dir ? 31 - (cp) : (cp))
#define S2_LOAD(cp) do { const int ci_ = S2_CI(cp); const size_t tok0_ = (size_t)b * SEQ + ci_ * 128; \
        _Pragma("unroll") for (int i_ = 0; i_ < 4; ++i_) { const int id_ = tid + 512 * i_, r_ = id_ >> 4, c_ = id_ & 15; const GAS bf16_t* s_ = XC + (tok0_ + r_) * 1024 + 512 + g * 128 + c_ * 8; \
            rB[i_] = *(const GAS u32x4*)s_; rC[i_] = *(const GAS u32x4*)(s_ + 256); \
            rT[i_] = *(const GAS u32x4*)(BT + ((size_t)((b * 32 + ci_) * 2 + g) * 128 + r_) * 128 + c_ * 8); } \
        _Pragma("unroll") for (int i_ = 0; i_ < 2; ++i_) { const int id_ = tid + 512 * i_, r_ = id_ >> 4, c_ = id_ & 15; rX[i_] = *(const GAS u32x4*)(XT + ((size_t)((b * 32 + ci_) * 8 + h) * 64 + r_) * 128 + c_ * 8); } } while (0)
#define S2_STORE() do { \
        _Pragma("unroll") for (int i_ = 0; i_ < 4; ++i_) { const int id_ = tid + 512 * i_, r_ = id_ >> 4, c_ = id_ & 15; \
            *(LAS u32x4*)(lds + SS_B + r_ * SS_ROW + c_ * 16) = rB[i_]; *(LAS u32x4*)(lds + SS_C + r_ * SS_ROW + c_ * 16) = rC[i_]; *(LAS u32x4*)(lds + SS_BT + r_ * SS_ROW + c_ * 16) = rT[i_]; } \
        _Pragma("unroll") for (int i_ = 0; i_ < 2; ++i_) { const int id_ = tid + 512 * i_, r_ = id_ >> 4, c_ = id_ & 15; *(LAS u32x4*)(lds + SS_XT + r_ * SS_ROW + c_ * 16) = rX[i_]; } } while (0)
#define S2_LOADDT(cp) do { const int ci_ = S2_CI(cp); const size_t tok0_ = (size_t)b * SEQ + ci_ * 128; const int la_ = dir ? 127 - 2 * lane : 2 * lane, lb_ = dir ? 126 - 2 * lane : 2 * lane + 1; \
        dt0 = DT[(tok0_ + la_) * 16 + dir * 8 + h]; dt1 = DT[(tok0_ + lb_) * 16 + dir * 8 + h]; } while (0)
#define S2_SCAN(buf) do { LAS float* sc_ = (LAS float*)(lds + SS_SC + (buf) * SS_SCB); const float a0_ = dt0 * Aneg, a1_ = dt1 * Aneg; float s_ = a0_ + a1_; \
        _Pragma("unroll") for (int o_ = 1; o_ < 64; o_ <<= 1) { const float t_ = __shfl_up(s_, o_); if (lane >= o_) s_ += t_; } \
        const float c1_ = s_, c0_ = s_ - a1_, tot_ = __shfl(s_, 63); const int la_ = dir ? 127 - 2 * lane : 2 * lane, lb_ = dir ? 126 - 2 * lane : 2 * lane + 1; \
        sc_[la_] = c0_; sc_[lb_] = c1_; sc_[128 + la_] = dt0; sc_[128 + lb_] = dt1; sc_[256 + la_] = __expf(tot_ - c0_) * dt0; sc_[256 + lb_] = __expf(tot_ - c1_) * dt1; \
        sc_[384 + la_] = __expf(c0_); sc_[384 + lb_] = __expf(c1_); if (lane == 0) sc_[512] = __expf(tot_); } while (0)
    S2_LOAD(0); S2_LOADDT(0);
    if (wid == 0) S2_SCAN(0);
    S2_LOADDT(1);
    S2_STORE();
    for (int i = tid; i < 64 * SS_ROW / 4; i += 512) ((LAS unsigned*)(lds + SS_S))[i] = 0u;
    __syncthreads();
    for (int cp = 0; cp < 32; ++cp) {
        if (wid == 0 && cp + 1 < 32) S2_SCAN((cp + 1) & 1);
        if (cp + 2 < 32) S2_LOADDT(cp + 2);
        if (cp + 1 < 32) S2_LOAD(cp + 1);
        const LAS float* sc = (const LAS float*)(lds + SS_SC + (cp & 1) * SS_SCB);
        const LAS float* sCum = sc; const LAS float* sDt = sc + 128; const LAS float* sW = sc + 256; const LAS float* sEin = sc + 384;
        bf16x8 cf[8];
#pragma unroll
        for (int k = 0; k < 8; ++k) cf[k] = *(const LAS bf16x8*)(lds + SS_C + (32 * lt + l31) * SS_ROW + (16 * k + 8 * hi) * 2);
        f32x16 Yd;
#pragma unroll
        for (int r = 0; r < 16; ++r) Yd[r] = 0.f;
        const float cum_l = sCum[32 * lt + l31];
        const int st_lo = dir ? lt : 0, st_hi = dir ? 3 : lt;
        for (int st = st_lo; st <= st_hi; ++st) {
            f32x16 G;
#pragma unroll
            for (int r = 0; r < 16; ++r) G[r] = 0.f;
            bf16x8 bfr[4]; f32x4 cs4[2], dt4[2]; u32x4 xw[2];
#pragma unroll
            for (int k = 0; k < 4; ++k) bfr[k] = *(const LAS bf16x8*)(lds + SS_B + (32 * st + l31) * SS_ROW + (16 * k + 8 * hi) * 2);
            cs4[0] = *(const LAS f32x4*)(sCum + 32 * st + 4 * hi); dt4[0] = *(const LAS f32x4*)(sDt + 32 * st + 4 * hi);
#pragma unroll
            for (int j = 0; j < 2; ++j) { const LAS uchar* xa = lds + SS_XT + (32 * pt + l31) * SS_ROW + (32 * st + 16 * j + 4 * hi) * 2;
                const u32x2 lo = *(const LAS u32x2*)xa, hh = *(const LAS u32x2*)(xa + 16); xw[j].x = lo.x; xw[j].y = lo.y; xw[j].z = hh.x; xw[j].w = hh.y; }
            __builtin_amdgcn_sched_barrier(0);
#pragma unroll
            for (int k = 0; k < 4; ++k) G = MFMA32(bfr[k], cf[k], G);
            __builtin_amdgcn_sched_barrier(0);
#pragma unroll
            for (int k = 0; k < 4; ++k) bfr[k] = *(const LAS bf16x8*)(lds + SS_B + (32 * st + l31) * SS_ROW + (16 * (k + 4) + 8 * hi) * 2);
            __builtin_amdgcn_sched_barrier(0);
#pragma unroll
            for (int k = 0; k < 4; ++k) G = MFMA32(bfr[k], cf[k + 4], G);
            const bool diag = (st == lt);
#pragma unroll
            for (int r4 = 0; r4 < 4; ++r4) {
                if (r4 < 3) { cs4[(r4 + 1) & 1] = *(const LAS f32x4*)(sCum + 32 * st + 8 * (r4 + 1) + 4 * hi); dt4[(r4 + 1) & 1] = *(const LAS f32x4*)(sDt + 32 * st + 8 * (r4 + 1) + 4 * hi); }
#pragma unroll
                for (int e = 0; e < 4; ++e) { const int srel = 8 * r4 + 4 * hi + e; float v = G[4 * r4 + e] * __expf(cum_l - cs4[r4 & 1][e]) * dt4[r4 & 1][e];
                    if (diag) { const bool ok = dir ? (srel >= l31) : (srel <= l31); v = ok ? v : 0.f; }
                    G[4 * r4 + e] = v; } }
#pragma unroll
            for (int j = 0; j < 2; ++j) { u32x4 pw; pw.x = cvtpk(G[8 * j], G[8 * j + 1]); pw.y = cvtpk(G[8 * j + 2], G[8 * j + 3]); pw.z = cvtpk(G[8 * j + 4], G[8 * j + 5]); pw.w = cvtpk(G[8 * j + 6], G[8 * j + 7]);
                Yd = MFMA32(__builtin_bit_cast(bf16x8, pw), __builtin_bit_cast(bf16x8, xw[j]), Yd); }
            __builtin_amdgcn_sched_barrier(0);
        }
        f32x16 Yo;
#pragma unroll
        for (int r = 0; r < 16; ++r) Yo[r] = 0.f;
#pragma unroll
        for (int kh = 0; kh < 2; ++kh) { bf16x8 sfr[4];
#pragma unroll
          for (int k = 0; k < 4; ++k) sfr[k] = *(const LAS bf16x8*)(lds + SS_S + (32 * pt + l31) * SS_ROW + (16 * (4 * kh + k) + 8 * hi) * 2);
          __builtin_amdgcn_sched_barrier(0);
#pragma unroll
          for (int k = 0; k < 4; ++k) Yo = MFMA32(cf[4 * kh + k], sfr[k], Yo);
          __builtin_amdgcn_sched_barrier(0); }
        { const size_t tok0 = (size_t)b * SEQ + S2_CI(cp) * 128;
#pragma unroll
          for (int r4 = 0; r4 < 4; ++r4) { const f32x4 e4 = *(const LAS f32x4*)(sEin + 32 * lt + 8 * r4 + 4 * hi);
#pragma unroll
              for (int e = 0; e < 4; ++e) { const float yv = Yd[4 * r4 + e] + e4[e] * Yo[4 * r4 + e];
                  __builtin_nontemporal_store((bf16_t)(cvtpk(yv, 0.f) & 0xffffu), &Y[(tok0 + 32 * lt + 8 * r4 + 4 * hi + e) * 512 + h * 64 + 32 * pt + l31]); } } }
        { const float etot = sc[512];
#pragma unroll
          for (int r = 0; r < 16; ++r) S[r] *= etot;
#pragma unroll
          for (int kh = 0; kh < 4; ++kh) { u32x4 xr[2]; f32x4 w0[2], w1[2]; bf16x8 btf[2];
#pragma unroll
              for (int q = 0; q < 2; ++q) { const int k = 2 * kh + q; xr[q] = *(const LAS u32x4*)(lds + SS_XT + (32 * pt + l31) * SS_ROW + (16 * k + 8 * hi) * 2);
                  w0[q] = *(const LAS f32x4*)(sW + 16 * k + 8 * hi); w1[q] = *(const LAS f32x4*)(sW + 16 * k + 8 * hi + 4);
                  btf[q] = *(const LAS bf16x8*)(lds + SS_BT + (32 * lt + l31) * SS_ROW + (16 * k + 8 * hi) * 2); }
              __builtin_amdgcn_sched_barrier(0);
#pragma unroll
              for (int q = 0; q < 2; ++q) { u32x4 xs; xs.x = cvtpk(bflo(xr[q].x) * w0[q][0], bfhi(xr[q].x) * w0[q][1]); xs.y = cvtpk(bflo(xr[q].y) * w0[q][2], bfhi(xr[q].y) * w0[q][3]);
                  xs.z = cvtpk(bflo(xr[q].z) * w1[q][0], bfhi(xr[q].z) * w1[q][1]); xs.w = cvtpk(bflo(xr[q].w) * w1[q][2], bfhi(xr[q].w) * w1[q][3]);
                  S = MFMA32(__builtin_bit_cast(bf16x8, xs), btf[q], S); }
              __builtin_amdgcn_sched_barrier(0); } }
        __syncthreads();
        if (cp + 1 < 32) S2_STORE();
#pragma unroll
        for (int r = 0; r < 16; ++r) *(LAS unsigned short*)(lds + SS_S + (32 * pt + crow(r, hi)) * SS_ROW + (32 * lt + l31) * 2) = (unsigned short)(cvtpk(S[r], 0.f) & 0xffffu);
        __syncthreads();
    }
#undef S2_CI
#undef S2_LOAD
#undef S2_STORE
#undef S2_LOADDT
#undef S2_SCAN
}

template <int DQK, int KW, int DVT, int NT, int MODE, bool PIPE>
__device__ __forceinline__ void attn_item(LAS uchar* lds, const GAS bf16_t* qptr, int qpitch, const GAS bf16_t* kptr, int kpitch, int kwcol, const GAS bf16_t* vtptr, int vtpitch, int vrow,
                                          GAS bf16_t* outp, int opitch, float lam, const GAS float* subg, unsigned& tacc) {
#ifdef TSEG
#define TS_BEGIN(k) do { if (TSEG == (k)) { __builtin_amdgcn_sched_barrier(0); tacc -= (unsigned)__builtin_amdgcn_s_memrealtime(); __builtin_amdgcn_sched_barrier(0); } } while (0)
#else
#define TS_BEGIN(k) do {} while (0)
#endif
    constexpr int KROW = KW * 2 + 16, KBUF = 64 * KROW, VROW = 136, VBUF = DVT * VROW, NKP = 64 * (KW / 8) / 512, NVP = DVT * 8 / 512, NS = DQK / 16;
    static_assert(2 * KBUF + 2 * VBUF <= PTAB_OFF && 128 * 256 * 4 + 1024 <= PTAB_OFF, "attention LDS");
    const int tid = opaque_tid(), lane = tid & 63, wid = __builtin_amdgcn_readfirstlane(tid >> 6), qg = wid >> 1, t = wid & 1, l31 = lane & 31, hi = lane >> 5;
    bf16x8 qf[NS];
    { const GAS bf16_t* qr = qptr + (size_t)(qg * 32 + l31) * qpitch + 8 * hi;
#pragma unroll
      for (int s = 0; s < NS; ++s) qf[s] = *(const GAS bf16x8*)(qr + 16 * s); }
    f32x16 o[4];
#pragma unroll
    for (int d = 0; d < 4; ++d)
#pragma unroll
        for (int r = 0; r < 16; ++r) o[d][r] = 0.f;
    float m = -1e30f, l = 0.f;
    u32x4 kst[NKP], vst[NVP];
#define AT_LOAD(tile) do { \
        _Pragma("unroll") for (int i_ = 0; i_ < NKP; ++i_) { const int id_ = tid + 512 * i_, r_ = id_ / (KW / 8), c_ = id_ % (KW / 8); kst[i_] = *(const GAS u32x4*)(kptr + (size_t)((tile) * 64 + r_) * kpitch + c_ * 8); } \
        _Pragma("unroll") for (int i_ = 0; i_ < NVP; ++i_) { const int id_ = tid + 512 * i_, r_ = id_ >> 3, c_ = id_ & 7; vst[i_] = *(const GAS u32x4*)(vtptr + (size_t)r_ * vtpitch + (tile) * 64 + c_ * 8); } } while (0)
#define AT_STORE(buf) do { \
        _Pragma("unroll") for (int i_ = 0; i_ < NKP; ++i_) { const int id_ = tid + 512 * i_, r_ = id_ / (KW / 8), c_ = id_ % (KW / 8); *(LAS u32x4*)(lds + (buf) * KBUF + r_ * KROW + c_ * 16) = kst[i_]; } \
        _Pragma("unroll") for (int i_ = 0; i_ < NVP; ++i_) { const int id_ = tid + 512 * i_, r_ = id_ >> 3, c_ = id_ & 7; LAS u32x2* d_ = (LAS u32x2*)(lds + 2 * KBUF + (buf) * VBUF + r_ * VROW + c_ * 16); \
            d_[0] = (u32x2){vst[i_].x, vst[i_].y}; d_[1] = (u32x2){vst[i_].z, vst[i_].w}; } } while (0)
    if (PIPE) { AT_LOAD(0); AT_STORE(0); __syncthreads(); }
#pragma unroll
    for (int s = 0; s < NS; ++s) asm volatile("" :: "v"(qf[s]));
    for (int tile = 0; tile < NT; ++tile) {
        if (PIPE) { if (tile + 1 < NT) AT_LOAD(tile + 1); }
        else { AT_LOAD(tile); AT_STORE(tile & 1); __syncthreads(); }
        TS_BEGIN(1);
        const LAS uchar* kb = lds + (tile & 1) * KBUF; const LAS uchar* vb = lds + 2 * KBUF + (tile & 1) * VBUF;
        f32x16 s0, s1;
#pragma unroll
        for (int r = 0; r < 16; ++r) { s0[r] = 0.f; s1[r] = 0.f; }
        { const LAS uchar* ka = kb + l31 * KROW + (kwcol + 8 * hi) * 2;
          constexpr int GS = (NS > 4) ? 2 : 4;
#pragma unroll
          for (int g4 = 0; g4 < NS / GS; ++g4) { bf16x8 kf[2 * GS];
#pragma unroll
              for (int s = 0; s < GS; ++s) { kf[2 * s] = *(const LAS bf16x8*)(ka + 32 * (GS * g4 + s)); kf[2 * s + 1] = *(const LAS bf16x8*)(ka + 32 * KROW + 32 * (GS * g4 + s)); }
              __builtin_amdgcn_sched_barrier(0);
#pragma unroll
              for (int s = 0; s < GS; ++s) { s0 = MFMA32(kf[2 * s], qf[GS * g4 + s], s0); s1 = MFMA32(kf[2 * s + 1], qf[GS * g4 + s], s1); }
              __builtin_amdgcn_sched_barrier(0); } }
        u32x4 vfA[4], vfB[4];
#define AT_VLOAD(dst, kt, j) do { _Pragma("unroll") for (int d_ = 0; d_ < 4; ++d_) { const LAS uchar* va_ = vb + (vrow + 32 * d_ + l31) * VROW + (32 * (kt) + 16 * (j) + 4 * hi) * 2; \
            const u32x2 lo_ = *(const LAS u32x2*)va_, hh_ = *(const LAS u32x2*)(va_ + 16); dst[d_].x = lo_.x; dst[d_].y = lo_.y; dst[d_].z = hh_.x; dst[d_].w = hh_.y; } } while (0)
#define AT_PV(src, P, j) do { u32x4 pw_; pw_.x = cvtpk(P[8 * (j)], P[8 * (j) + 1]); pw_.y = cvtpk(P[8 * (j) + 2], P[8 * (j) + 3]); pw_.z = cvtpk(P[8 * (j) + 4], P[8 * (j) + 5]); pw_.w = cvtpk(P[8 * (j) + 6], P[8 * (j) + 7]); \
            const bf16x8 pa_ = __builtin_bit_cast(bf16x8, pw_); _Pragma("unroll") for (int d_ = 0; d_ < 4; ++d_) o[d_] = MFMA32(pa_, __builtin_bit_cast(bf16x8, src[d_]), o[d_]); } while (0)
        AT_VLOAD(vfA, 0, 0);
        __builtin_amdgcn_sched_barrier(0);
#ifdef TSEG
        if (TSEG == 1) { asm volatile("s_nop 0" :: "v"(s0[15]), "v"(s1[15])); tacc += (unsigned)__builtin_amdgcn_s_memrealtime(); }
#endif
        TS_BEGIN(2);
        asm volatile("s_nop 15\n\ts_nop 7" : "+v"(s0), "+v"(s1));
        float mxa = max3f(s0[0], s0[1], s0[2]), mxb = max3f(s0[3], s0[4], s0[5]), mxc = max3f(s1[0], s1[1], s1[2]), mxd = max3f(s1[3], s1[4], s1[5]);
        mxa = max3f(mxa, s0[6], s0[7]); mxb = max3f(mxb, s0[8], s0[9]); mxc = max3f(mxc, s1[6], s1[7]); mxd = max3f(mxd, s1[8], s1[9]);
        mxa = max3f(mxa, s0[10], s0[11]); mxb = max3f(mxb, s0[12], s0[13]); mxc = max3f(mxc, s1[10], s1[11]); mxd = max3f(mxd, s1[12], s1[13]);
        mxa = max3f(mxa, s0[14], s0[15]); mxc = max3f(mxc, s1[14], s1[15]);
        float mx = max3f(max3f(mxa, mxb, mxc), mxd, mxd);
        { auto rr = __builtin_amdgcn_permlane32_swap(__float_as_uint(mx), __float_as_uint(mx), false, false); mx = max3f(__uint_as_float(rr[0]), __uint_as_float(rr[1]), __uint_as_float(rr[1])); }
        if (__any(mx > m + 8.0f)) {
            const float mnew = fmaxf(m, mx); const float alpha = fast_exp2(m - mnew);
#pragma unroll
            for (int r = 0; r < 16; ++r) { const float ar = __shfl(alpha, crow(r, hi));
#pragma unroll
                for (int d = 0; d < 4; ++d) o[d][r] *= ar; }
            l *= alpha; m = mnew;
        }
        float psa = 0.f, psb = 0.f, psc = 0.f, psd = 0.f;
#pragma unroll
        for (int r = 0; r < 16; r += 2) { s0[r] = fast_exp2(s0[r] - m); s1[r] = fast_exp2(s1[r] - m); s0[r + 1] = fast_exp2(s0[r + 1] - m); s1[r + 1] = fast_exp2(s1[r + 1] - m);
            psa += s0[r]; psb += s1[r]; psc += s0[r + 1]; psd += s1[r + 1]; }
        l += (psa + psb) + (psc + psd);
        __builtin_amdgcn_sched_barrier(0);
#ifdef TSEG
        if (TSEG == 2) { asm volatile("s_nop 0" :: "v"(s0[15]), "v"(s1[15]), "v"(s0[0]), "v"(l)); tacc += (unsigned)__builtin_amdgcn_s_memrealtime(); }
#endif
        TS_BEGIN(3);
        if constexpr (NS <= 4) {
        AT_VLOAD(vfB, 0, 1); __builtin_amdgcn_sched_barrier(0); AT_PV(vfA, s0, 0); __builtin_amdgcn_sched_barrier(0);
        AT_VLOAD(vfA, 1, 0); __builtin_amdgcn_sched_barrier(0); AT_PV(vfB, s0, 1); __builtin_amdgcn_sched_barrier(0);
        AT_VLOAD(vfB, 1, 1); __builtin_amdgcn_sched_barrier(0); AT_PV(vfA, s1, 0); __builtin_amdgcn_sched_barrier(0);
        AT_PV(vfB, s1, 1);
        } else {
        AT_PV(vfA, s0, 0); __builtin_amdgcn_sched_barrier(0); AT_VLOAD(vfA, 0, 1); __builtin_amdgcn_sched_barrier(0);
        AT_PV(vfA, s0, 1); __builtin_amdgcn_sched_barrier(0); AT_VLOAD(vfA, 1, 0); __builtin_amdgcn_sched_barrier(0);
        AT_PV(vfA, s1, 0); __builtin_amdgcn_sched_barrier(0); AT_VLOAD(vfA, 1, 1); __builtin_amdgcn_sched_barrier(0);
        AT_PV(vfA, s1, 1);
        }
#undef AT_VLOAD
#undef AT_PV
#ifdef TSEG
        if (TSEG == 3) { __builtin_amdgcn_sched_barrier(0); asm volatile("s_nop 0" :: "v"(o[0][15]), "v"(o[1][15]), "v"(o[2][15]), "v"(o[3][15])); tacc += (unsigned)__builtin_amdgcn_s_memrealtime(); }
#endif
        TS_BEGIN(4);
        if (PIPE) { if (tile + 1 < NT) AT_STORE((tile + 1) & 1); __syncthreads(); }
#ifdef TSEG
        if (TSEG == 4) tacc += (unsigned)__builtin_amdgcn_s_memrealtime();
#endif
    }
    if (!PIPE) __syncthreads();
#undef AT_LOAD
#undef AT_STORE
    l += __shfl_xor(l, 32);
    LAS float* ex = (LAS float*)lds; LAS float* lsum = (LAS float*)(lds + 128 * 256 * 4);
#pragma unroll
    for (int d = 0; d < 4; ++d)
#pragma unroll
        for (int r = 0; r < 16; ++r) ex[(qg * 32 + crow(r, hi)) * 256 + t * 128 + 32 * d + l31] = o[d][r];
    if (hi == 0) lsum[t * 128 + qg * 32 + l31] = l;
    __syncthreads();
    if (MODE == 0) {
        float av[16], bv[16], ss[16];
#pragma unroll
        for (int rr = 0; rr < 16; ++rr) { const int q = wid * 16 + rr; const float i1 = 1.0f / lsum[q], i2 = lam / lsum[128 + q];
            const f32x2 o1 = ((const LAS f32x2*)(ex + q * 256))[lane], o2 = ((const LAS f32x2*)(ex + q * 256 + 128))[lane];
            av[rr] = o1.x * i1 - o2.x * i2; bv[rr] = o1.y * i1 - o2.y * i2; ss[rr] = av[rr] * av[rr] + bv[rr] * bv[rr]; }
#pragma unroll
        for (int o_ = 1; o_ < 64; o_ <<= 1) {
#pragma unroll
            for (int rr = 0; rr < 16; ++rr) ss[rr] += __shfl_xor(ss[rr], o_); }
        const float g0 = subg[2 * lane], g1 = subg[2 * lane + 1];
#pragma unroll
        for (int rr = 0; rr < 16; ++rr) { const int q = wid * 16 + rr; const float rn = (1.0f - LAMBDA_INIT) / sqrtf(ss[rr] * (1.0f / 128.0f) + EPS);
            __builtin_nontemporal_store(cvtpk(av[rr] * rn * g0, bv[rr] * rn * g1), (GAS unsigned*)(outp + (size_t)q * opitch + 2 * lane)); }
    } else {
#pragma unroll 4
        for (int rr = 0; rr < 16; ++rr) { const int q = wid * 16 + rr;
            const float inv = 1.0f / lsum[q]; const f32x4 v = ((const LAS f32x4*)(ex + q * 256))[lane];
            u32x2 w; w.x = cvtpk(v[0] * inv, v[1] * inv); w.y = cvtpk(v[2] * inv, v[3] * inv);
            *(GAS u32x2*)(outp + (size_t)q * opitch + 4 * lane) = w; }
    }
    __syncthreads();
}

constexpr int XA_KROW = 528, XA_VROW = 136, XA_K = 0, XA_V = 64 * XA_KROW, XA_Q = XA_V + 256 * XA_VROW, XA_END = XA_Q + 128 * XA_KROW;
static_assert(XA_END <= PTAB_OFF, "cross attention LDS");
__device__ __forceinline__ void xattn_item(LAS uchar* lds, const GAS bf16_t* qptr, int qpitch, const GAS bf16_t* kptr, int kpitch, const GAS bf16_t* vtptr, int vtpitch, GAS bf16_t* outp, int opitch) {
    const int tid = opaque_tid(), lane = tid & 63, wid = __builtin_amdgcn_readfirstlane(tid >> 6), qg = wid >> 1, t = wid & 1, l31 = lane & 31, hi = lane >> 5;
    const int vrow = t * 128;
    u32x4 kst[4], vst[4];
#define XA_LOAD(tile) do { \
        _Pragma("unroll") for (int i_ = 0; i_ < 4; ++i_) { const int id_ = tid + 512 * i_, r_ = id_ >> 5, c_ = id_ & 31; kst[i_] = *(const GAS u32x4*)(kptr + (size_t)((tile) * 64 + r_) * kpitch + c_ * 8); } \
        _Pragma("unroll") for (int i_ = 0; i_ < 4; ++i_) { const int id_ = tid + 512 * i_, r_ = id_ >> 3, c_ = id_ & 7; vst[i_] = *(const GAS u32x4*)(vtptr + (size_t)r_ * vtpitch + (tile) * 64 + c_ * 8); } } while (0)
#define XA_STORE() do { \
        _Pragma("unroll") for (int i_ = 0; i_ < 4; ++i_) { const int id_ = tid + 512 * i_, r_ = id_ >> 5, c_ = id_ & 31; *(LAS u32x4*)(lds + XA_K + r_ * XA_KROW + c_ * 16) = kst[i_]; } \
        _Pragma("unroll") for (int i_ = 0; i_ < 4; ++i_) { const int id_ = tid + 512 * i_, r_ = id_ >> 3, c_ = id_ & 7; LAS u32x2* d_ = (LAS u32x2*)(lds + XA_V + r_ * XA_VROW + c_ * 16); \
            d_[0] = (u32x2){vst[i_].x, vst[i_].y}; d_[1] = (u32x2){vst[i_].z, vst[i_].w}; } } while (0)
    XA_LOAD(0);
    { u32x4 qs[8];
#pragma unroll
      for (int i = 0; i < 8; ++i) { const int id = tid + 512 * i, r = id >> 5, c = id & 31; qs[i] = *(const GAS u32x4*)(qptr + (size_t)r * qpitch + c * 8); }
#pragma unroll
      for (int i = 0; i < 8; ++i) { const int id = tid + 512 * i, r = id >> 5, c = id & 31; *(LAS u32x4*)(lds + XA_Q + r * XA_KROW + c * 16) = qs[i]; } }
    f32x16 o[4];
#pragma unroll
    for (int d = 0; d < 4; ++d)
#pragma unroll
        for (int r = 0; r < 16; ++r) o[d][r] = 0.f;
    float m = -1e30f, l = 0.f;
    for (int tile = 0; tile < 4; ++tile) {
        XA_STORE();
        __syncthreads();
        if (tile + 1 < 4) XA_LOAD(tile + 1);
        f32x16 s0, s1;
#pragma unroll
        for (int r = 0; r < 16; ++r) { s0[r] = 0.f; s1[r] = 0.f; }
        { const LAS uchar* ka = lds + XA_K + l31 * XA_KROW + (8 * hi) * 2; const LAS uchar* qa = lds + XA_Q + (qg * 32 + l31) * XA_KROW + (8 * hi) * 2;
#pragma unroll
          for (int g2 = 0; g2 < 8; ++g2) { bf16x8 kf[4], qb[2];
#pragma unroll
              for (int s = 0; s < 2; ++s) { kf[2 * s] = *(const LAS bf16x8*)(ka + 32 * (2 * g2 + s)); kf[2 * s + 1] = *(const LAS bf16x8*)(ka + 32 * XA_KROW + 32 * (2 * g2 + s)); qb[s] = *(const LAS bf16x8*)(qa + 32 * (2 * g2 + s)); }
              __builtin_amdgcn_sched_barrier(0);
#pragma unroll
              for (int s = 0; s < 2; ++s) { s0 = MFMA32(kf[2 * s], qb[s], s0); s1 = MFMA32(kf[2 * s + 1], qb[s], s1); }
              __builtin_amdgcn_sched_barrier(0); } }
        asm volatile("s_nop 15\n\ts_nop 7" : "+v"(s0), "+v"(s1));
        float mxa = max3f(s0[0], s0[1], s0[2]), mxb = max3f(s0[3], s0[4], s0[5]), mxc = max3f(s1[0], s1[1], s1[2]), mxd = max3f(s1[3], s1[4], s1[5]);
        mxa = max3f(mxa, s0[6], s0[7]); mxb = max3f(mxb, s0[8], s0[9]); mxc = max3f(mxc, s1[6], s1[7]); mxd = max3f(mxd, s1[8], s1[9]);
        mxa = max3f(mxa, s0[10], s0[11]); mxb = max3f(mxb, s0[12], s0[13]); mxc = max3f(mxc, s1[10], s1[11]); mxd = max3f(mxd, s1[12], s1[13]);
        mxa = max3f(mxa, s0[14], s0[15]); mxc = max3f(mxc, s1[14], s1[15]);
        float mx = max3f(max3f(mxa, mxb, mxc), mxd, mxd);
        { auto rr = __builtin_amdgcn_permlane32_swap(__float_as_uint(mx), __float_as_uint(mx), false, false); mx = max3f(__uint_as_float(rr[0]), __uint_as_float(rr[1]), __uint_as_float(rr[1])); }
        if (__any(mx > m + 8.0f)) {
            const float mnew = fmaxf(m, mx); const float alpha = fast_exp2(m - mnew);
#pragma unroll
            for (int r = 0; r < 16; ++r) { const float ar = __shfl(alpha, crow(r, hi));
#pragma unroll
                for (int d = 0; d < 4; ++d) o[d][r] *= ar; }
            l *= alpha; m = mnew;
        }
        float psa = 0.f, psb = 0.f, psc = 0.f, psd = 0.f;
#pragma unroll
        for (int r = 0; r < 16; r += 2) { s0[r] = fast_exp2(s0[r] - m); s1[r] = fast_exp2(s1[r] - m); s0[r + 1] = fast_exp2(s0[r + 1] - m); s1[r + 1] = fast_exp2(s1[r + 1] - m);
            psa += s0[r]; psb += s1[r]; psc += s0[r + 1]; psd += s1[r + 1]; }
        l += (psa + psb) + (psc + psd);
        __builtin_amdgcn_sched_barrier(0);
#pragma unroll
        for (int s4 = 0; s4 < 4; ++s4) {
            u32x4 vf[4];
#pragma unroll
            for (int d = 0; d < 4; ++d) { const LAS uchar* va = lds + XA_V + (vrow + 32 * d + l31) * XA_VROW + (16 * s4 + 4 * hi) * 2; const u32x2 lo = *(const LAS u32x2*)va, hh = *(const LAS u32x2*)(va + 16);
                vf[d].x = lo.x; vf[d].y = lo.y; vf[d].z = hh.x; vf[d].w = hh.y; }
            u32x4 pw;
            if (s4 == 0)      { pw.x = cvtpk(s0[0], s0[1]); pw.y = cvtpk(s0[2], s0[3]); pw.z = cvtpk(s0[4], s0[5]); pw.w = cvtpk(s0[6], s0[7]); }
            else if (s4 == 1) { pw.x = cvtpk(s0[8], s0[9]); pw.y = cvtpk(s0[10], s0[11]); pw.z = cvtpk(s0[12], s0[13]); pw.w = cvtpk(s0[14], s0[15]); }
            else if (s4 == 2) { pw.x = cvtpk(s1[0], s1[1]); pw.y = cvtpk(s1[2], s1[3]); pw.z = cvtpk(s1[4], s1[5]); pw.w = cvtpk(s1[6], s1[7]); }
            else              { pw.x = cvtpk(s1[8], s1[9]); pw.y = cvtpk(s1[10], s1[11]); pw.z = cvtpk(s1[12], s1[13]); pw.w = cvtpk(s1[14], s1[15]); }
            __builtin_amdgcn_sched_barrier(0);
            const bf16x8 pa = __builtin_bit_cast(bf16x8, pw);
#pragma unroll
            for (int d = 0; d < 4; ++d) o[d] = MFMA32(pa, __builtin_bit_cast(bf16x8, vf[d]), o[d]);
            __builtin_amdgcn_sched_barrier(0);
        }
        __syncthreads();
    }
#undef XA_LOAD
#undef XA_STORE
    l += __shfl_xor(l, 32);
    LAS float* ex = (LAS float*)lds; LAS float* lsum = (LAS float*)(lds + 128 * 256 * 4);
#pragma unroll
    for (int d = 0; d < 4; ++d)
#pragma unroll
        for (int r = 0; r < 16; ++r) ex[(qg * 32 + crow(r, hi)) * 256 + t * 128 + 32 * d + l31] = o[d][r];
    if (hi == 0) lsum[t * 128 + qg * 32 + l31] = l;
    __syncthreads();
#pragma unroll 4
    for (int rr = 0; rr < 16; ++rr) { const int q = wid * 16 + rr;
        const float inv = 1.0f / lsum[q]; const f32x4 v = ((const LAS f32x4*)(ex + q * 256))[lane];
        u32x2 w; w.x = cvtpk(v[0] * inv, v[1] * inv); w.y = cvtpk(v[2] * inv, v[3] * inv);
        *(GAS u32x2*)(outp + (size_t)q * opitch + 4 * lane) = w; }
    __syncthreads();
}

#define XB_TMO      128
#define XB_XCNT(j)  (256  + 64 * (j))
#define XB_XSUB(j)  (1280 + 64 * (j))
#define XB_XGEN(j)  (2304 + 64 * (j))
#define XB_TOP      3328
#define XB_TOPGEN   3392
#define XCD_BAR_WORDS 3456
#define XB_SPIN_CAP (1u << 18)

__device__ __forceinline__ unsigned xb_ld(unsigned* p)              { return __hip_atomic_load(p, __ATOMIC_RELAXED, __HIP_MEMORY_SCOPE_AGENT); }
__device__ __forceinline__ unsigned xb_add(unsigned* p, unsigned v) { return __hip_atomic_fetch_add(p, v, __ATOMIC_RELAXED, __HIP_MEMORY_SCOPE_AGENT); }
__device__ __forceinline__ unsigned xb_xcc_id() { return (unsigned)__builtin_amdgcn_s_getreg((3 << 11) | 20) & 0xFu; }
#define XB_SPIN(cond, bar) do { unsigned _sp = 0; while (cond) { __builtin_amdgcn_s_sleep(1); \
    if ((++_sp & 255u) == 0u) { if (xb_ld(&(bar)[XB_TMO])) break; if (_sp > XB_SPIN_CAP) { atomicAdd(&(bar)[XB_TMO], 1u); break; } } } } while (0)

struct XcdBarrier {
    unsigned* bar; unsigned x;
    volatile LAS unsigned* st;
};

__device__ __forceinline__ XcdBarrier xcd_barrier_post(unsigned* bar, volatile LAS unsigned* st) {
    XcdBarrier b; b.bar = bar; b.x = xb_xcc_id(); b.st = st;
    if (threadIdx.x == 0) (void)xb_add(&bar[XB_XCNT(b.x)], 1u);
    return b;
}
__device__ __forceinline__ void xcd_barrier_complete(unsigned* bar, unsigned x, unsigned& nloc, unsigned& nx) {
    const unsigned G = gridDim.x * gridDim.y * gridDim.z;
    unsigned sum, cnt, mine, sp = 0u;
    for (;;) {
        sum = 0u; cnt = 0u; mine = 0u;
#pragma unroll
        for (unsigned j = 0; j < 16; ++j) { const unsigned c = xb_ld(&bar[XB_XCNT(j)]); sum += c; cnt += (c > 0u) ? 1u : 0u; mine = (j == x) ? c : mine; }
        if (sum == G) break;
        __builtin_amdgcn_s_sleep(1);
        if ((++sp & 255u) == 0u) { if (xb_ld(&bar[XB_TMO])) break; if (sp > XB_SPIN_CAP) { atomicAdd(&bar[XB_TMO], 1u); break; } }
    }
    nloc = mine > 0u ? mine : 1u; nx = cnt > 0u ? cnt : 1u;
}

__device__ __forceinline__ void xcd_barrier(const XcdBarrier& b) {
    asm volatile("s_waitcnt vmcnt(0)" ::: "memory");
    __syncthreads();
    if (threadIdx.x == 0) {
        unsigned* bar = b.bar;
        __builtin_amdgcn_s_waitcnt(0);
        unsigned nloc = b.st[0], nx = b.st[1];
        if (nloc == 0u) { xcd_barrier_complete(bar, b.x, nloc, nx); b.st[0] = nloc; b.st[1] = nx; }
        const unsigned old = xb_add(&bar[XB_XSUB(b.x)], 1u);
        const unsigned gen = old / nloc;
        if (old + 1u == (gen + 1u) * nloc) {
            __builtin_amdgcn_fence(__ATOMIC_RELEASE, "agent");
            asm volatile("s_waitcnt vmcnt(0)" ::: "memory");
            const unsigned og = xb_add(&bar[XB_TOP], 1u);
            const unsigned tg = og / nx;
            if (og + 1u == (tg + 1u) * nx) xb_add(&bar[XB_TOPGEN], 1u);
            else XB_SPIN(xb_ld(&bar[XB_TOPGEN]) == tg, bar);
            __builtin_amdgcn_fence(__ATOMIC_ACQUIRE, "agent");
            xb_add(&bar[XB_XGEN(b.x)], 1u);
            asm volatile("s_waitcnt vmcnt(0)" ::: "memory");
        } else {
            XB_SPIN(xb_ld(&bar[XB_XGEN(b.x)]) == gen, bar);
            __builtin_amdgcn_fence(__ATOMIC_ACQUIRE, "agent");
            asm volatile("s_waitcnt vmcnt(0)" ::: "memory");
        }
    }
    __syncthreads();
}

#ifndef PHASE_MASK
#define PHASE_MASK 0xFFFF
#endif
#define PH_ON(k) ((PHASE_MASK >> (k)) & 1)
#define PH_IDS const int tid = opaque_tid(), lane = tid & 63, wave = __builtin_amdgcn_readfirstlane(tid >> 6), gw = bx * 8 + wave, gtid = bx * 512 + tid; (void)lane; (void)gw; (void)gtid; (void)wave
struct Args { const float* in[32]; float* out; unsigned char* ws; int ph_lo, ph_hi; };
#ifdef TSEG
constexpr int N_PHASES = 15;
#else
constexpr int N_PHASES = 14;
#endif

__global__ void __launch_bounds__(512, 2) mega_fwd(Args a) {
    extern __shared__ __attribute__((aligned(16))) unsigned char lds_raw[];
    LAS uchar* lds = (LAS uchar*)lds_raw;
    const int G = (int)gridDim.x, bx = (int)blockIdx.x, NGW = G * 8, NTHR = G * 512;
    LAS unsigned long long* ptab = (LAS unsigned long long*)(lds + PTAB_OFF);
    if (threadIdx.x < 32) ptab[threadIdx.x] = (unsigned long long)a.in[threadIdx.x];
    if (threadIdx.x < 2) ((volatile LAS unsigned*)(lds + PTAB_OFF + 384))[threadIdx.x] = 0u;
    __syncthreads();
    XcdBarrier xbar = xcd_barrier_post((unsigned*)(a.ws + WS_CTL + 4096), (volatile LAS unsigned*)(lds + PTAB_OFF + 384));
#define INP(k) ((const GAS float*)(((unsigned long long)(unsigned)__builtin_amdgcn_readfirstlane((int)(ptab[k] >> 32)) << 32) | (unsigned long long)(unsigned)__builtin_amdgcn_readfirstlane((int)(ptab[k] & 0xffffffffull))))
    if (a.ph_lo == 0 && PH_ON(0)) {
        GAS float* rope_cs = (GAS float*)((GAS unsigned char*)a.ws + WS_ROPE);
        for (int i = bx * 512 + (int)threadIdx.x; i < SEQ * 8; i += NTHR) rope_entry(i, rope_cs, rope_cs + SEQ * 8);
    }
#ifdef REP_PH
    bool rep_done = false;
#endif
    for (int ph = a.ph_lo; ph < a.ph_hi; ++ph) {
        GAS unsigned char* ws = (GAS unsigned char*)a.ws; asm volatile("" : "+s"(ws));
        GAS float* lamp = (GAS float*)(ws + WS_CTL);
        GAS float* rope_cs = (GAS float*)(ws + WS_ROPE); GAS float* rope_sn = rope_cs + SEQ * 8;
        GAS float* SS0 = (GAS float*)(ws + WS_SS0); GAS float* SS1 = (GAS float*)(ws + WS_SS1); GAS float* SS2 = (GAS float*)(ws + WS_SS2); GAS float* SS3 = (GAS float*)(ws + WS_SS3); GAS float* SS4 = (GAS float*)(ws + WS_SS4); GAS float* SSM = (GAS float*)(ws + WS_SSM);
        GAS float* DTB = (GAS float*)(ws + WS_DT);
        GAS bf16_t* WGU1 = (GAS bf16_t*)(ws + WS_WGU1); GAS bf16_t* WD1 = (GAS bf16_t*)(ws + WS_WD1); GAS bf16_t* WIN = (GAS bf16_t*)(ws + WS_WIN); GAS bf16_t* WOUT = (GAS bf16_t*)(ws + WS_WOUT);
        GAS bf16_t* WQ = (GAS bf16_t*)(ws + WS_WQ); GAS bf16_t* WKV = (GAS bf16_t*)(ws + WS_WKV); GAS bf16_t* WO = (GAS bf16_t*)(ws + WS_WO); GAS bf16_t* WGU2 = (GAS bf16_t*)(ws + WS_WGU2); GAS bf16_t* WD2 = (GAS bf16_t*)(ws + WS_WD2);
        GAS bf16_t* MEMB = (GAS bf16_t*)(ws + WS_MEMB); GAS bf16_t* KVX = (GAS bf16_t*)(ws + WS_KVX); GAS bf16_t* VTX = (GAS bf16_t*)(ws + WS_VTX); GAS bf16_t* VT = (GAS bf16_t*)(ws + WS_VT);
        GAS float* out = (GAS float*)a.out;
        GAS bf16_t* XB = (GAS bf16_t*)(ws + WS_XB);
        GAS bf16_t* XC = (GAS bf16_t*)out; GAS bf16_t* XT = XC + (size_t)T * 1024; GAS bf16_t* BTR = XT + (size_t)T * 512;
        GAS bf16_t* YMIX = (GAS bf16_t*)(ws + WS_YMIX); GAS bf16_t* OX = YMIX;
        GAS bf16_t* YF = (GAS bf16_t*)(ws + WS_YFB); GAS bf16_t* YB = YF + (size_t)T * 512; GAS bf16_t* QX = YF;
        GAS bf16_t* BIG = (GAS bf16_t*)(ws + WS_BIG); GAS bf16_t* U = BIG; GAS bf16_t* PROJ = BIG;

        if (ph == 0 && PH_ON(0)) {
            PH_IDS;
            LAS float* scr = (LAS float*)(lds + wave * 16384);
            constexpr int I_G = 16 * 88, I_D = 44 * 32, I_IN = 16 * 97, I_SQ = 16 * 32, I_KV = 16 * 64;
            constexpr int NITEMS = 6 * I_G + I_IN + 3 * I_SQ + I_KV;
            static_assert(I_G == I_D, "item counts");
            for (int it = gw; it < NITEMS; it += NGW) {
                int r = it; const GAS float* W; const GAS float* gq = nullptr; GAS bf16_t* WT; int K = DM, N = DM, kind = 0;
                if (r < 3 * I_G) { const int w = r / I_G; r -= w * I_G; if (w == 2) { W = INP(5); K = FF; WT = WD1; } else { W = INP(3 + w); N = FF; WT = WGU1; kind = 1 + w; gq = INP(2); } }
                else if (r < 6 * I_G) { r -= 3 * I_G; const int w = r / I_G; r -= w * I_G; if (w == 2) { W = INP(30); K = FF; WT = WD2; } else { W = INP(28 + w); N = FF; WT = WGU2; kind = 1 + w; gq = INP(27); } }
                else if (r < 6 * I_G + I_IN) { r -= 6 * I_G; W = INP(7); N = 3088; WT = WIN; kind = 3; gq = INP(6); }
                else { r -= 6 * I_G + I_IN;
                    if (r < I_SQ) { W = INP(21); WT = WOUT; }
                    else if (r < 2 * I_SQ) { r -= I_SQ; W = INP(24); WT = WQ; gq = INP(22); }
                    else if (r < 3 * I_SQ) { r -= 2 * I_SQ; W = INP(26); WT = WO; }
                    else { r -= 3 * I_SQ; W = INP(25); N = 2 * DM; WT = WKV; gq = INP(23); } }
                p0_transpose_item(W, K, N, WT, kind, gq, scr, r, lane);
            }
            { const GAS float* xin = INP(0); for (int mrow = gw * 4; mrow < T; mrow += NGW * 4) rows4_to_bf16_ss(xin, XB, SS0, mrow, lane); }
            { const GAS float* min_ = INP(1); for (int mrow = gw * 4; mrow < TM; mrow += NGW * 4) rows4_to_bf16_ss(min_, MEMB, SSM, mrow, lane); }
            for (int i = gtid; i < (NPROJ - 3088) * DM / 8; i += NTHR) { unsigned oz = 0u; asm volatile("" : "+v"(oz)); ((GAS u32x4*)(WIN + (size_t)3088 * DM))[i] = (u32x4){oz, oz, oz, oz}; }
            if (bx == 0 && wave == 0) {
                const float s1 = wave_sum(INP(16)[lane] * INP(17)[lane]), s2 = wave_sum(INP(18)[lane] * INP(19)[lane]);
                if (lane == 0) lamp[0] = __expf(s1) - __expf(s2) + LAMBDA_INIT;
            }
        } else if (PH_ON(1) && (ph == 1 || ph == 2 || ph == 3 || ph == 7 || ph == 8 || ph == 10 || ph == 11 || ph == 12)) {
            for (int sub = 0; sub < 2; ++sub) {
                if (sub == 1 && ph != 1) break;
                GJob j; j.E = EpiAny{0, ws, 1.0f, 0u, 0u, 0u, 0};
                if (ph == 1 && sub == 0) { j.A = XB; j.Bt = WGU1; j.M = T; j.N = 2 * FF; j.K = DM; j.E.kind = 1; j.E.part_off = (unsigned)WS_SS0; j.E.o_off = (unsigned)WS_BIG; }
                else if (ph == 1)        { j.A = MEMB; j.Bt = WKV; j.M = TM; j.N = 2 * DM; j.K = DM; j.E.kind = 0; j.E.part_off = (unsigned)WS_SSM; j.E.o_off = (unsigned)WS_KVX; j.E.ldc = 2 * DM; }
                else if (ph == 2)        { j.A = U; j.Bt = WD1; j.M = T; j.N = DM; j.K = FF; j.E.kind = 2; j.E.scale = 0.5f; j.E.opart_off = (unsigned)WS_SS1; }
                else if (ph == 3)        { j.A = XB; j.Bt = WIN; j.M = T; j.N = NPROJ; j.K = DM; j.E.kind = 3; j.E.part_off = (unsigned)WS_SS1; j.E.o_off = (unsigned)WS_BIG; }
                else if (ph == 7)        { j.A = YMIX; j.Bt = WOUT; j.M = T; j.N = DM; j.K = DM; j.E.kind = 2; j.E.opart_off = (unsigned)WS_SS2; }
                else if (ph == 8)        { j.A = XB; j.Bt = WQ; j.M = T; j.N = DM; j.K = DM; j.E.kind = 0; j.E.part_off = (unsigned)WS_SS2; j.E.scale = 0.0625f * LOG2E; j.E.o_off = (unsigned)WS_YFB; j.E.ldc = DM; }
                else if (ph == 10)       { j.A = OX; j.Bt = WO; j.M = T; j.N = DM; j.K = DM; j.E.kind = 2; j.E.opart_off = (unsigned)WS_SS3; }
                else if (ph == 11)       { j.A = XB; j.Bt = WGU2; j.M = T; j.N = 2 * FF; j.K = DM; j.E.kind = 1; j.E.part_off = (unsigned)WS_SS3; j.E.o_off = (unsigned)WS_BIG; }
                else                     { j.A = U; j.Bt = WD2; j.M = T; j.N = DM; j.K = FF; j.E.kind = 2; j.E.scale = 0.5f; j.E.opart_off = (unsigned)WS_SS4; }
                run_gemm(lds, j.A, j.Bt, j.M, j.N, j.K, j.E, j.E.kind == 2 ? (const GAS float*)nullptr : (const GAS float*)(ws + j.E.part_off));
            }
        } else if (ph == 4 && PH_ON(4)) {
            PH_IDS;
            LAS uchar* scr = lds + wave * 8448;
            { const GAS float* cwp = INP(8); const GAS float* cbp = INP(9); for (int it = gw; it < (T / 64) * 16; it += NGW) conv_item(PROJ, cwp, cbp, XC, XT, BTR, scr, it, lane); }
            for (int it = gw; it < NB * 4 * 2 * 64; it += NGW) { const int st = it & 63, dt = (it >> 6) & 1, bh = it >> 7, b = bh >> 2, h = bh & 3;
                transpose64(PROJ + (size_t)(b * SEQ + st * 64) * PLD + PC_V + h * 128 + dt * 64, PLD, VT + (size_t)(bh * 128 + dt * 64) * SEQ + st * 64, SEQ, scr, lane); }
            for (int it = gw; it < NB * 4 * 4 * 4; it += NGW) { const int mt = it & 3, dt = (it >> 2) & 3, bh = it >> 4, b = bh >> 2, h = bh & 3;
                transpose64(KVX + (size_t)(b * MEML + mt * 64) * (2 * DM) + DM + h * 256 + dt * 64, 2 * DM, VTX + (size_t)(bh * 256 + dt * 64) * MEML + mt * 64, MEML, scr, lane); }
        } else if (ph == 5 && PH_ON(5)) {
            PH_IDS;
#ifndef REP_SSD
#define REP_SSD 1
#endif
#ifndef REP_ATT
#define REP_ATT 1
#endif
            for (int rep = 0; rep < REP_SSD; ++rep)
            for (int it = bx; it < NB * 8 * 2; it += G) { const int dir = it & 1, h = (it >> 1) & 7, b = it >> 4;
                const float Aneg = -__expf(dir ? INP(13)[h] : INP(12)[h]);
#ifdef SSD_VALU
                ssd_item(lds, b, h, dir, XC, DTB, Aneg, dir ? YB : YF); }
#else
                ssd_item2(lds, b, h, dir, XC, BTR, XT, DTB, Aneg, dir ? YB : YF); }
#endif
            unsigned tacc = 0u;
            for (int rep = 0; rep < REP_ATT; ++rep)
            for (int i = 0;; ++i) {
                int bh, qb;
                if (G == 256) { if (i >= 8) break; bh = i * 8 + (bx & 7); qb = bx >> 3; }
                else { const int L = i * G + bx; if (L >= 2048) break; bh = L >> 5; qb = L & 31; }
                const int b = bh >> 2, h = bh & 3; const size_t row0 = (size_t)b * SEQ + qb * 128;
                const int t = wave & 1;
                attn_item<64, 128, 128, 64, 0, true>(lds, PROJ + row0 * PLD + PC_Q + h * 128 + t * 64, PLD, PROJ + (size_t)b * SEQ * PLD + PC_K + h * 128, PLD, t * 64,
                                               VT + (size_t)bh * 128 * SEQ, SEQ, 0, YMIX + row0 * DM + 512 + h * 128, DM, lamp[0], INP(20), tacc);
            }
#ifdef TSEG
            if (bx == 0 && tid == 0) *(GAS unsigned*)(ws + WS_CTL + 64) = (TSEG == 0) ? 250000u : tacc;
#endif
        } else if (ph == 6 && PH_ON(6)) {
            PH_IDS;
            { const GAS float* Dp = INP(14); const GAS float* gp = INP(15);
              for (int it0 = gw * 4; it0 < T * 2; it0 += NGW * 4) {
                u32x2 yf[4], yb[4], xv[4], zv[4];
#pragma unroll
                for (int q = 0; q < 4; ++q) { const int it = it0 + q, tok = it >> 1, c = (it & 1) * 256 + 4 * lane;
                    yf[q] = *(const GAS u32x2*)(YF + (size_t)tok * 512 + c); yb[q] = *(const GAS u32x2*)(YB + (size_t)tok * 512 + c); xv[q] = *(const GAS u32x2*)(XC + (size_t)tok * 1024 + c); zv[q] = *(const GAS u32x2*)(PROJ + (size_t)tok * PLD + PC_Z + c); }
                float y[4][4], ss[4];
#pragma unroll
                for (int q = 0; q < 4; ++q) { const int c = ((it0 + q) & 1) * 256 + 4 * lane; const float D = Dp[c >> 6];
                    y[q][0] = (bflo(yf[q].x) + bflo(yb[q].x) + D * bflo(xv[q].x)) * silu_f(bflo(zv[q].x)); y[q][1] = (bfhi(yf[q].x) + bfhi(yb[q].x) + D * bfhi(xv[q].x)) * silu_f(bfhi(zv[q].x));
                    y[q][2] = (bflo(yf[q].y) + bflo(yb[q].y) + D * bflo(xv[q].y)) * silu_f(bflo(zv[q].y)); y[q][3] = (bfhi(yf[q].y) + bfhi(yb[q].y) + D * bfhi(xv[q].y)) * silu_f(bfhi(zv[q].y));
                    ss[q] = (y[q][0] * y[q][0] + y[q][1] * y[q][1]) + (y[q][2] * y[q][2] + y[q][3] * y[q][3]); }
#pragma unroll
                for (int o = 1; o < 64; o <<= 1) {
#pragma unroll
                    for (int q = 0; q < 4; ++q) ss[q] += __shfl_xor(ss[q], o); }
#pragma unroll
                for (int q = 0; q < 4; ++q) { const int it = it0 + q, tok = it >> 1, c = (it & 1) * 256 + 4 * lane; const float rn = 1.0f / sqrtf(ss[q] * (1.0f / 256.0f) + EPS); const f32x4 gv = *(const GAS f32x4*)(gp + c);
                    u32x2 w; w.x = cvtpk(y[q][0] * rn * gv[0], y[q][1] * rn * gv[1]); w.y = cvtpk(y[q][2] * rn * gv[2], y[q][3] * rn * gv[3]);
                    *(GAS u32x2*)(YMIX + (size_t)tok * DM + c) = w; }
              } }
        } else if (ph == 9 && PH_ON(9)) {
            PH_IDS;
            unsigned tdummy = 0u;
            for (int i = 0;; ++i) {
                int bh, qb;
                if (G == 256) { if (i >= 8) break; bh = i * 8 + (bx & 7); qb = bx >> 3; }
                else { const int L = i * G + bx; if (L >= 2048) break; bh = L >> 5; qb = L & 31; }
                const int b = bh >> 2, h = bh & 3; const size_t row0 = (size_t)b * SEQ + qb * 128;
                const int t = wave & 1;
xattn_item(lds, QX + row0 * DM + h * 256, DM, KVX + (size_t)b * MEML * (2 * DM) + h * 256, 2 * DM, VTX + (size_t)bh * 256 * MEML, MEML, OX + row0 * DM + h * 256, DM);
            }
        } else if (ph == 13 && PH_ON(13)) {
            PH_IDS;
            { f32x4 gv[4];
#pragma unroll
              for (int j = 0; j < 4; ++j) gv[j] = ((const GAS f32x4*)INP(31))[lane + 64 * j];
              for (int row0 = gw * 8; row0 < T; row0 += NGW * 8) {
                float sp[8]; u32x2 xv[8][4];
#pragma unroll
                for (int r = 0; r < 8; ++r) { sp[r] = SS4[(size_t)(row0 + r) * 16 + (lane & 15)];
#pragma unroll
                    for (int j = 0; j < 4; ++j) xv[r][j] = ((const GAS u32x2*)(XB + (size_t)(row0 + r) * DM))[lane + 64 * j]; }
#pragma unroll
                for (int o = 1; o < 16; o <<= 1) {
#pragma unroll
                    for (int r = 0; r < 8; ++r) sp[r] += __shfl_xor(sp[r], o); }
#pragma unroll
                for (int r = 0; r < 8; ++r) { const float rs = 1.0f / sqrtf(sp[r] * (1.0f / 1024.0f) + EPS); GAS f32x4* xr = (GAS f32x4*)(out + (size_t)(row0 + r) * DM);
#pragma unroll
                    for (int j = 0; j < 4; ++j) { f32x4 v; v[0] = bflo(xv[r][j].x); v[1] = bfhi(xv[r][j].x); v[2] = bflo(xv[r][j].y); v[3] = bfhi(xv[r][j].y); xr[lane + 64 * j] = v * rs * gv[j]; } }
              } }
        }
#ifdef TSEG
        else if (ph == 14) {
            const unsigned tk = *(GAS unsigned*)(ws + WS_CTL + 64); unsigned K = ((tk + 1024u) & ~2047u) * 4u; if (K > 8000000u) K = 8000000u;
            for (unsigned i = (unsigned)bx * 512u + (unsigned)opaque_tid(); i < K; i += (unsigned)NTHR) out[i * 8u] += (i & 1u) ? 0.1f : -0.1f;
        }
#endif
#ifdef REP_PH
        if (ph == REP_PH && !rep_done) { rep_done = true; cg::this_grid().sync(); --ph; continue; }
#endif
        if (ph + 1 < a.ph_hi) { if (a.ph_lo < 0) cg::this_grid().sync(); else xcd_barrier(xbar); }
#ifdef EXTRA_SYNCS
        if (ph == 6) for (int e = 0; e < EXTRA_SYNCS; ++e) cg::this_grid().sync();
#endif
    }
}

extern "C" void kernel_launch(void* const* d_in, const int* in_sizes, int n_in, void* d_out, int out_size, void* d_ws, size_t ws_size, hipStream_t stream) {
    static int grid = 0;
    if (grid == 0) {
        if (n_in != 32 || in_sizes[0] != T * DM || out_size != T * DM || ws_size < WS_END) {
            fprintf(stderr, "kernel_launch: unexpected shapes (n_in %d, in0 %d, out %d, ws %zu < %zu); nothing launched\n", n_in, n_in > 0 ? in_sizes[0] : -1, out_size, ws_size, (size_t)WS_END); grid = -1; return; }
        int dev = 0, cus = 0, per_cu = 0;
        hipGetDevice(&dev); hipDeviceGetAttribute(&cus, hipDeviceAttributeMultiprocessorCount, dev);
        if (hipFuncSetAttribute((const void*)mega_fwd, hipFuncAttributeMaxDynamicSharedMemorySize, LDS_BYTES) != hipSuccess) { fprintf(stderr, "kernel_launch: hipFuncSetAttribute failed\n"); grid = -1; return; }
        if (hipOccupancyMaxActiveBlocksPerMultiprocessor(&per_cu, (const void*)mega_fwd, 512, LDS_BYTES) != hipSuccess || per_cu < 1) { fprintf(stderr, "kernel_launch: occupancy query says %d\n", per_cu); per_cu = 1; }
        (void)hipGetLastError();
        grid = cus * per_cu;
        if (grid <= 0 || grid > 256) grid = 256;
        if (grid != 256) fprintf(stderr, "kernel_launch: grid %d != 256: built for a 256-CU device\n", grid);
    }
    if (grid < 0) return;
    Args a{};
    for (int i = 0; i < 32; ++i) a.in[i] = (const float*)d_in[i];
    a.out = (float*)d_out; a.ws = (unsigned char*)d_ws;
#if MK_COOP
    if (hipMemsetAsync((char*)d_ws + WS_CTL + 4096, 0, XCD_BAR_WORDS * 4, stream) != hipSuccess) { fprintf(stderr, "kernel_launch: memset of the barrier words failed\n"); return; }
    a.ph_lo = 0; a.ph_hi = N_PHASES;
    void* kargs[] = {&a};
    hipError_t e = hipLaunchCooperativeKernel((const void*)mega_fwd, dim3(grid), dim3(512), kargs, LDS_BYTES, stream);
    if (e != hipSuccess) fprintf(stderr, "kernel_launch: cooperative launch failed: %s (grid %d)\n", hipGetErrorString(e), grid);
#else
    for (int ph = 0; ph < N_PHASES; ++ph) { a.ph_lo = ph; a.ph_hi = ph + 1; hipLaunchKernelGGL(mega_fwd, dim3(grid), dim3(512), LDS_BYTES, stream, a); }
#endif
}
```
